# Optimizing an MI355X kernel written in HIP

```python
import math
import jax, jax.numpy as jnp
from jax import lax
import numpy as np

D_MODEL = 1024
BATCH = 32
SEQ = 2048
DEPTH = 2
DEC_BATCH = 8
DEC_SEQ = 4096
PAST_LEN = 128

N_META = 16
NORM_EPS = 1e-6
N_BRANCH = 4
BRANCH_W = 512
FNET_GROUPS = 4
FNET_GW = BRANCH_W // FNET_GROUPS
SSM_HEAD_DIM = 64
SSM_HEADS = BRANCH_W // SSM_HEAD_DIM
SSM_GROUPS = 2
SSM_HPG = SSM_HEADS // SSM_GROUPS
SSM_STATE = 128
SSM_CHUNK = 128
SSM_CONV = 3
SSM_XBC = BRANCH_W + 2 * SSM_GROUPS * SSM_STATE
HYENA_ORDER = 2
HYENA_EMB = 33
HYENA_FFN = 64
HYENA_CONV = 3
HYENA_TARGET = 1e-2
HYENA_FAST = 0.3
HYENA_SLOW = 1.5
SC_CONV = 3
D_FF = 2816
FFN_CONV = 3

COL_FNET = BRANCH_W
COL_SSM = BRANCH_W + SSM_XBC + 2 * SSM_HEADS
COL_HYENA = (HYENA_ORDER + 1) * BRANCH_W
COL_SC = 3 * BRANCH_W
COL_GATE = N_BRANCH * D_MODEL
D_IN_PROJ = COL_FNET + COL_SSM + COL_HYENA + COL_SC + COL_GATE
SPLIT_IN = (COL_FNET, COL_FNET + COL_SSM, COL_FNET + COL_SSM + COL_HYENA, COL_FNET + COL_SSM + COL_HYENA + COL_SC)

kernel_name = 'hybrid_bidir_gated_encoder'


def rms_norm(x, w):
    xf = x.astype(jnp.float32)
    y = xf * lax.rsqrt(jnp.mean(xf * xf, axis=-1, keepdims=True) + NORM_EPS)
    return (y * w.astype(jnp.float32)).astype(x.dtype)


def dwconv_centred(u, w):
    k = w.shape[0]
    p = k // 2
    t = u.shape[1]
    up = jnp.pad(u, ((0, 0), (p, p), (0, 0)))
    out = up[:, 0:t] * w[0]
    for j in range(1, k):
        out = out + up[:, j:j + t] * w[j]
    return out


def _pad_time(a, front, back):
    return jnp.pad(a, [(0, 0), (front, back)] + [(0, 0)] * (a.ndim - 2))


def fnet_branch(u):
    b, t, _ = u.shape
    g = u.astype(jnp.float32).reshape(b, t, FNET_GROUPS, FNET_GW)
    y = jnp.fft.fft2(g, axes=(1, 3), norm='ortho').real
    return y.reshape(b, t, BRANCH_W).astype(u.dtype)


def ssd_scan(x, dt, a, bm, cm):
    b, t, g, r, p = x.shape
    n = bm.shape[-1]
    c = t // SSM_CHUNK
    xc = (x * dt[..., None]).reshape(b, c, SSM_CHUNK, g, r, p)
    a_cs = jnp.cumsum((dt * a).reshape(b, c, SSM_CHUNK, g, r), axis=2)
    bc = bm.reshape(b, c, SSM_CHUNK, g, n)
    cc = cm.reshape(b, c, SSM_CHUNK, g, n)
    seg = a_cs[:, :, :, None] - a_cs[:, :, None, :]
    lower = jnp.tril(jnp.ones((SSM_CHUNK, SSM_CHUNK), dtype=bool))[None, None, :, :, None, None]
    decay = jnp.exp(jnp.where(lower, seg, -jnp.inf))
    cb = jnp.einsum('bclgn,bcsgn->bclsg', cc, bc)
    y_diag = jnp.einsum('bclsgr,bcsgrp->bclgrp', cb[..., None] * decay, xc)
    decay_states = jnp.exp(a_cs[:, :, -1:] - a_cs)
    states = jnp.einsum('bcsgn,bcsgr,bcsgrp->bcgrpn', bc, decay_states, xc)
    chunk_decay = jnp.exp(a_cs[:, :, -1])

    def step(h, inp):
        s, d = inp
        return h * d[..., None, None] + s, h

    h0 = jnp.zeros((b, g, r, p, n), jnp.float32)
    _, prev = lax.scan(step, h0, (jnp.moveaxis(states, 1, 0), jnp.moveaxis(chunk_decay, 1, 0)))
    prev = jnp.moveaxis(prev, 0, 1)
    y_off = jnp.einsum('bclgn,bcgrpn,bclgr->bclgrp', cc, prev, jnp.exp(a_cs))
    return (y_diag + y_off).reshape(b, t, g, r, p)


def ssd_branch(u, conv_w, conv_b, dt_bias, a_log, d_skip, norm_w):
    b, t, _ = u.shape
    f32 = jnp.float32
    z, xbc, dt_raw = jnp.split(u, (BRANCH_W, BRANCH_W + SSM_XBC), axis=-1)
    xbc = jax.nn.silu(dwconv_centred(xbc, conv_w) + conv_b).astype(f32)
    xs, bm, cm = jnp.split(xbc, (BRANCH_W, BRANCH_W + SSM_GROUPS * SSM_STATE), axis=-1)
    dt = jax.nn.softplus(dt_raw.astype(f32).reshape(b, t, 2, SSM_GROUPS, SSM_HPG)
                         + dt_bias.astype(f32).reshape(2, SSM_GROUPS, SSM_HPG))
    a = -jnp.exp(a_log.astype(f32)).reshape(2, SSM_GROUPS, SSM_HPG)
    front = SSM_CHUNK - N_META
    back = (-(t - N_META)) % SSM_CHUNK
    xs5 = xs.reshape(b, t, SSM_GROUPS, SSM_HPG, SSM_HEAD_DIM)
    xh = _pad_time(xs5, front, back)
    bp = _pad_time(bm.reshape(b, t, SSM_GROUPS, SSM_STATE), front, back)
    cp = _pad_time(cm.reshape(b, t, SSM_GROUPS, SSM_STATE), front, back)
    dtp = _pad_time(dt, front, back)
    y_fwd = ssd_scan(xh, dtp[:, :, 0], a[0], bp, cp)
    y_bwd = ssd_scan(xh[:, ::-1], dtp[:, ::-1, 1], a[1], bp[:, ::-1], cp[:, ::-1])[:, ::-1]
    y = (y_fwd + y_bwd)[:, front:front + t] + xs5 * d_skip.astype(f32).reshape(SSM_GROUPS, SSM_HPG, 1)
    y = y.reshape(b, t, BRANCH_W) * jax.nn.silu(z.astype(f32))
    yg = y.reshape(b, t, SSM_GROUPS, BRANCH_W // SSM_GROUPS)
    yg = yg * lax.rsqrt(jnp.mean(yg * yg, axis=-1, keepdims=True) + NORM_EPS)
    return (yg.reshape(b, t, BRANCH_W) * norm_w.astype(f32)).astype(u.dtype)


def hyena_filter_spectrum(t, w1, b1, w2, b2, w3, freq):
    f32 = jnp.float32
    tt = jnp.linspace(0.0, 1.0, t, dtype=f32)[:, None]
    bands = (HYENA_EMB - 1) // 2
    w = (2.0 * math.pi / t) * jnp.arange(t, dtype=f32)[:, None]
    fr = jnp.linspace(1e-4, bands - 1, bands, dtype=f32)[None, :]
    z = jnp.concatenate([tt, jnp.cos(fr * w), -jnp.sin(fr * w)], axis=-1)
    fq = freq.astype(f32)
    hid = jnp.sin(fq * (z @ w1.astype(f32) + b1.astype(f32)))
    hid = jnp.sin(fq * (hid @ w2.astype(f32) + b2.astype(f32)))
    h = (hid @ w3.astype(f32)).reshape(t, HYENA_ORDER, 2, BRANCH_W)
    max_decay = math.log(HYENA_TARGET) / HYENA_FAST
    min_decay = math.log(HYENA_TARGET) / HYENA_SLOW
    deltas = jnp.abs(jnp.linspace(min_decay, max_decay, BRANCH_W, dtype=f32))
    h = h * jnp.exp(-tt[:, :, None, None] * deltas)
    h_f = h[:, :, 0]
    h_b = h[1:, :, 1]
    l1 = jnp.sum(jnp.abs(h_f), axis=0) + jnp.sum(jnp.abs(h_b), axis=0)
    k = jnp.concatenate([h_f, jnp.zeros((1, HYENA_ORDER, BRANCH_W), f32), h_b[::-1]], axis=0) / l1
    return jnp.fft.rfft(k, axis=0)


def long_conv(u, kf, bias):
    t = u.shape[1]
    uf = jnp.fft.rfft(u, n=2 * t, axis=1)
    return jnp.fft.irfft(uf * kf, n=2 * t, axis=1)[:, :t] + u * bias


def hyena_branch(u, conv_w, w1, b1, w2, b2, w3, freq, bias):
    t = u.shape[1]
    uc = dwconv_centred(u, conv_w).astype(jnp.float32)
    v, x1, x2 = jnp.split(uc, 3, axis=-1)
    kf = hyena_filter_spectrum(t, w1, b1, w2, b2, w3, freq)
    bias = bias.astype(jnp.float32)
    z = x1 * long_conv(v, kf[:, 0], bias[0])
    z = x2 * long_conv(z, kf[:, 1], bias[1])
    return z.astype(u.dtype)


def shortconv_branch(u, conv_w):
    bg, cg, xin = jnp.split(u, 3, axis=-1)
    return bg * dwconv_centred(cg * xin, conv_w)


def mixer_block(x, norm_mix, w_in, ssm_conv_w, ssm_conv_b, ssm_dt_bias, ssm_a_log, ssm_d, ssm_norm,
                hyena_conv_w, hyena_w1, hyena_b1, hyena_w2, hyena_b2, hyena_w3, hyena_freq, hyena_bias,
                sc_conv_w, w_branch, w_out):
    b, t, _ = x.shape
    h = rms_norm(x, norm_mix)
    proj = h @ w_in
    u_fn, u_ssm, u_hy, u_sc, g_raw = jnp.split(proj, SPLIT_IN, axis=-1)
    branches = (
        fnet_branch(u_fn),
        ssd_branch(u_ssm, ssm_conv_w, ssm_conv_b, ssm_dt_bias, ssm_a_log, ssm_d, ssm_norm),
        hyena_branch(u_hy, hyena_conv_w, hyena_w1, hyena_b1, hyena_w2, hyena_b2, hyena_w3, hyena_freq, hyena_bias),
        shortconv_branch(u_sc, sc_conv_w),
    )
    gates = jax.nn.sigmoid(g_raw.astype(jnp.float32)).astype(x.dtype).reshape(b, t, N_BRANCH, D_MODEL)
    merged = gates[:, :, 0] * (branches[0] @ w_branch[0])
    for k in range(1, N_BRANCH):
        merged = merged + gates[:, :, k] * (branches[k] @ w_branch[k])
    return merged @ w_out


def conv_ffn(x, norm_ffn, ffn_conv_w, w_up, w_down):
    h = rms_norm(x, norm_ffn)
    up = dwconv_centred(h @ w_up, ffn_conv_w)
    a, v = jnp.split(up, 2, axis=-1)
    return (jax.nn.silu(a) * v) @ w_down


def run_trunk(x, meta_tokens, norm_final, mixer_params, ffn_params):
    b = x.shape[0]
    meta = jnp.broadcast_to(meta_tokens[None].astype(x.dtype), (b, N_META, D_MODEL))
    h = jnp.concatenate([meta, x], axis=1)
    for l in range(DEPTH):
        h = h + mixer_block(h, *(p[l] for p in mixer_params))
        h = h + conv_ffn(h, *(p[l] for p in ffn_params))
    return rms_norm(h, norm_final)[:, N_META:]


def setup_inputs(seed: int = 0) -> dict:
    key = jax.random.key(seed)
    ks = jax.random.split(key, 32)
    f32 = jnp.float32

    def nrm(k, shape, scale):
        return jax.random.normal(k, shape, f32) * scale

    dt0 = jnp.exp(jax.random.uniform(ks[8], (DEPTH, 2, SSM_HEADS), f32, math.log(1e-3), math.log(1e-1)))
    return {
        'x_prompt': nrm(ks[0], (BATCH, SEQ, D_MODEL), 1.0),
        'x_sample': nrm(ks[1], (DEC_BATCH, DEC_SEQ, D_MODEL), 1.0),
        'meta_tokens': nrm(ks[2], (N_META, D_MODEL), 1.0),
        'norm_mix': 1.0 + nrm(ks[3], (DEPTH, D_MODEL), 0.02),
        'w_in': nrm(ks[4], (DEPTH, D_MODEL, D_IN_PROJ), D_MODEL ** -0.5),
        'ssm_conv_w': nrm(ks[5], (DEPTH, SSM_CONV, SSM_XBC), SSM_CONV ** -0.5),
        'ssm_conv_b': nrm(ks[6], (DEPTH, SSM_XBC), 0.02),
        'ssm_dt_bias': dt0 + jnp.log(-jnp.expm1(-dt0)),
        'ssm_a_log': jnp.log(jax.random.uniform(ks[9], (DEPTH, 2, SSM_HEADS), f32, 1.0, 16.0)),
        'ssm_d': 1.0 + nrm(ks[10], (DEPTH, SSM_HEADS), 0.02),
        'ssm_norm': 1.0 + nrm(ks[11], (DEPTH, BRANCH_W), 0.02),
        'hyena_conv_w': nrm(ks[12], (DEPTH, HYENA_CONV, COL_HYENA), HYENA_CONV ** -0.5),
        'hyena_w1': nrm(ks[13], (DEPTH, HYENA_EMB, HYENA_FFN), HYENA_EMB ** -0.5),
        'hyena_b1': nrm(ks[14], (DEPTH, HYENA_FFN), 0.02),
        'hyena_w2': nrm(ks[15], (DEPTH, HYENA_FFN, HYENA_FFN), HYENA_FFN ** -0.5),
        'hyena_b2': nrm(ks[16], (DEPTH, HYENA_FFN), 0.02),
        'hyena_w3': nrm(ks[17], (DEPTH, HYENA_FFN, HYENA_ORDER * 2 * BRANCH_W), HYENA_FFN ** -0.5),
        'hyena_freq': 1.0 + nrm(ks[18], (DEPTH, HYENA_FFN), 0.02),
        'hyena_bias': nrm(ks[19], (DEPTH, HYENA_ORDER, BRANCH_W), 1.0),
        'sc_conv_w': nrm(ks[20], (DEPTH, SC_CONV, BRANCH_W), SC_CONV ** -0.5),
        'w_branch': nrm(ks[21], (DEPTH, N_BRANCH, BRANCH_W, D_MODEL), BRANCH_W ** -0.5),
        'w_out': nrm(ks[22], (DEPTH, D_MODEL, D_MODEL), D_MODEL ** -0.5),
        'norm_ffn': 1.0 + nrm(ks[23], (DEPTH, D_MODEL), 0.02),
        'ffn_conv_w': nrm(ks[24], (DEPTH, FFN_CONV, 2 * D_FF), FFN_CONV ** -0.5),
        'w_up': nrm(ks[25], (DEPTH, D_MODEL, 2 * D_FF), D_MODEL ** -0.5),
        'w_down': nrm(ks[26], (DEPTH, D_FF, D_MODEL), D_FF ** -0.5),
        'norm_final': 1.0 + nrm(ks[27], (D_MODEL,), 0.02),
    }


def reference(x_prompt, x_sample, meta_tokens, norm_mix, w_in, ssm_conv_w, ssm_conv_b, ssm_dt_bias,
              ssm_a_log, ssm_d, ssm_norm, hyena_conv_w, hyena_w1, hyena_b1, hyena_w2, hyena_b2, hyena_w3,
              hyena_freq, hyena_bias, sc_conv_w, w_branch, w_out, norm_ffn, ffn_conv_w, w_up, w_down,
              norm_final):
    mixer_params = (norm_mix, w_in, ssm_conv_w, ssm_conv_b, ssm_dt_bias, ssm_a_log, ssm_d, ssm_norm,
                    hyena_conv_w, hyena_w1, hyena_b1, hyena_w2, hyena_b2, hyena_w3, hyena_freq, hyena_bias,
                    sc_conv_w, w_branch, w_out)
    ffn_params = (norm_ffn, ffn_conv_w, w_up, w_down)
    y_prompt = run_trunk(x_prompt, meta_tokens, norm_final, mixer_params, ffn_params)
    y_sample = run_trunk(x_sample, meta_tokens, norm_final, mixer_params, ffn_params)
    return (y_prompt, y_sample)
```

```cpp
#include <hip/hip_runtime.h>
#include <hip/hip_cooperative_groups.h>
#include <cstdio>
namespace cg = cooperative_groups;

typedef unsigned short u16;
using bf16x8 = __attribute__((ext_vector_type(8))) short;
using f32x4 = __attribute__((ext_vector_type(4))) float;

constexpr int NT = 98944, TP = 2064, TS = 4112, ROWS_P = 32 * 2064;
constexpr int DIN = 9232;
constexpr float EPS = 1e-6f;
constexpr int XCD_BAR_WORDS_C = 3456;
#ifndef REPG
#define REPG 1
#endif
#ifndef REPL
#define REPL 1
#endif
#ifndef REPS
#define REPS 1
#endif
#ifndef REPE
#define REPE 1
#endif
#ifndef REPY
#define REPY 1
#endif
#define GSYNC() do { for (int rs_ = 0; rs_ < REPY; ++rs_) xcd_barrier_impl(xb.bar, xb.x, xb.st); } while (0)

constexpr size_t SZ_WL = 44597248ull;
constexpr size_t OW_IN = 0, OW_FN = 18907136ull, OW_BR = OW_FN + 2097152ull, OW_OUT = OW_BR + 4194304ull,
                 OW_UP = OW_OUT + 2097152ull, OW_DOWN = OW_UP + 11534336ull;
constexpr size_t OFF_H = 2 * SZ_WL;
constexpr size_t SZ_ACT = (size_t)NT * 1024 * 2;
constexpr size_t OFF_HN = OFF_H + SZ_ACT;
constexpr size_t OFF_BR = OFF_HN + SZ_ACT;
constexpr size_t SZ_BR = (size_t)NT * 512 * 2;
constexpr size_t OFF_X2T = OFF_BR + 4 * SZ_BR;
constexpr size_t OFF_KF = OFF_X2T + SZ_BR;
constexpr size_t SZ_KF = 2ull * 512 * (4128 + 8224) * 2;
constexpr size_t OFF_HID = OFF_KF + SZ_KF;
constexpr size_t SZ_HID = (size_t)(TP + TS) * 64 * 4;
constexpr size_t OFF_L1 = OFF_HID + SZ_HID;
constexpr size_t WS_NEED = OFF_BR + (size_t)NT * 2816 * 2;
constexpr size_t OFF_BAR = (WS_NEED + 4095) / 4096 * 4096;
constexpr size_t WS_TOTAL = OFF_BAR + XCD_BAR_WORDS_C * 4;
constexpr int THP = 2112, THS = 4160;
constexpr int MHP = 9 * 128, MHS = 17 * 128;
constexpr size_t OD_DFTP = 0, OD_DFTS = (size_t)MHP * 2 * THP * 2, OD_PROJ = OD_DFTS + (size_t)MHS * 2 * THS * 2;
constexpr size_t OD_HS = OD_PROJ + (size_t)NT * 1552 * 2;
constexpr size_t OD_DS = OD_HS + 4ull * 56 * 4 * 8192 * 4;
constexpr size_t OD_CSG = OD_DS + 4ull * 56 * 4 * 4;
constexpr int SEGC = 33;
constexpr long GT_SAMPLE0 = 32l * 512 * 2 * THP;

struct P {
  const float* in[27];
  float* out;
  char* ws;
};

__device__ __forceinline__ u16 f2bf(float f) {
  unsigned u = __float_as_uint(f);
  u += 0x7fffu + ((u >> 16) & 1u);
  return (u16)(u >> 16);
}
__device__ __forceinline__ float bf2f(u16 h) { return __uint_as_float(((unsigned)h) << 16); }
__device__ __forceinline__ unsigned pack2(float a, float b) { return (unsigned)f2bf(a) | ((unsigned)f2bf(b) << 16); }
__device__ __forceinline__ float lo2f(unsigned u) { return __uint_as_float(u << 16); }
__device__ __forceinline__ float hi2f(unsigned u) { return __uint_as_float(u & 0xffff0000u); }
__device__ __forceinline__ float siluf(float x) { return x / (1.f + __expf(-x)); }
__device__ __forceinline__ float sigmf(float x) { return 1.f / (1.f + __expf(-x)); }

__device__ __forceinline__ int tidx() { int t = threadIdx.x; asm volatile("" : "+v"(t)); return t; }
__device__ __forceinline__ int bidx() { int b = blockIdx.x; asm volatile("" : "+s"(b)); return b; }
__device__ __forceinline__ void ld8(const float* p, float (&w)[8]) {
  float4 a = *(const float4*)p, b = *(const float4*)(p + 4);
  w[0] = a.x; w[1] = a.y; w[2] = a.z; w[3] = a.w; w[4] = b.x; w[5] = b.y; w[6] = b.z; w[7] = b.w;
}
__device__ __forceinline__ int seq_base(int seq) { return seq < 32 ? seq * TP : ROWS_P + (seq - 32) * TS; }
__device__ __forceinline__ void row_info(int r, int& t, int& T) {
  if (r < ROWS_P) { t = r % TP; T = TP; } else { t = (r - ROWS_P) % TS; T = TS; }
}
__device__ __forceinline__ float bperm(float v, int src_lane) {
  return __int_as_float(__builtin_amdgcn_ds_bpermute(src_lane << 2, __float_as_int(v)));
}
__device__ __forceinline__ float wave_sum(float v) {
  const int lane = tidx() & 63;
#pragma unroll
  for (int o = 32; o > 0; o >>= 1) v += bperm(v, lane ^ o);
  return v;
}


#define XB_TMO      128
#define XB_XCNT(j)  (256  + 64 * (j))
#define XB_XSUB(j)  (1280 + 64 * (j))
#define XB_XGEN(j)  (2304 + 64 * (j))
#define XB_TOP      3328
#define XB_TOPGEN   3392
#define XCD_BAR_WORDS 3456
#define XB_SPIN_CAP (1u << 24)
#define LAS __attribute__((address_space(3)))
__device__ __forceinline__ unsigned xb_ld(unsigned* p)              { return __hip_atomic_load(p, __ATOMIC_RELAXED, __HIP_MEMORY_SCOPE_AGENT); }
__device__ __forceinline__ unsigned xb_add(unsigned* p, unsigned v) { return __hip_atomic_fetch_add(p, v, __ATOMIC_RELAXED, __HIP_MEMORY_SCOPE_AGENT); }
__device__ __forceinline__ unsigned xb_xcc_id() { return (unsigned)__builtin_amdgcn_s_getreg((3 << 11) | 20) & 0xFu; }
#define XB_SPIN(cond, bar) do { unsigned _sp = 0; while (cond) { __builtin_amdgcn_s_sleep(1); \
    if ((++_sp & 255u) == 0u) { if (xb_ld(&(bar)[XB_TMO])) break; if (_sp > XB_SPIN_CAP) { atomicAdd(&(bar)[XB_TMO], 1u); break; } } } } while (0)
struct XcdBarrier { unsigned* bar; unsigned x; volatile LAS unsigned* st; };
__device__ __forceinline__ XcdBarrier xcd_barrier_post(unsigned* bar, volatile LAS unsigned* st) {
  XcdBarrier b; b.bar = bar; b.x = xb_xcc_id(); b.st = st;
  if (threadIdx.x == 0) (void)xb_add(&bar[XB_XCNT(b.x)], 1u);
  return b;
}
__device__ __forceinline__ void xcd_barrier_complete(unsigned* bar, unsigned x, unsigned& nloc, unsigned& nx) {
  const unsigned G = gridDim.x * gridDim.y * gridDim.z;
  unsigned sum, cnt, mine, sp = 0u;
  for (;;) {
    sum = 0u; cnt = 0u; mine = 0u;
#pragma unroll
    for (unsigned j = 0; j < 16; ++j) { const unsigned c = xb_ld(&bar[XB_XCNT(j)]); sum += c; cnt += (c > 0u) ? 1u : 0u; mine = (j == x) ? c : mine; }
    if (sum == G) break;
    __builtin_amdgcn_s_sleep(1);
    if ((++sp & 255u) == 0u) { if (xb_ld(&bar[XB_TMO])) break; if (sp > XB_SPIN_CAP) { atomicAdd(&bar[XB_TMO], 1u); break; } }
  }
  nloc = mine > 0u ? mine : 1u; nx = cnt > 0u ? cnt : 1u;
}
__device__ __noinline__ void xcd_barrier_impl(unsigned* bar, unsigned bx, volatile LAS unsigned* st) {
  XcdBarrier b; b.bar = bar; b.x = bx; b.st = st;
  asm volatile("s_waitcnt vmcnt(0)" ::: "memory");
  __syncthreads();
  if (threadIdx.x == 0) {
    unsigned* bar = b.bar;
    __builtin_amdgcn_s_waitcnt(0);
    unsigned nloc = b.st[0], nx = b.st[1];
    if (nloc == 0u) { xcd_barrier_complete(bar, b.x, nloc, nx); b.st[0] = nloc; b.st[1] = nx; }
    const unsigned old = xb_add(&bar[XB_XSUB(b.x)], 1u);
    const unsigned gen = old / nloc;
    if (old + 1u == (gen + 1u) * nloc) {
      __builtin_amdgcn_fence(__ATOMIC_RELEASE, "agent");
      asm volatile("s_waitcnt vmcnt(0)" ::: "memory");
      const unsigned og = xb_add(&bar[XB_TOP], 1u);
      const unsigned tg = og / nx;
      if (og + 1u == (tg + 1u) * nx) xb_add(&bar[XB_TOPGEN], 1u);
      else XB_SPIN(xb_ld(&bar[XB_TOPGEN]) == tg, bar);
      __builtin_amdgcn_fence(__ATOMIC_ACQUIRE, "agent");
      xb_add(&bar[XB_XGEN(b.x)], 1u);
      asm volatile("s_waitcnt vmcnt(0)" ::: "memory");
    } else {
      XB_SPIN(xb_ld(&bar[XB_XGEN(b.x)]) == gen, bar);
      __builtin_amdgcn_fence(__ATOMIC_ACQUIRE, "agent");
      asm volatile("s_waitcnt vmcnt(0)" ::: "memory");
    }
  }
  __syncthreads();
}

struct GA { const u16* A; long lda; int M; const u16* B; long ldb; int N; int K; };

__device__ __forceinline__ uint4 ld_mask(const u16* base, long ld, int r, int R, int k, int K) {
  const bool ok = (r < R) && (k < K);
  const int rr = r < R ? r : R - 1;
  const int kk = k < K ? k : 0;
  uint4 v = *(const uint4*)(base + (long)rr * ld + kk);
  v.x = ok ? v.x : 0u; v.y = ok ? v.y : 0u; v.z = ok ? v.z : 0u; v.w = ok ? v.w : 0u;
  return v;
}

template <bool SWAP, int MW>
__device__ __forceinline__ void gemm_compute(f32x4 (&acc)[MW][4], const u16* sA, const u16* sB, int wr, int wc, int fr, int fq) {
  constexpr int MG = MW < 4 ? MW : 4;
#pragma unroll
  for (int kk = 0; kk < 2; ++kk) {
    bf16x8 bfr[4];
#pragma unroll
    for (int n = 0; n < 4; ++n) bfr[n] = *(const bf16x8*)(sB + (wc * 64 + n * 16 + fr) * 72 + kk * 32 + fq * 8);
#pragma unroll
    for (int mg = 0; mg < MW / MG; ++mg) {
      bf16x8 af[MG];
#pragma unroll
      for (int m = 0; m < MG; ++m) af[m] = *(const bf16x8*)(sA + (wr * (MW * 16) + (mg * MG + m) * 16 + fr) * 72 + kk * 32 + fq * 8);
#pragma unroll
      for (int m = 0; m < MG; ++m)
#pragma unroll
        for (int n = 0; n < 4; ++n)
          acc[mg * MG + m][n] = SWAP ? __builtin_amdgcn_mfma_f32_16x16x32_bf16(bfr[n], af[m], acc[mg * MG + m][n], 0, 0, 0)
                                     : __builtin_amdgcn_mfma_f32_16x16x32_bf16(af[m], bfr[n], acc[mg * MG + m][n], 0, 0, 0);
    }
  }
}

template <bool SWAP, int MW = 4>
__device__ __forceinline__ void gemm_main(const GA& g, int m0, int n0, f32x4 (&acc)[MW][4], u16* sA, u16* sB) {
  const int tid = tidx(), lane = tid & 63, wid = tid >> 6, wr = wid >> 1, wc = wid & 1, fr = lane & 15, fq = lane >> 4;
  uint4 ra0[MW], rb0[4], ra1[MW], rb1[4];
  const int nk = (g.K + 63) >> 6;
  const int lr = tid >> 3, lk = (tid & 7) * 8;
#pragma unroll
  for (int i = 0; i < MW; ++i) ra0[i] = ld_mask(g.A, g.lda, m0 + lr + i * 32, g.M, lk, g.K);
#pragma unroll
  for (int i = 0; i < 4; ++i) rb0[i] = ld_mask(g.B, g.ldb, n0 + lr + i * 32, g.N, lk, g.K);
#pragma unroll
  for (int i = 0; i < MW; ++i) ra1[i] = ld_mask(g.A, g.lda, m0 + lr + i * 32, g.M, 64 + lk, g.K);
#pragma unroll
  for (int i = 0; i < 4; ++i) rb1[i] = ld_mask(g.B, g.ldb, n0 + lr + i * 32, g.N, 64 + lk, g.K);
  for (int kt = 0; kt < nk; kt += 2) {
    __syncthreads();
#pragma unroll
    for (int i = 0; i < MW; ++i) *(uint4*)(sA + (lr + i * 32) * 72 + lk) = ra0[i];
#pragma unroll
    for (int i = 0; i < 4; ++i) *(uint4*)(sB + (lr + i * 32) * 72 + lk) = rb0[i];
    __syncthreads();
    if (kt + 2 < nk) {
      const int k = (kt + 2) * 64 + lk;
#pragma unroll
      for (int i = 0; i < MW; ++i) ra0[i] = ld_mask(g.A, g.lda, m0 + lr + i * 32, g.M, k, g.K);
#pragma unroll
      for (int i = 0; i < 4; ++i) rb0[i] = ld_mask(g.B, g.ldb, n0 + lr + i * 32, g.N, k, g.K);
    }
    gemm_compute<SWAP, MW>(acc, sA, sB, wr, wc, fr, fq);
    if (kt + 1 < nk) {
      __syncthreads();
#pragma unroll
      for (int i = 0; i < MW; ++i) *(uint4*)(sA + (lr + i * 32) * 72 + lk) = ra1[i];
#pragma unroll
      for (int i = 0; i < 4; ++i) *(uint4*)(sB + (lr + i * 32) * 72 + lk) = rb1[i];
      __syncthreads();
      if (kt + 3 < nk) {
        const int k = (kt + 3) * 64 + lk;
#pragma unroll
        for (int i = 0; i < MW; ++i) ra1[i] = ld_mask(g.A, g.lda, m0 + lr + i * 32, g.M, k, g.K);
#pragma unroll
        for (int i = 0; i < 4; ++i) rb1[i] = ld_mask(g.B, g.ldb, n0 + lr + i * 32, g.N, k, g.K);
      }
      gemm_compute<SWAP, MW>(acc, sA, sB, wr, wc, fr, fq);
    }
  }
}

template <bool SWAP, int MW>
__device__ __forceinline__ void gemm_main1(const GA& g, int m0, int n0, f32x4 (&acc)[MW][4], u16* sA, u16* sB) {
  static_assert(MW == 8, "256-row tile");
  const int tid = tidx(), lane = tid & 63, wid = tid >> 6, wr = wid >> 1, wc = wid & 1, fr = lane & 15, fq = lane >> 4;
  const int nk = (g.K + 63) >> 6;
  const int lr = tid >> 3, lk = (tid & 7) * 8;
  const u16* pA = g.A + (long)(m0 + lr) * g.lda + lk;
  const u16* pB = g.B + (long)(n0 + lr) * g.ldb + lk;
  const long sa = 32 * g.lda, sb = 32 * g.ldb;
  uint4 a0, a1, a2, a3, a4, a5, a6, a7, b0, b1, b2, b3;
#define GL_LOAD(k) do { \
    a0 = *(const uint4*)(pA + (k)); a1 = *(const uint4*)(pA + (k) + sa); a2 = *(const uint4*)(pA + (k) + 2 * sa); a3 = *(const uint4*)(pA + (k) + 3 * sa); \
    a4 = *(const uint4*)(pA + (k) + 4 * sa); a5 = *(const uint4*)(pA + (k) + 5 * sa); a6 = *(const uint4*)(pA + (k) + 6 * sa); a7 = *(const uint4*)(pA + (k) + 7 * sa); \
    b0 = *(const uint4*)(pB + (k)); b1 = *(const uint4*)(pB + (k) + sb); b2 = *(const uint4*)(pB + (k) + 2 * sb); b3 = *(const uint4*)(pB + (k) + 3 * sb); } while (0)
  GL_LOAD(0);
  u16* wA = sA + lr * 72 + lk;
  u16* wB = sB + lr * 72 + lk;
  for (int kt = 0; kt < nk; ++kt) {
    __syncthreads();
    *(uint4*)(wA) = a0; *(uint4*)(wA + 32 * 72) = a1; *(uint4*)(wA + 64 * 72) = a2; *(uint4*)(wA + 96 * 72) = a3;
    *(uint4*)(wA + 128 * 72) = a4; *(uint4*)(wA + 160 * 72) = a5; *(uint4*)(wA + 192 * 72) = a6; *(uint4*)(wA + 224 * 72) = a7;
    *(uint4*)(wB) = b0; *(uint4*)(wB + 32 * 72) = b1; *(uint4*)(wB + 64 * 72) = b2; *(uint4*)(wB + 96 * 72) = b3;
    __syncthreads();
    const int k = (kt + 1 < nk ? kt + 1 : kt) * 64;
    GL_LOAD(k);
    gemm_compute<SWAP, MW>(acc, sA, sB, wr, wc, fr, fq);
  }
#undef GL_LOAD
}

template <bool SWAP>
__device__ __forceinline__ void gemm_main1_4(const GA& g, int m0, int n0, f32x4 (&acc)[4][4], u16* sA, u16* sB) {
  const int tid = tidx(), lane = tid & 63, wid = tid >> 6, wr = wid >> 1, wc = wid & 1, fr = lane & 15, fq = lane >> 4;
  const int nk = (g.K + 63) >> 6;
  const int lr = tid >> 3, lk = (tid & 7) * 8;
  const u16* pA = g.A + (long)(m0 + lr) * g.lda + lk;
  const u16* pB = g.B + (long)(n0 + lr) * g.ldb + lk;
  const long sa = 32 * g.lda, sb = 32 * g.ldb;
  uint4 a0, a1, a2, a3, b0, b1, b2, b3;
#define GL_LOAD4(k) do { \
    a0 = *(const uint4*)(pA + (k)); a1 = *(const uint4*)(pA + (k) + sa); a2 = *(const uint4*)(pA + (k) + 2 * sa); a3 = *(const uint4*)(pA + (k) + 3 * sa); \
    b0 = *(const uint4*)(pB + (k)); b1 = *(const uint4*)(pB + (k) + sb); b2 = *(const uint4*)(pB + (k) + 2 * sb); b3 = *(const uint4*)(pB + (k) + 3 * sb); } while (0)
  GL_LOAD4(0);
  u16* wA = sA + lr * 72 + lk;
  u16* wB = sB + lr * 72 + lk;
  for (int kt = 0; kt < nk; ++kt) {
    __syncthreads();
    *(uint4*)(wA) = a0; *(uint4*)(wA + 32 * 72) = a1; *(uint4*)(wA + 64 * 72) = a2; *(uint4*)(wA + 96 * 72) = a3;
    *(uint4*)(wB) = b0; *(uint4*)(wB + 32 * 72) = b1; *(uint4*)(wB + 64 * 72) = b2; *(uint4*)(wB + 96 * 72) = b3;
    __syncthreads();
    const int k = (kt + 1 < nk ? kt + 1 : kt) * 64;
    GL_LOAD4(k);
    gemm_compute<SWAP, 4>(acc, sA, sB, wr, wc, fr, fq);
  }
#undef GL_LOAD4
}

template <bool SWAP>
__device__ __forceinline__ void gemm_main2_4(const GA& g, int m0, int n0, f32x4 (&acc)[4][4], u16* sA, u16* sB) {
  const int tid = tidx(), lane = tid & 63, wid = tid >> 6, wr = wid >> 1, wc = wid & 1, fr = lane & 15, fq = lane >> 4;
  const int nk = (g.K + 63) >> 6;
  const int lr = tid >> 3, lk = (tid & 7) * 8;
  const u16* pA = g.A + (long)(m0 + lr) * g.lda + lk;
  const u16* pB = g.B + (long)(n0 + lr) * g.ldb + lk;
  const long sa = 32 * g.lda, sb = 32 * g.ldb;
  uint4 a0, a1, a2, a3, b0, b1, b2, b3, c0, c1, c2, c3, d0, d1, d2, d3;
#define G2_LOAD(k, A0, A1, A2, A3, B0, B1, B2, B3) do { \
    A0 = *(const uint4*)(pA + (k)); A1 = *(const uint4*)(pA + (k) + sa); A2 = *(const uint4*)(pA + (k) + 2 * sa); A3 = *(const uint4*)(pA + (k) + 3 * sa); \
    B0 = *(const uint4*)(pB + (k)); B1 = *(const uint4*)(pB + (k) + sb); B2 = *(const uint4*)(pB + (k) + 2 * sb); B3 = *(const uint4*)(pB + (k) + 3 * sb); } while (0)
#define G2_STORE(A0, A1, A2, A3, B0, B1, B2, B3) do { \
    *(uint4*)(wA) = A0; *(uint4*)(wA + 32 * 72) = A1; *(uint4*)(wA + 64 * 72) = A2; *(uint4*)(wA + 96 * 72) = A3; \
    *(uint4*)(wB) = B0; *(uint4*)(wB + 32 * 72) = B1; *(uint4*)(wB + 64 * 72) = B2; *(uint4*)(wB + 96 * 72) = B3; } while (0)
  u16* wA = sA + lr * 72 + lk;
  u16* wB = sB + lr * 72 + lk;
  G2_LOAD(0, a0, a1, a2, a3, b0, b1, b2, b3);
  G2_LOAD((nk > 1 ? 64 : 0), c0, c1, c2, c3, d0, d1, d2, d3);
  for (int kt = 0; kt < nk; kt += 2) {
    __syncthreads();
    G2_STORE(a0, a1, a2, a3, b0, b1, b2, b3);
    __syncthreads();
    { const int k = (kt + 2 < nk ? kt + 2 : kt) * 64; G2_LOAD(k, a0, a1, a2, a3, b0, b1, b2, b3); }
    gemm_compute<SWAP, 4>(acc, sA, sB, wr, wc, fr, fq);
    if (kt + 1 < nk) {
      __syncthreads();
      G2_STORE(c0, c1, c2, c3, d0, d1, d2, d3);
      __syncthreads();
      { const int k = (kt + 3 < nk ? kt + 3 : kt + 1) * 64; G2_LOAD(k, c0, c1, c2, c3, d0, d1, d2, d3); }
      gemm_compute<SWAP, 4>(acc, sA, sB, wr, wc, fr, fq);
    }
  }
#undef G2_LOAD
#undef G2_STORE
}

template <bool SWAP>
__device__ __forceinline__ void gemm_main_db_4(const GA& g, int m0, int n0, f32x4 (&acc)[4][4], u16* lds) {
  const int tid = tidx(), lane = tid & 63, wid = tid >> 6, wr = wid >> 1, wc = wid & 1, fr = lane & 15, fq = lane >> 4;
  const int nk = g.K >> 5;
  const int lr = tid >> 2, lk = (tid & 3) * 8;
  const u16* pA = g.A + (long)(m0 + lr) * g.lda + lk;
  const u16* pB = g.B + (long)(n0 + lr) * g.ldb + lk;
  const long sa = 64 * g.lda, sb = 64 * g.ldb;
  uint4 a0, a1, b0, b1;
  a0 = *(const uint4*)(pA); a1 = *(const uint4*)(pA + sa); b0 = *(const uint4*)(pB); b1 = *(const uint4*)(pB + sb);
  u16* w = lds + lr * 40 + lk;
  *(uint4*)(w) = a0; *(uint4*)(w + 64 * 40) = a1; *(uint4*)(w + 5120) = b0; *(uint4*)(w + 5120 + 64 * 40) = b1;
  { const int k = (nk > 1 ? 32 : 0); a0 = *(const uint4*)(pA + k); a1 = *(const uint4*)(pA + k + sa); b0 = *(const uint4*)(pB + k); b1 = *(const uint4*)(pB + k + sb); }
  __syncthreads();
  for (int kt = 0; kt < nk; ++kt) {
    const u16* cA = lds + (kt & 1) * 10240;
    const u16* cB = cA + 5120;
    bf16x8 af[4], bfr[4];
#pragma unroll
    for (int m = 0; m < 4; ++m) af[m] = *(const bf16x8*)(cA + (wr * 64 + m * 16 + fr) * 40 + fq * 8);
#pragma unroll
    for (int n = 0; n < 4; ++n) bfr[n] = *(const bf16x8*)(cB + (wc * 64 + n * 16 + fr) * 40 + fq * 8);
    if (kt + 1 < nk) {
      u16* wn = w + ((kt + 1) & 1) * 10240;
      *(uint4*)(wn) = a0; *(uint4*)(wn + 64 * 40) = a1; *(uint4*)(wn + 5120) = b0; *(uint4*)(wn + 5120 + 64 * 40) = b1;
    }
    { const int k = (kt + 2 < nk ? kt + 2 : kt) * 32; a0 = *(const uint4*)(pA + k); a1 = *(const uint4*)(pA + k + sa); b0 = *(const uint4*)(pB + k); b1 = *(const uint4*)(pB + k + sb); }
#pragma unroll
    for (int m = 0; m < 4; ++m)
#pragma unroll
      for (int n = 0; n < 4; ++n)
        acc[m][n] = SWAP ? __builtin_amdgcn_mfma_f32_16x16x32_bf16(bfr[n], af[m], acc[m][n], 0, 0, 0)
                         : __builtin_amdgcn_mfma_f32_16x16x32_bf16(af[m], bfr[n], acc[m][n], 0, 0, 0);
    __syncthreads();
  }
}

template <bool SWAP, class Epi>
__device__ __forceinline__ void gemm_phase256(const GA& g, Epi epi, char* smem, int reps = 1) {
  u16* sA = (u16*)smem; u16* sB = sA + 256 * 72;
  const int nM = (g.M + 255) >> 8, nN = (g.N + 127) >> 7;
  const int G = gridDim.x, bq = bidx();
  const int bsw = (G & 7) == 0 ? (bq & 7) * (G >> 3) + (bq >> 3) : bq;
  for (int rep = 0; rep < reps; ++rep)
  for (int tile = bsw; tile < nM * nN; tile += G) {
    int m0 = (tile / nN) * 256, n0 = (tile % nN) * 128;
    f32x4 acc[8][4];
#pragma unroll
    for (int m = 0; m < 8; ++m)
#pragma unroll
      for (int n = 0; n < 4; ++n) acc[m][n] = (f32x4){0.f, 0.f, 0.f, 0.f};
    gemm_main1<SWAP, 8>(g, m0, n0, acc, sA, sB);
    gemm_epi<SWAP, 8>(m0, n0, acc, epi);
  }
}

template <bool SWAP, int MW = 4, class Epi>
__device__ __forceinline__ void gemm_epi(int m0, int n0, f32x4 (&acc)[MW][4], Epi epi) {
  const int lane = tidx() & 63, wid = tidx() >> 6, wr = wid >> 1, wc = wid & 1, fr = lane & 15, fq = lane >> 4;
#pragma unroll
  for (int m = 0; m < MW; ++m)
#pragma unroll
    for (int n = 0; n < 4; ++n) {
      int row, col;
      if (SWAP) { row = m0 + wr * (MW * 16) + m * 16 + fr; col = n0 + wc * 64 + n * 16 + fq * 4; }
      else { row = m0 + wr * (MW * 16) + m * 16 + fq * 4; col = n0 + wc * 64 + n * 16 + fr; }
      epi(row, col, acc[m][n]);
    }
}

template <bool SWAP, class Epi>
__device__ __forceinline__ void gemm_phase(const GA& g, Epi epi, char* smem, int reps = 1) {
  u16* sA = (u16*)smem; u16* sB = sA + 128 * 72;
  const int nM = (g.M + 127) >> 7, nN = (g.N + 127) >> 7;
  const int G = gridDim.x, bq = bidx();
  const int bsw = (G & 7) == 0 ? (bq & 7) * (G >> 3) + (bq >> 3) : bq;
  for (int rep = 0; rep < reps; ++rep)
  for (int tile = bsw; tile < nM * nN; tile += G) {
    int m0 = (tile / nN) * 128, n0 = (tile % nN) * 128;
    f32x4 acc[4][4];
#pragma unroll
    for (int m = 0; m < 4; ++m)
#pragma unroll
      for (int n = 0; n < 4; ++n) acc[m][n] = (f32x4){0.f, 0.f, 0.f, 0.f};
    gemm_main<SWAP, 4>(g, m0, n0, acc, sA, sB);
    gemm_epi<SWAP, 4>(m0, n0, acc, epi);
  }
}

__device__ void transpose_cvt(const float* W, int K, int N, u16* out, char* smem) {
  float* tile = (float*)smem;
  const int tk = (K + 63) / 64, tn = (N + 63) / 64;
  const int tx = tidx() & 63, ty = tidx() >> 6;
  for (int id = bidx(); id < tk * tn; id += gridDim.x) {
    int k0 = (id / tn) * 64, n0 = (id % tn) * 64;
    __syncthreads();
    for (int i = ty; i < 64; i += 4) {
      int k = k0 + i, n = n0 + tx;
      tile[i * 65 + tx] = (k < K && n < N) ? __builtin_nontemporal_load(W + (long)k * N + n) : 0.f;
    }
    __syncthreads();
    for (int i = ty; i < 64; i += 4) {
      int n = n0 + i, k = k0 + tx;
      if (n < N && k < K) out[(long)n * K + k] = f2bf(tile[tx * 65 + i]);
    }
  }
}

__device__ void prep_phase(const P& p, char* smem) {
  const int tid = tidx();
  const long gtid = (long)bidx() * 256 + tid, gsz = (long)gridDim.x * 256;
  {
    u16* H = (u16*)(p.ws + OFF_H);
    for (long i = gtid; i < (long)NT * 128; i += gsz) {
      int row = (int)(i >> 7), c8 = (int)(i & 127) * 8;
      int t, T; row_info(row, t, T);
      const float* src;
      if (t < 16) src = p.in[2] + t * 1024 + c8;
      else if (row < ROWS_P) { int s = row / TP; src = p.in[0] + ((long)s * 2048 + (t - 16)) * 1024 + c8; }
      else { int s = (row - ROWS_P) / TS; src = p.in[1] + ((long)s * 4096 + (t - 16)) * 1024 + c8; }
      f32x4 av4 = __builtin_nontemporal_load((const f32x4*)src), bv4 = __builtin_nontemporal_load((const f32x4*)(src + 4));
      float4 a = make_float4(av4[0], av4[1], av4[2], av4[3]), b = make_float4(bv4[0], bv4[1], bv4[2], bv4[3]);
      uint4 o = make_uint4(pack2(a.x, a.y), pack2(a.z, a.w), pack2(b.x, b.y), pack2(b.z, b.w));
      *(uint4*)(H + (long)row * 1024 + c8) = o;
    }
  }
  for (int which = 0; which < 2; ++which) {
    const int T = which ? TS : TP, Th = which ? THS : THP, Mh = T / 2 + 1;
    u16* A = (u16*)((char*)p.out + (which ? OD_DFTS : OD_DFTP));
    for (long i = gtid; i < (long)Mh * Th; i += gsz) {
      int tt = (int)(i / Th), k = (int)(i % Th);
      u16 c = 0, sn = 0;
      if (k < T) {
        int m = (int)(((long)tt * k) % T);
        float x = 2.f * (float)m / (float)T;
        c = f2bf(cospif(x)); sn = f2bf(sinpif(x));
      }
      A[(long)tt * 2 * Th + k] = c;
      A[(long)tt * 2 * Th + Th + k] = sn;
    }
  }
  for (int l = 0; l < 2; ++l) {
    char* wl = p.ws + (size_t)l * SZ_WL;
    transpose_cvt(p.in[4] + (size_t)l * 1024 * DIN, 1024, DIN, (u16*)(wl + OW_IN), smem);
    for (int k = 0; k < 4; ++k)
      transpose_cvt(p.in[20] + ((size_t)l * 4 + k) * 512 * 1024, 512, 1024, (u16*)(wl + OW_BR) + (size_t)k * 1024 * 512, smem);
    transpose_cvt(p.in[21] + (size_t)l * 1024 * 1024, 1024, 1024, (u16*)(wl + OW_OUT), smem);
    transpose_cvt(p.in[24] + (size_t)l * 1024 * 5632, 1024, 5632, (u16*)(wl + OW_UP), smem);
    transpose_cvt(p.in[25] + (size_t)l * 2816 * 1024, 2816, 1024, (u16*)(wl + OW_DOWN), smem);
  }
  {
    float* wt = (float*)smem;
    float* ct = wt + 64 * 129;
    for (int task = bidx(); task < 128; task += gridDim.x) {
      int l = task >> 6, kt = (task & 63) >> 2, g = task & 3;
      const float* win = p.in[4] + (size_t)l * 1024 * DIN;
      u16* Wfn = (u16*)(p.ws + (size_t)l * SZ_WL + OW_FN);
      __syncthreads();
      for (int idx = tid; idx < 64 * 128; idx += 256) {
        int kk = idx >> 7, j = idx & 127;
        wt[kk * 129 + j] = win[(size_t)(kt * 64 + kk) * DIN + g * 128 + j];
      }
      if (tid < 128) { ct[tid] = cospif(tid / 64.f); ct[128 + tid] = sinpif(tid / 64.f); }
      __syncthreads();
      int kk = tid & 63, grp = tid >> 6;
      for (int mm = grp; mm < 256; mm += 4) {
        int half = mm >> 7, m = mm & 127;
        float s = 0.f;
        for (int j = 0; j < 128; ++j) s += wt[kk * 129 + j] * ct[half * 128 + ((j * m) & 127)];
        Wfn[(size_t)(half * 512 + g * 128 + m) * 1024 + kt * 64 + kk] = f2bf(s);
      }
    }
  }
}

__device__ void rmsnorm_phase(const u16* H, const float* w, u16* HN, float* zbuf, long zn4) {
  const int lane = tidx() & 63;
  const int wave = (bidx() * 256 + tidx()) >> 6, nw = gridDim.x * 4;
  if (zbuf) {
    float4 z = make_float4(0.f, 0.f, 0.f, 0.f);
    for (long i = (long)bidx() * 256 + tidx(); i < zn4; i += (long)gridDim.x * 256) ((float4*)zbuf)[i] = z;
  }
  for (int row = wave; row < NT; row += nw) {
    const uint4* hp = (const uint4*)(H + (long)row * 1024);
    uint4 a = hp[lane], b = hp[64 + lane];
    unsigned ua[8] = {a.x, a.y, a.z, a.w, b.x, b.y, b.z, b.w};
    float x[16];
    float ss = 0.f;
#pragma unroll
    for (int i = 0; i < 8; ++i) { x[2 * i] = lo2f(ua[i]); x[2 * i + 1] = hi2f(ua[i]); ss += x[2 * i] * x[2 * i] + x[2 * i + 1] * x[2 * i + 1]; }
    ss = wave_sum(ss);
    float r = rsqrtf(ss * (1.f / 1024.f) + EPS);
    unsigned o[8];
#pragma unroll
    for (int i = 0; i < 8; ++i) {
      int c = (i < 4 ? lane * 8 : 512 + lane * 8) + (i & 3) * 2;
      o[i] = pack2(x[2 * i] * r * w[c], x[2 * i + 1] * r * w[c + 1]);
    }
    uint4* op = (uint4*)(HN + (long)row * 1024);
    op[lane] = make_uint4(o[0], o[1], o[2], o[3]);
    op[64 + lane] = make_uint4(o[4], o[5], o[6], o[7]);
  }
}

__device__ void final_phase(const P& p) {
  const u16* H = (const u16*)(p.ws + OFF_H);
  const float* w = p.in[26];
  const int lane = tidx() & 63;
  const int wave = (bidx() * 256 + tidx()) >> 6, nw = gridDim.x * 4;
  for (int row = wave; row < NT; row += nw) {
    int t, T; row_info(row, t, T);
    if (t < 16) continue;
    long orow;
    if (row < ROWS_P) orow = (long)(row / TP) * 2048 + (t - 16);
    else orow = 32l * 2048 + (long)((row - ROWS_P) / TS) * 4096 + (t - 16);
    const uint4* hp = (const uint4*)(H + (long)row * 1024);
    uint4 a = hp[lane], b = hp[64 + lane];
    unsigned ua[8] = {a.x, a.y, a.z, a.w, b.x, b.y, b.z, b.w};
    float x[16];
    float ss = 0.f;
#pragma unroll
    for (int i = 0; i < 8; ++i) { x[2 * i] = lo2f(ua[i]); x[2 * i + 1] = hi2f(ua[i]); ss += x[2 * i] * x[2 * i] + x[2 * i + 1] * x[2 * i + 1]; }
    ss = wave_sum(ss);
    float r = rsqrtf(ss * (1.f / 1024.f) + EPS);
    float* op = p.out + orow * 1024;
#pragma unroll
    for (int hgrp = 0; hgrp < 2; ++hgrp) {
      int c = hgrp * 512 + lane * 8;
      float4 o0, o1;
      o0.x = x[hgrp * 8 + 0] * r * w[c + 0]; o0.y = x[hgrp * 8 + 1] * r * w[c + 1];
      o0.z = x[hgrp * 8 + 2] * r * w[c + 2]; o0.w = x[hgrp * 8 + 3] * r * w[c + 3];
      o1.x = x[hgrp * 8 + 4] * r * w[c + 4]; o1.y = x[hgrp * 8 + 5] * r * w[c + 5];
      o1.z = x[hgrp * 8 + 6] * r * w[c + 6]; o1.w = x[hgrp * 8 + 7] * r * w[c + 7];
      __builtin_nontemporal_store((f32x4){o0.x, o0.y, o0.z, o0.w}, (f32x4*)(op + c));
      __builtin_nontemporal_store((f32x4){o1.x, o1.y, o1.z, o1.w}, (f32x4*)(op + c + 4));
    }
  }
}

__device__ __forceinline__ float conv3_at(const u16* PR, long row, int ld, int col, int t, int T, float w0, float w1, float w2) {
  float x1 = bf2f(PR[row * ld + col]);
  float x0 = (t > 0) ? bf2f(PR[(row - 1) * ld + col]) : 0.f;
  float x2 = (t < T - 1) ? bf2f(PR[(row + 1) * ld + col]) : 0.f;
  return w0 * x0 + w1 * x1 + w2 * x2;
}

__device__ void ssd_conv_phase(const P& p, int l) {
  const u16* PR = (const u16*)((char*)p.out + OD_PROJ);
  const float* cw = p.in[5] + l * 3 * 1024;
  const float* cb = p.in[6] + l * 1024;
  u16* XS = (u16*)(p.ws + OFF_BR + 1 * SZ_BR);
  u16* BC = (u16*)(p.ws + OFF_X2T);
  for (long i = (long)bidx() * 256 + tidx(); i < (long)NT * 128; i += (long)gridDim.x * 256) {
    int row = (int)(i >> 7), c8 = (int)(i & 127) * 8;
    int t, T; row_info(row, t, T);
    const u16* pr = PR + (long)row * 1552 + 512 + c8;
    uint4 z4 = make_uint4(0, 0, 0, 0);
    uint4 x1 = *(const uint4*)pr, x0 = z4, x2 = z4;
    if (t > 0) x0 = *(const uint4*)(pr - 1552);
    if (t < T - 1) x2 = *(const uint4*)(pr + 1552);
    unsigned a0[4] = {x0.x, x0.y, x0.z, x0.w}, a1[4] = {x1.x, x1.y, x1.z, x1.w}, a2[4] = {x2.x, x2.y, x2.z, x2.w};
    float w0[8], w1[8], w2[8], wb[8];
    ld8(cw + c8, w0); ld8(cw + 1024 + c8, w1); ld8(cw + 2048 + c8, w2); ld8(cb + c8, wb);
    unsigned o[4];
#pragma unroll
    for (int e = 0; e < 4; ++e) {
      float lo = siluf(w0[2 * e] * lo2f(a0[e]) + w1[2 * e] * lo2f(a1[e]) + w2[2 * e] * lo2f(a2[e]) + wb[2 * e]);
      float hi = siluf(w0[2 * e + 1] * hi2f(a0[e]) + w1[2 * e + 1] * hi2f(a1[e]) + w2[2 * e + 1] * hi2f(a2[e]) + wb[2 * e + 1]);
      o[e] = pack2(lo, hi);
    }
    u16* dst = c8 < 512 ? XS + (long)row * 512 + c8 : BC + (long)row * 512 + (c8 - 512);
    *(uint4*)dst = make_uint4(o[0], o[1], o[2], o[3]);
  }
}

__device__ void ssd_scan_phase(const P& p, int l, char* smem) {
  u16* Cn = (u16*)smem;
  u16* Bn = Cn + 32 * 136;
  u16* BT = Bn + 32 * 136;
  u16* XT = BT + 128 * 40;
  float* dts = (float*)(XT + 4 * 64 * 40);
  float* css = dts + 128;
  const u16* PR = (const u16*)((char*)p.out + OD_PROJ);
  const u16* XS = (const u16*)(p.ws + OFF_BR + 1 * SZ_BR);
  const u16* BC = (const u16*)(p.ws + OFF_X2T);
  const float* dtb = p.in[7] + l * 16;
  const float* alog = p.in[8] + l * 16;
  for (int task = bidx(); task < 384; task += gridDim.x) {
    const int tid = tidx(), lane = tid & 63, r = tid >> 6;
    const int fr = lane & 15, fq = lane >> 4;
    int seq, g, dir, seg;
    if (task < 128) { seq = 32 + (task >> 4); int rem = task & 15; g = rem >> 3; dir = (rem >> 2) & 1; seg = rem & 3; }
    else { int q = task - 128; seq = q >> 3; int rem = q & 7; g = rem >> 2; dir = (rem >> 1) & 1; seg = rem & 1; }
    int base = seq_base(seq), T = seq < 32 ? TP : TS;
    float csoff = 0.f;
    u16* Yd = (u16*)(p.ws + OFF_BR + (size_t)(2 + dir) * SZ_BR);
    f32x4 HT[8][4];
#pragma unroll
    for (int a = 0; a < 8; ++a)
#pragma unroll
      for (int b = 0; b < 4; ++b) HT[a][b] = (f32x4){0.f, 0.f, 0.f, 0.f};
    const int nch = (T + 31) >> 5;
    const int chb = seg * SEGC, che = (chb + SEGC < nch) ? chb + SEGC : nch;
    const int sv_v = tid & 63;
    const u16* colp = sv_v < 32 ? BC + (sv_v < 16 ? g * 128 + 8 * sv_v : 256 + g * 128 + 8 * (sv_v - 16)) : XS + g * 256 + 8 * (sv_v - 32);
    uint4 sv[4];
    u16 rawdt = 0;
#define SCAN_LOADN(i0, C0, NV, S0) _Pragma("unroll") for (int i = 0; i < (NV); ++i) { \
        const int tau = (C0) + r + 4 * ((i0) + i); const bool ok = tau < T; \
        const int tc = ok ? (dir ? T - 1 - tau : tau) : 0; \
        uint4 val = *(const uint4*)(colp + (long)(base + tc) * 512); \
        sv[(S0) + i].x = ok ? val.x : 0u; sv[(S0) + i].y = ok ? val.y : 0u; sv[(S0) + i].z = ok ? val.z : 0u; sv[(S0) + i].w = ok ? val.w : 0u; }
#define SCAN_LOADDT(C0) do { rawdt = 0; if (tid < 128) { int tau = (C0) + (tid & 31); if (tau < T) { int t = dir ? T - 1 - tau : tau; \
        rawdt = PR[(long)(base + t) * 1552 + 1536 + dir * 8 + g * 4 + (tid >> 5)]; } } } while (0)
#define SCAN_STORE(i0) _Pragma("unroll") for (int i = 0; i < 4; ++i) { \
        const int tl = r + 4 * ((i0) + i); const int v = sv_v; \
        uint4 val = sv[i]; unsigned w4[4] = {val.x, val.y, val.z, val.w}; \
        if (v < 16) { \
          *(uint4*)(Bn + tl * 136 + 8 * v) = val; \
          _Pragma("unroll") for (int e = 0; e < 4; ++e) { BT[(8 * v + 2 * e) * 40 + tl] = (u16)(w4[e] & 0xffffu); BT[(8 * v + 2 * e + 1) * 40 + tl] = (u16)(w4[e] >> 16); } \
        } else if (v < 32) { \
          *(uint4*)(Cn + tl * 136 + 8 * (v - 16)) = val; \
        } else { \
          int h = (v - 32) >> 3, p0 = ((v - 32) & 7) * 8; \
          float dt = dts[h * 32 + tl]; \
          _Pragma("unroll") for (int e = 0; e < 4; ++e) { \
            XT[(h * 64 + p0 + 2 * e) * 40 + tl] = f2bf(lo2f(w4[e]) * dt); \
            XT[(h * 64 + p0 + 2 * e + 1) * 40 + tl] = f2bf(hi2f(w4[e]) * dt); } } }
    SCAN_LOADDT(chb * 32);
    SCAN_LOADN(0, chb * 32, 2, 0)
    for (int ch = chb; ch < che; ++ch) {
      const int c0 = ch * 32;
      __syncthreads();
      if (tid < 128) {
        int h = tid >> 5, tl = tid & 31, tau = c0 + tl;
        int hi = dir * 8 + g * 4 + h;
        float dt = 0.f;
        if (tau < T) {
          float dr = bf2f(rawdt) + dtb[hi];
          dt = dr > 20.f ? dr : __logf(1.f + __expf(dr));
        }
        float v = -dt * __expf(alog[hi]);
#pragma unroll
        for (int o = 1; o < 32; o <<= 1) { float u = bperm(v, (lane - o) & 63); if (tl >= o) v += u; }
        dts[h * 32 + tl] = dt; css[h * 32 + tl] = v;
      }
      __syncthreads();
      SCAN_LOADN(2, c0, 2, 2)
      SCAN_STORE(0)
      SCAN_LOADN(4, c0, 4, 0)
      SCAN_STORE(4)
      __syncthreads();
      if (ch + 1 < che) { SCAN_LOADDT(c0 + 32); SCAN_LOADN(0, c0 + 32, 2, 0) }
      const float* cs = css + r * 32;
      const u16* xt = XT + r * 64 * 40;
      if (lane < 32) {
        int tau = c0 + lane;
        if (tau < T) { int t = dir ? T - 1 - tau : tau; ((float*)((char*)p.out + OD_CSG))[((long)(base + t) * 2 + dir) * 8 + g * 4 + r] = csoff + cs[lane]; }
      }
      f32x4 GT00 = (f32x4){0.f, 0.f, 0.f, 0.f}, GT01 = GT00, GT11 = GT00;
#pragma unroll
      for (int kk = 0; kk < 4; ++kk) {
        bf16x8 b0 = *(const bf16x8*)(Bn + (fr) * 136 + kk * 32 + fq * 8);
        bf16x8 b1 = *(const bf16x8*)(Bn + (16 + fr) * 136 + kk * 32 + fq * 8);
        bf16x8 c0v = *(const bf16x8*)(Cn + (fr) * 136 + kk * 32 + fq * 8);
        bf16x8 c1v = *(const bf16x8*)(Cn + (16 + fr) * 136 + kk * 32 + fq * 8);
        GT00 = __builtin_amdgcn_mfma_f32_16x16x32_bf16(b0, c0v, GT00, 0, 0, 0);
        GT01 = __builtin_amdgcn_mfma_f32_16x16x32_bf16(b0, c1v, GT01, 0, 0, 0);
        GT11 = __builtin_amdgcn_mfma_f32_16x16x32_bf16(b1, c1v, GT11, 0, 0, 0);
      }
      const float csl0 = cs[fr], csl1 = cs[16 + fr];
      float m00[4], m01[4], m11[4];
#pragma unroll
      for (int j = 0; j < 4; ++j) {
        int s0 = 4 * fq + j;
        float css0 = cs[s0], css1 = cs[16 + s0];
        m00[j] = (s0 <= fr) ? GT00[j] * __expf(csl0 - css0) : 0.f;
        m01[j] = GT01[j] * __expf(csl1 - css0);
        m11[j] = (s0 <= fr) ? GT11[j] * __expf(csl1 - css1) : 0.f;
      }
      union { bf16x8 v; unsigned u[4]; } A0, A1;
      A0.u[0] = pack2(m00[0], m00[1]); A0.u[1] = pack2(m00[2], m00[3]); A0.u[2] = 0u; A0.u[3] = 0u;
      A1.u[0] = pack2(m01[0], m01[1]); A1.u[1] = pack2(m01[2], m01[3]); A1.u[2] = pack2(m11[0], m11[1]); A1.u[3] = pack2(m11[2], m11[3]);
      f32x4 Y[2][4];
#pragma unroll
      for (int tp = 0; tp < 4; ++tp) {
        union { bf16x8 v; uint2 h[2]; } xb;
        xb.h[0] = *(const uint2*)(xt + (tp * 16 + fr) * 40 + 4 * fq);
        xb.h[1] = *(const uint2*)(xt + (tp * 16 + fr) * 40 + 16 + 4 * fq);
        f32x4 z = (f32x4){0.f, 0.f, 0.f, 0.f};
        Y[0][tp] = __builtin_amdgcn_mfma_f32_16x16x32_bf16(A0.v, xb.v, z, 0, 0, 0);
        Y[1][tp] = __builtin_amdgcn_mfma_f32_16x16x32_bf16(A1.v, xb.v, z, 0, 0, 0);
      }
      const float e0 = __expf(csl0), e1 = __expf(csl1);
#pragma unroll
      for (int u = 0; u < 4; ++u) {
        union { bf16x8 v; uint2 h[2]; unsigned w[4]; } ca, cbv;
        ca.h[0] = *(const uint2*)(Cn + (fr) * 136 + 32 * u + 4 * fq);
        ca.h[1] = *(const uint2*)(Cn + (fr) * 136 + 32 * u + 16 + 4 * fq);
        cbv.h[0] = *(const uint2*)(Cn + (16 + fr) * 136 + 32 * u + 4 * fq);
        cbv.h[1] = *(const uint2*)(Cn + (16 + fr) * 136 + 32 * u + 16 + 4 * fq);
#pragma unroll
        for (int e = 0; e < 4; ++e) {
          ca.w[e] = pack2(lo2f(ca.w[e]) * e0, hi2f(ca.w[e]) * e0);
          cbv.w[e] = pack2(lo2f(cbv.w[e]) * e1, hi2f(cbv.w[e]) * e1);
        }
#pragma unroll
        for (int tp = 0; tp < 4; ++tp) {
          union { bf16x8 v; unsigned w[4]; } hb;
          hb.w[0] = pack2(HT[2 * u][tp][0], HT[2 * u][tp][1]); hb.w[1] = pack2(HT[2 * u][tp][2], HT[2 * u][tp][3]);
          hb.w[2] = pack2(HT[2 * u + 1][tp][0], HT[2 * u + 1][tp][1]); hb.w[3] = pack2(HT[2 * u + 1][tp][2], HT[2 * u + 1][tp][3]);
          Y[0][tp] = __builtin_amdgcn_mfma_f32_16x16x32_bf16(ca.v, hb.v, Y[0][tp], 0, 0, 0);
          Y[1][tp] = __builtin_amdgcn_mfma_f32_16x16x32_bf16(cbv.v, hb.v, Y[1][tp], 0, 0, 0);
        }
      }
#pragma unroll
      for (int tl = 0; tl < 2; ++tl)
#pragma unroll
        for (int j = 0; j < 4; ++j) {
          int tau = c0 + tl * 16 + 4 * fq + j;
          if (tau < T) {
            int t = dir ? T - 1 - tau : tau;
            u16* yp = Yd + (long)(base + t) * 512 + g * 256 + r * 64 + fr;
#pragma unroll
            for (int tp = 0; tp < 4; ++tp) yp[tp * 16] = f2bf(Y[tl][tp][j]);
          }
        }
      const float csL = cs[31];
      const float eL = __expf(csL);
      float w8[8];
#pragma unroll
      for (int jj = 0; jj < 8; ++jj) w8[jj] = __expf(csL - cs[8 * fq + jj]);
      bf16x8 xs4[4];
#pragma unroll
      for (int tp = 0; tp < 4; ++tp) {
        union { bf16x8 v; unsigned w[4]; } xx;
        xx.v = *(const bf16x8*)(xt + (tp * 16 + fr) * 40 + 8 * fq);
#pragma unroll
        for (int e = 0; e < 4; ++e) xx.w[e] = pack2(lo2f(xx.w[e]) * w8[2 * e], hi2f(xx.w[e]) * w8[2 * e + 1]);
        xs4[tp] = xx.v;
      }
#pragma unroll
      for (int tn = 0; tn < 8; ++tn) {
        bf16x8 bt = *(const bf16x8*)(BT + (tn * 16 + fr) * 40 + 8 * fq);
#pragma unroll
        for (int tp = 0; tp < 4; ++tp) {
          f32x4 hv = HT[tn][tp];
          hv[0] *= eL; hv[1] *= eL; hv[2] *= eL; hv[3] *= eL;
          HT[tn][tp] = __builtin_amdgcn_mfma_f32_16x16x32_bf16(bt, xs4[tp], hv, 0, 0, 0);
        }
      }
      csoff += csL;
    }
#undef SCAN_LOADN
#undef SCAN_LOADDT
#undef SCAN_STORE
    if (seg < (seq < 32 ? 1 : 3)) {
      const int sslot = seq < 32 ? seq : 32 + (seq - 32) * 3 + seg;
      const long sl = (long)((g * 2 + dir) * 56 + sslot) * 4 + r;
      f32x4* hs = (f32x4*)((float*)((char*)p.out + OD_HS) + sl * 8192);
#pragma unroll
      for (int tn = 0; tn < 8; ++tn)
#pragma unroll
        for (int tp = 0; tp < 4; ++tp) hs[(tn * 4 + tp) * 64 + lane] = HT[tn][tp];
      if (lane == 0) ((float*)((char*)p.out + OD_DS))[sl] = __expf(csoff);
    }
  }
}

__device__ void ssd_state_phase(const P& p) {
  float* HS = (float*)((char*)p.out + OD_HS);
  const float* DS = (const float*)((char*)p.out + OD_DS);
  for (long i = (long)bidx() * 256 + tidx(); i < 128l * 2048; i += (long)gridDim.x * 256) {
    int chain = (int)(i >> 11), e = (int)(i & 2047);
    int gd = chain >> 5, sq = (chain >> 2) & 7, h = chain & 3;
    long sl0 = (long)(gd * 56 + 32 + sq * 3) * 4 + h;
    float4 a = ((const float4*)(HS + sl0 * 8192))[e];
    float4 b = ((const float4*)(HS + (sl0 + 4) * 8192))[e];
    float d1 = DS[sl0 + 4];
    b.x += d1 * a.x; b.y += d1 * a.y; b.z += d1 * a.z; b.w += d1 * a.w;
    ((float4*)(HS + (sl0 + 4) * 8192))[e] = b;
    float4 c = ((const float4*)(HS + (sl0 + 8) * 8192))[e];
    float d2 = DS[sl0 + 8];
    c.x += d2 * b.x; c.y += d2 * b.y; c.z += d2 * b.z; c.w += d2 * b.w;
    ((float4*)(HS + (sl0 + 8) * 8192))[e] = c;
  }
}

__device__ void ssd_fix_phase(const P& p) {
  const float* HS = (const float*)((char*)p.out + OD_HS);
  const float* CSG = (const float*)((char*)p.out + OD_CSG);
  const u16* BC = (const u16*)(p.ws + OFF_X2T);
  const int tid = tidx(), lane = tid & 63, r = tid >> 6;
  const int fr = lane & 15, fq = lane >> 4;
  for (int task = bidx(); task < 7168; task += gridDim.x) {
    int seq, gd, ch;
    if (task < 3072) { seq = 32 + task / 384; int rem = task % 384; gd = rem / 96; ch = SEGC + rem % 96; }
    else { int q = task - 3072; seq = q >> 7; int rem = q & 127; gd = rem >> 5; ch = SEGC + (rem & 31); }
    const int g = gd >> 1, dir = gd & 1;
    const int base = seq_base(seq), T = seq < 32 ? TP : TS;
    const int seg = ch / SEGC;
    const int sslot = seq < 32 ? seq : 32 + (seq - 32) * 3 + (seg - 1);
    const f32x4* hs = (const f32x4*)(HS + ((long)(gd * 56 + sslot) * 4 + r) * 8192);
    u16* Yd = (u16*)(p.ws + OFF_BR + (size_t)(2 + dir) * SZ_BR);
    const int c0 = ch * 32;
    const int tau0 = c0 + fr, tau1 = c0 + 16 + fr;
    const bool ok0 = tau0 < T, ok1 = tau1 < T;
    const int t0r = ok0 ? (dir ? T - 1 - tau0 : tau0) : 0, t1r = ok1 ? (dir ? T - 1 - tau1 : tau1) : 0;
    const float e0 = ok0 ? __expf(CSG[((long)(base + t0r) * 2 + dir) * 8 + g * 4 + r]) : 0.f;
    const float e1 = ok1 ? __expf(CSG[((long)(base + t1r) * 2 + dir) * 8 + g * 4 + r]) : 0.f;
    const u16* c0p = BC + (long)(base + t0r) * 512 + 256 + g * 128;
    const u16* c1p = BC + (long)(base + t1r) * 512 + 256 + g * 128;
    f32x4 Y[2][4];
#pragma unroll
    for (int a = 0; a < 2; ++a)
#pragma unroll
      for (int b = 0; b < 4; ++b) Y[a][b] = (f32x4){0.f, 0.f, 0.f, 0.f};
#pragma unroll
    for (int u = 0; u < 4; ++u) {
      union { bf16x8 v; uint2 h[2]; unsigned w[4]; } ca, cbv;
      ca.h[0] = *(const uint2*)(c0p + 32 * u + 4 * fq);
      ca.h[1] = *(const uint2*)(c0p + 32 * u + 16 + 4 * fq);
      cbv.h[0] = *(const uint2*)(c1p + 32 * u + 4 * fq);
      cbv.h[1] = *(const uint2*)(c1p + 32 * u + 16 + 4 * fq);
#pragma unroll
      for (int e = 0; e < 4; ++e) {
        ca.w[e] = pack2(lo2f(ca.w[e]) * e0, hi2f(ca.w[e]) * e0);
        cbv.w[e] = pack2(lo2f(cbv.w[e]) * e1, hi2f(cbv.w[e]) * e1);
      }
#pragma unroll
      for (int tp = 0; tp < 4; ++tp) {
        f32x4 ha = hs[((2 * u) * 4 + tp) * 64 + lane], hb2 = hs[((2 * u + 1) * 4 + tp) * 64 + lane];
        union { bf16x8 v; unsigned w[4]; } hb;
        hb.w[0] = pack2(ha[0], ha[1]); hb.w[1] = pack2(ha[2], ha[3]);
        hb.w[2] = pack2(hb2[0], hb2[1]); hb.w[3] = pack2(hb2[2], hb2[3]);
        Y[0][tp] = __builtin_amdgcn_mfma_f32_16x16x32_bf16(ca.v, hb.v, Y[0][tp], 0, 0, 0);
        Y[1][tp] = __builtin_amdgcn_mfma_f32_16x16x32_bf16(cbv.v, hb.v, Y[1][tp], 0, 0, 0);
      }
    }
#pragma unroll
    for (int tl = 0; tl < 2; ++tl)
#pragma unroll
      for (int j = 0; j < 4; ++j) {
        int tau = c0 + tl * 16 + 4 * fq + j;
        if (tau < T) {
          int t = dir ? T - 1 - tau : tau;
          u16* yp = Yd + (long)(base + t) * 512 + g * 256 + r * 64 + fr;
#pragma unroll
          for (int tp = 0; tp < 4; ++tp) yp[tp * 16] = f2bf(bf2f(yp[tp * 16]) + Y[tl][tp][j]);
        }
      }
  }
}

__device__ void ssd_post_phase(const P& p, int l) {
  const u16* PR = (const u16*)((char*)p.out + OD_PROJ);
  const float* dsk = p.in[9] + l * 8;
  const float* nw = p.in[10] + l * 512;
  const u16* Yf = (const u16*)(p.ws + OFF_BR + 2 * SZ_BR);
  const u16* Yb = (const u16*)(p.ws + OFF_BR + 3 * SZ_BR);
  u16* BR1 = (u16*)(p.ws + OFF_BR + 1 * SZ_BR);
  const int lane = tidx() & 63;
  const int wave = (bidx() * 256 + tidx()) >> 6, nwv = gridDim.x * 4;
  const float4 nw0 = *(const float4*)(nw + lane * 8), nw1 = *(const float4*)(nw + lane * 8 + 4);
  const float nwv8[8] = {nw0.x, nw0.y, nw0.z, nw0.w, nw1.x, nw1.y, nw1.z, nw1.w};
  const float dk = dsk[lane >> 3];
  for (int row = wave; row < NT; row += nwv) {
    uint4 xs4 = *(const uint4*)(BR1 + (long)row * 512 + lane * 8);
    uint4 yf4 = *(const uint4*)(Yf + (long)row * 512 + lane * 8);
    uint4 yb4 = *(const uint4*)(Yb + (long)row * 512 + lane * 8);
    uint4 z4 = *(const uint4*)(PR + (long)row * 1552 + lane * 8);
    unsigned xa[4] = {xs4.x, xs4.y, xs4.z, xs4.w}, fa[4] = {yf4.x, yf4.y, yf4.z, yf4.w};
    unsigned ba[4] = {yb4.x, yb4.y, yb4.z, yb4.w}, za[4] = {z4.x, z4.y, z4.z, z4.w};
    float v[8];
    float ss = 0.f;
#pragma unroll
    for (int e = 0; e < 4; ++e) {
      float y0 = (lo2f(fa[e]) + lo2f(ba[e]) + lo2f(xa[e]) * dk) * siluf(lo2f(za[e]));
      float y1 = (hi2f(fa[e]) + hi2f(ba[e]) + hi2f(xa[e]) * dk) * siluf(hi2f(za[e]));
      v[2 * e] = y0; v[2 * e + 1] = y1; ss += y0 * y0 + y1 * y1;
    }
#pragma unroll
    for (int o = 16; o > 0; o >>= 1) ss += bperm(ss, lane ^ o);
    float rr = rsqrtf(ss * (1.f / 256.f) + EPS);
    unsigned o4[4];
#pragma unroll
    for (int e = 0; e < 4; ++e) o4[e] = pack2(v[2 * e] * rr * nwv8[2 * e], v[2 * e + 1] * rr * nwv8[2 * e + 1]);
    *(uint4*)(BR1 + (long)row * 512 + lane * 8) = make_uint4(o4[0], o4[1], o4[2], o4[3]);
  }
}

__device__ void hyena_hid_phase(const P& p, int l) {
  const float* w1 = p.in[12] + l * 33 * 64;
  const float* b1 = p.in[13] + l * 64;
  const float* w2 = p.in[14] + l * 64 * 64;
  const float* b2 = p.in[15] + l * 64;
  const float* fq = p.in[17] + l * 64;
  float* HID = (float*)(p.ws + OFF_HID);
  const int lane = tidx() & 63;
  const int wave = (bidx() * 256 + tidx()) >> 6, nwv = gridDim.x * 4;
  for (int item = wave; item < TP + TS; item += nwv) {
    int T = item < TP ? TP : TS;
    int lag = item < TP ? item : item - TP;
    float tt = (float)lag / (float)(T - 1);
    float wv = (float)(2.0 * 3.14159265358979323846 / (double)T) * (float)lag;
    float z = 0.f;
    if (lane == 0) z = tt;
    else if (lane < 33) {
      int i = (lane - 1) & 15;
      float fr = 1e-4f + (float)i * ((15.f - 1e-4f) / 15.f);
      z = lane < 17 ? cosf(fr * wv) : -sinf(fr * wv);
    }
    float s = b1[lane];
    for (int e = 0; e < 33; ++e) s += bperm(z, e) * w1[e * 64 + lane];
    float h1 = sinf(fq[lane] * s);
    float s2 = b2[lane];
    for (int i = 0; i < 64; ++i) s2 += bperm(h1, i) * w2[i * 64 + lane];
    HID[(long)item * 64 + lane] = sinf(fq[lane] * s2);
  }
}

__device__ __forceinline__ void hyena_kf_phase(const P& p, int l, int first_block, int nblocks) {
  const float* w3 = p.in[16] + (size_t)l * 64 * 2048;
  const float* HID = (const float*)(p.ws + OFF_HID);
  u16* KF = (u16*)(p.ws + OFF_KF);
  float* L1 = (float*)(p.ws + OFF_L1);
  const int lane = tidx() & 63;
  const int bl = bidx() - first_block;
  const int wave = bl * 4 + (tidx() >> 6), nwv = nblocks * 4;
  for (int it2 = (bl < 0 ? 2048 : wave); it2 < 2048; it2 += nwv) {
    const int item = it2 < 1024 ? 1024 + it2 : it2 - 1024;
    int ti = item >> 10, o = (item >> 9) & 1, c = item & 511;
    int T = ti ? TS : TP;
    const float* hid = HID + (ti ? (long)TP * 64 : 0);
    u16* kf = KF + (ti ? 2l * 512 * 4128 : 0) + (long)(o * 512 + c) * 2 * T;
    float delta = fabsf(-3.0701134573253943f + (float)c * ((-15.350567286626972f + 3.0701134573253943f) / 511.f));
    float asum = 0.f;
    {
      const int col0 = (o * 2) * 512 + c, col1 = col0 + 512;
      float wc0[64], wc1[64];
#pragma unroll
      for (int j = 0; j < 64; ++j) { wc0[j] = w3[j * 2048 + col0]; wc1[j] = w3[j * 2048 + col1]; }
      for (int lb = 0; lb < T; lb += 64) {
        int lag = lb + lane;
        if (lag < T) {
          const float4* hp = (const float4*)(hid + (long)lag * 64);
          float s0 = 0.f, s1 = 0.f;
#pragma unroll
          for (int j4 = 0; j4 < 16; ++j4) {
            float4 hv = hp[j4];
            s0 += hv.x * wc0[j4 * 4] + hv.y * wc0[j4 * 4 + 1] + hv.z * wc0[j4 * 4 + 2] + hv.w * wc0[j4 * 4 + 3];
            s1 += hv.x * wc1[j4 * 4] + hv.y * wc1[j4 * 4 + 1] + hv.z * wc1[j4 * 4 + 2] + hv.w * wc1[j4 * 4 + 3];
          }
          float tt = (float)lag / (float)(T - 1);
          float dec = __expf(-tt * delta);
          float v0 = s0 * dec, v1 = s1 * dec;
          asum += fabsf(v0); kf[T + lag] = f2bf(v0);
          if (lag > 0) { asum += fabsf(v1); kf[T - lag] = f2bf(v1); }
        }
      }
    }
    if (lane == 0) kf[0] = 0;
    asum = wave_sum(asum);
    if (lane == 0) L1[item] = asum;
  }
}

__device__ void hyena_prep_phase(const P& p, int l, char* smem) {
  const u16* PR = (const u16*)((char*)p.out + OD_PROJ);
  const float* cw = p.in[11] + l * 3 * 1536;
  u16* tile = (u16*)smem;
  const int tid = tidx();
  const int ntile = (NT / 64) * 8;
  for (int id = bidx(); id < ntile * 3; id += gridDim.x) {
    int part = id / ntile, rem = id % ntile;
    int r0 = (rem >> 3) * 64, c0 = (rem & 7) * 64;
    __syncthreads();
#pragma unroll
    for (int i = 0; i < 2; ++i) {
      int item = tid + 256 * i;
      int rl = item >> 3, cv = (item & 7) * 8;
      int row = r0 + rl; int t, T; row_info(row, t, T);
      int col = part * 512 + c0 + cv;
      const u16* pr = PR + (long)row * 1536 + col;
      uint4 z4 = make_uint4(0, 0, 0, 0);
      uint4 x1 = *(const uint4*)pr, x0 = z4, x2 = z4;
      if (t > 0) x0 = *(const uint4*)(pr - 1536);
      if (t < T - 1) x2 = *(const uint4*)(pr + 1536);
      float4 wa0 = *(const float4*)(cw + col), wa1 = *(const float4*)(cw + col + 4);
      float4 wb0 = *(const float4*)(cw + 1536 + col), wb1 = *(const float4*)(cw + 1536 + col + 4);
      float4 wc0 = *(const float4*)(cw + 3072 + col), wc1 = *(const float4*)(cw + 3072 + col + 4);
      float w0[8] = {wa0.x, wa0.y, wa0.z, wa0.w, wa1.x, wa1.y, wa1.z, wa1.w};
      float w1[8] = {wb0.x, wb0.y, wb0.z, wb0.w, wb1.x, wb1.y, wb1.z, wb1.w};
      float w2[8] = {wc0.x, wc0.y, wc0.z, wc0.w, wc1.x, wc1.y, wc1.z, wc1.w};
      unsigned a0[4] = {x0.x, x0.y, x0.z, x0.w}, a1[4] = {x1.x, x1.y, x1.z, x1.w}, a2[4] = {x2.x, x2.y, x2.z, x2.w};
#pragma unroll
      for (int e = 0; e < 4; ++e) {
        tile[(cv + 2 * e) * 72 + rl] = f2bf(w0[2 * e] * lo2f(a0[e]) + w1[2 * e] * lo2f(a1[e]) + w2[2 * e] * lo2f(a2[e]));
        tile[(cv + 2 * e + 1) * 72 + rl] = f2bf(w0[2 * e + 1] * hi2f(a0[e]) + w1[2 * e + 1] * hi2f(a1[e]) + w2[2 * e + 1] * hi2f(a2[e]));
      }
    }
    __syncthreads();
    u16* o = (u16*)(p.ws + (part == 0 ? OFF_BR + 2 * SZ_BR : (part == 1 ? OFF_BR + 3 * SZ_BR : OFF_X2T)));
#pragma unroll
    for (int i = 0; i < 2; ++i) {
      int item = tid + 256 * i;
      int cl = item >> 3, tv = (item & 7) * 8;
      *(uint4*)(o + (long)(c0 + cl) * NT + r0 + tv) = *(const uint4*)(tile + cl * 72 + tv);
    }
  }
}

template <bool SAMPLE, int ORD>
__device__ __forceinline__ void longconv_task(const P& p, int l, int c, u16* smem16) {
  constexpr int T = SAMPLE ? TS : TP;
  constexpr int W = SAMPLE ? 256 : 128;
  constexpr int NSTRIP = 17;
  constexpr int DMAX = W;
  constexpr int NEW = SAMPLE ? 1 : 2;
  constexpr int NHF = SAMPLE ? 1 : 2;
  constexpr int NB = SAMPLE ? 18 : 9;
  constexpr int PADL = 320;
  constexpr int LK = SAMPLE ? 8832 : 4672;
  constexpr int TW = SAMPLE ? 32 : 16;
  constexpr int R = SAMPLE ? 8 : 16;
  constexpr int LS = 280;
  constexpr int NV = R * 34;
  constexpr int NLD = (NV + 255) / 256;
  u16* kl = smem16;
  u16* ub = smem16 + 2 * 8832;
  const int tid = tidx(), lane = tid & 63, wave = tid >> 6;
  const u16* KF = (const u16*)(p.ws + OFF_KF) + (SAMPLE ? 2l * 512 * 4128 : 0) + (long)(ORD * 512 + c) * 2 * T;
  __syncthreads();
  for (int v = tid; v < LK / 8; v += 256) {
    int idx = v * 8 - PADL;
    uint4 val = (idx >= 0 && idx <= 2 * T - 8) ? *(const uint4*)(KF + idx) : make_uint4(0, 0, 0, 0);
    *(uint4*)(kl + v * 8) = val;
    unsigned prev = (idx - 1 >= 0 && idx - 1 <= 2 * T - 1) ? (unsigned)KF[idx - 1] : 0u;
    uint4 sh;
    sh.x = (val.x << 16) | prev; sh.y = (val.y << 16) | (val.x >> 16); sh.z = (val.z << 16) | (val.y >> 16); sh.w = (val.w << 16) | (val.z >> 16);
    *(uint4*)(kl + LK + v * 8) = sh;
  }
  const unsigned klw = (unsigned)(size_t)(__attribute__((address_space(3))) u16*)(kl + ((lane & 1) ? 0 : LK + 2));
  const u16* U = (ORD == 0 ? (const u16*)(p.ws + OFF_BR + 2 * SZ_BR) : (const u16*)((char*)p.out + OD_PROJ)) + (long)c * NT;
  const u16* X = (ORD == 0 ? (const u16*)(p.ws + OFF_BR + 3 * SZ_BR) : (const u16*)(p.ws + OFF_X2T)) + (long)c * NT;
  const float invl1 = 1.f / ((const float*)(p.ws + OFF_L1))[(SAMPLE ? 1024 : 0) + ORD * 512 + c];
  const float bias = p.in[18][(l * 2 + ORD) * 512 + c];
  const int n = lane & 15, g = lane >> 4;
  const int toff = SAMPLE ? 16 * (n >> 3) : 0;
  const int lrow = SAMPLE ? (n & 7) : n;
  const int lane_s = toff + 8 * g;
  const bf16x8 zero8 = (bf16x8){0, 0, 0, 0, 0, 0, 0, 0};
  int srow[NLD], scol[NLD];
#pragma unroll
  for (int i = 0; i < NLD; ++i) { int v = tid + 256 * i; srow[i] = v / 34; scol[i] = (v - srow[i] * 34) * 8; }
  for (int hf = 0; hf < NHF; ++hf) {
    const int rowbase_blk = SAMPLE ? ROWS_P : hf * 16 * TP;
    for (int rnd = 0; rnd < 5; ++rnd) {
      const int strip = rnd * 4 + wave;
      const bool active = strip < NSTRIP;
      const int t0 = strip * W;
      f32x4 acc[8];
      bf16x8 ring[8];
#pragma unroll
      for (int q = 0; q < 8; ++q) { acc[q] = (f32x4){0.f, 0.f, 0.f, 0.f}; ring[q] = zero8; }
      uint4 st[NLD];
#pragma unroll
      for (int i = 0; i < NLD; ++i) {
        int s = -32 + scol[i];
        bool ok = (tid + 256 * i < NV) && s >= 0 && s <= T - 8;
        st[i] = ok ? *(const uint4*)(U + rowbase_blk + srow[i] * T + s) : make_uint4(0, 0, 0, 0);
      }
      __syncthreads();
#pragma unroll
      for (int i = 0; i < NLD; ++i) if (tid + 256 * i < NV) *(uint4*)(ub + srow[i] * LS + scol[i]) = st[i];
      __syncthreads();
      unsigned x0 = 0, x1 = 0, x2 = 0, x3 = 0;
      if (active) {
        const int li0 = t0 + DMAX + n - 8 * g + T + PADL;
        const unsigned ad = klw + (((li0 - 7) >> 1) << 2);
        asm volatile("ds_read_b32 %0, %4 offset:12\n\tds_read_b32 %1, %4 offset:8\n\tds_read_b32 %2, %4 offset:4\n\tds_read_b32 %3, %4"
                     : "=&v"(x0), "=&v"(x1), "=&v"(x2), "=&v"(x3) : "v"(ad));
      }
      for (int ib = 0; ib < NB; ++ib) {
        const u16* cur = ub + (ib & 1) * (R * LS);
        if (ib + 1 < NB) {
#pragma unroll
          for (int i = 0; i < NLD; ++i) {
            int s = 256 * (ib + 1) - 32 + scol[i];
            bool ok = (tid + 256 * i < NV) && s >= 0 && s <= T - 8;
            st[i] = ok ? *(const uint4*)(U + rowbase_blk + srow[i] * T + s) : make_uint4(0, 0, 0, 0);
          }
        }
        if (active) {
#pragma unroll
          for (int u = 0; u < 8; ++u) {
            const int it = ib * 8 + u;
#pragma unroll
            for (int j = 0; j < NEW; ++j)
              ring[(8 - NEW + j + NEW * u) & 7] = *(const bf16x8*)(cur + lrow * LS + 16 * j + 32 * u + lane_s);
            asm volatile("s_waitcnt lgkmcnt(0)" : "+v"(x0), "+v"(x1), "+v"(x2), "+v"(x3));
            union { bf16x8 v; unsigned w[4]; } avu;
            avu.w[0] = (x0 >> 16) | (x0 << 16); avu.w[1] = (x1 >> 16) | (x1 << 16);
            avu.w[2] = (x2 >> 16) | (x2 << 16); avu.w[3] = (x3 >> 16) | (x3 << 16);
            const bf16x8 av = avu.v;
            {
              const int li0 = t0 + DMAX - 32 * (it + 1) + n - 8 * g + T + PADL;
              const unsigned ad = klw + (((li0 - 7) >> 1) << 2);
              asm volatile("ds_read_b32 %0, %4 offset:12\n\tds_read_b32 %1, %4 offset:8\n\tds_read_b32 %2, %4 offset:4\n\tds_read_b32 %3, %4"
                           : "=&v"(x0), "=&v"(x1), "=&v"(x2), "=&v"(x3) : "v"(ad));
            }
#pragma unroll
            for (int q = 0; q < 8; ++q)
              acc[q] = __builtin_amdgcn_mfma_f32_16x16x32_bf16(av, ring[(q + NEW * u) & 7], acc[q], 0, 0, 0);
          }
        }
        if (ib + 1 < NB) {
          u16* nb = ub + ((ib + 1) & 1) * (R * LS);
#pragma unroll
          for (int i = 0; i < NLD; ++i) if (tid + 256 * i < NV) *(uint4*)(nb + srow[i] * LS + scol[i]) = st[i];
        }
        __syncthreads();
      }
      if (active) {
#pragma unroll
        for (int q = 0; q < 8; ++q) {
          const int t = t0 + TW * q + toff + 4 * g;
          const int rb = rowbase_blk + lrow * T;
          if (t < T) {
            uint2 uu = *(const uint2*)(U + rb + t);
            uint2 xx = *(const uint2*)(X + rb + t);
            float uv[4] = {lo2f(uu.x), hi2f(uu.x), lo2f(uu.y), hi2f(uu.y)};
            float xv[4] = {lo2f(xx.x), hi2f(xx.x), lo2f(xx.y), hi2f(xx.y)};
            float zv[4];
#pragma unroll
            for (int j = 0; j < 4; ++j) zv[j] = xv[j] * (acc[q][j] * invl1 + uv[j] * bias);
            u16* Z = (ORD == 0 ? (u16*)((char*)p.out + OD_PROJ) : (u16*)(p.ws + OFF_BR + 3 * SZ_BR)) + (long)c * NT;
            *(uint2*)(Z + rb + t) = make_uint2(pack2(zv[0], zv[1]), pack2(zv[2], zv[3]));
          }
        }
      }
    }
  }
}

template <int ORD>
__device__ void longconv_phase(const P& p, int l, char* smem) {
  u16* kl = (u16*)smem;
  for (int task = bidx(); task < 1024; task += gridDim.x) {
    int c = task & 511;
    if (task >= 512) longconv_task<true, ORD>(p, l, c, kl);
    else longconv_task<false, ORD>(p, l, c, kl);
  }
}

__device__ void hyena_tr_phase(const P& p, char* smem) {
  const u16* ZT = (const u16*)(p.ws + OFF_BR + 3 * SZ_BR);
  u16* BR2 = (u16*)(p.ws + OFF_BR + 2 * SZ_BR);
  u16* tile = (u16*)smem;
  const int tid = tidx();
  const int ntile = (NT / 64) * 8;
  for (int id = bidx(); id < ntile; id += gridDim.x) {
    int r0 = (id >> 3) * 64, c0 = (id & 7) * 64;
    __syncthreads();
#pragma unroll
    for (int i = 0; i < 2; ++i) {
      int item = tid + 256 * i;
      int cl = item >> 3, tv = (item & 7) * 8;
      uint4 v = *(const uint4*)(ZT + (long)(c0 + cl) * NT + r0 + tv);
      unsigned w4[4] = {v.x, v.y, v.z, v.w};
#pragma unroll
      for (int e = 0; e < 4; ++e) { tile[(tv + 2 * e) * 72 + cl] = (u16)(w4[e] & 0xffffu); tile[(tv + 2 * e + 1) * 72 + cl] = (u16)(w4[e] >> 16); }
    }
    __syncthreads();
#pragma unroll
    for (int i = 0; i < 2; ++i) {
      int item = tid + 256 * i;
      int rl = item >> 3, cv = (item & 7) * 8;
      *(uint4*)(BR2 + (long)(r0 + rl) * 512 + c0 + cv) = *(const uint4*)(tile + rl * 72 + cv);
    }
  }
}

__device__ void sc_phase(const P& p, int l) {
  const u16* PR = (const u16*)((char*)p.out + OD_PROJ);
  const float* cw = p.in[19] + l * 3 * 512;
  u16* BR3 = (u16*)(p.ws + OFF_BR + 3 * SZ_BR);
  for (long i = (long)bidx() * 256 + tidx(); i < (long)NT * 64; i += (long)gridDim.x * 256) {
    int row = (int)(i >> 6), c8 = (int)(i & 63) * 8;
    int t, T; row_info(row, t, T);
    const u16* pr = PR + (long)row * 1536;
    uint4 bg = *(const uint4*)(pr + c8);
    uint4 z4 = make_uint4(0, 0, 0, 0);
    uint4 c1 = *(const uint4*)(pr + 512 + c8), x1 = *(const uint4*)(pr + 1024 + c8);
    uint4 c0 = z4, x0 = z4, c2 = z4, x2 = z4;
    if (t > 0) { c0 = *(const uint4*)(pr - 1536 + 512 + c8); x0 = *(const uint4*)(pr - 1536 + 1024 + c8); }
    if (t < T - 1) { c2 = *(const uint4*)(pr + 1536 + 512 + c8); x2 = *(const uint4*)(pr + 1536 + 1024 + c8); }
    unsigned bga[4] = {bg.x, bg.y, bg.z, bg.w};
    unsigned c0a[4] = {c0.x, c0.y, c0.z, c0.w}, x0a[4] = {x0.x, x0.y, x0.z, x0.w};
    unsigned c1a[4] = {c1.x, c1.y, c1.z, c1.w}, x1a[4] = {x1.x, x1.y, x1.z, x1.w};
    unsigned c2a[4] = {c2.x, c2.y, c2.z, c2.w}, x2a[4] = {x2.x, x2.y, x2.z, x2.w};
    float w0[8], w1[8], w2[8];
    ld8(cw + c8, w0); ld8(cw + 512 + c8, w1); ld8(cw + 1024 + c8, w2);
    unsigned o[4];
#pragma unroll
    for (int e = 0; e < 4; ++e) {
      float lo = lo2f(bga[e]) * (w0[2 * e] * lo2f(c0a[e]) * lo2f(x0a[e]) + w1[2 * e] * lo2f(c1a[e]) * lo2f(x1a[e]) + w2[2 * e] * lo2f(c2a[e]) * lo2f(x2a[e]));
      float hi = hi2f(bga[e]) * (w0[2 * e + 1] * hi2f(c0a[e]) * hi2f(x0a[e]) + w1[2 * e + 1] * hi2f(c1a[e]) * hi2f(x1a[e]) + w2[2 * e + 1] * hi2f(c2a[e]) * hi2f(x2a[e]));
      o[e] = pack2(lo, hi);
    }
    *(uint4*)(BR3 + (long)row * 512 + c8) = make_uint4(o[0], o[1], o[2], o[3]);
  }
}

__device__ void ffn_act_phase(const P& p, int l, int rb, int re) {
  const u16* UP = (const u16*)((char*)p.out + OD_PROJ);
  const float* cw = p.in[23] + (size_t)l * 3 * 5632;
  u16* ACT = (u16*)(p.ws + OFF_BR);
  const long nitem = (long)(re - rb) * 352;
  for (long i = (long)bidx() * 256 + tidx(); i < nitem; i += (long)gridDim.x * 256) {
    int lr = (int)(i / 352), j8 = (int)(i % 352) * 8;
    int row = rb + lr;
    int t, T; row_info(row, t, T);
    const u16* pr = UP + (long)lr * 5632;
    uint4 z4 = make_uint4(0, 0, 0, 0);
    uint4 a1 = *(const uint4*)(pr + j8), v1 = *(const uint4*)(pr + 2816 + j8);
    uint4 a0 = z4, v0 = z4, a2 = z4, v2 = z4;
    if (t > 0) { a0 = *(const uint4*)(pr - 5632 + j8); v0 = *(const uint4*)(pr - 5632 + 2816 + j8); }
    if (t < T - 1) { a2 = *(const uint4*)(pr + 5632 + j8); v2 = *(const uint4*)(pr + 5632 + 2816 + j8); }
    unsigned a0a[4] = {a0.x, a0.y, a0.z, a0.w}, a1a[4] = {a1.x, a1.y, a1.z, a1.w}, a2a[4] = {a2.x, a2.y, a2.z, a2.w};
    unsigned v0a[4] = {v0.x, v0.y, v0.z, v0.w}, v1a[4] = {v1.x, v1.y, v1.z, v1.w}, v2a[4] = {v2.x, v2.y, v2.z, v2.w};
    float wa0[8], wa1[8], wa2[8], wv0[8], wv1[8], wv2[8];
    ld8(cw + j8, wa0); ld8(cw + 5632 + j8, wa1); ld8(cw + 11264 + j8, wa2);
    ld8(cw + 2816 + j8, wv0); ld8(cw + 5632 + 2816 + j8, wv1); ld8(cw + 11264 + 2816 + j8, wv2);
    unsigned o[4];
#pragma unroll
    for (int e = 0; e < 4; ++e) {
      float al = wa0[2 * e] * lo2f(a0a[e]) + wa1[2 * e] * lo2f(a1a[e]) + wa2[2 * e] * lo2f(a2a[e]);
      float ah = wa0[2 * e + 1] * hi2f(a0a[e]) + wa1[2 * e + 1] * hi2f(a1a[e]) + wa2[2 * e + 1] * hi2f(a2a[e]);
      float vl = wv0[2 * e] * lo2f(v0a[e]) + wv1[2 * e] * lo2f(v1a[e]) + wv2[2 * e] * lo2f(v2a[e]);
      float vh = wv0[2 * e + 1] * hi2f(v0a[e]) + wv1[2 * e + 1] * hi2f(v1a[e]) + wv2[2 * e + 1] * hi2f(v2a[e]);
      o[e] = pack2(siluf(al) * vl, siluf(ah) * vh);
    }
    *(uint4*)(ACT + (long)row * 2816 + j8) = make_uint4(o[0], o[1], o[2], o[3]);
  }
}

__device__ __forceinline__ void ffn_gate_rows(const u16* E, int rfirst, int tpos0, int T, int sb, int j0, const float* cw, u16* ACT, int tid) {
#pragma unroll
  for (int it = 0; it < 4; ++it) {
    const int item = tid + 256 * it;
    const int r = rfirst + (item >> 3), cg = (item & 7) * 8;
    const int t = tpos0 + r;
    if ((item >> 3) < 127 && t < T) {
      uint4 ea0 = *(const uint4*)(E + (r - 1) * 136 + cg), ea1 = *(const uint4*)(E + r * 136 + cg), ea2 = *(const uint4*)(E + (r + 1) * 136 + cg);
      uint4 ev0 = *(const uint4*)(E + (r - 1) * 136 + 64 + cg), ev1 = *(const uint4*)(E + r * 136 + 64 + cg), ev2 = *(const uint4*)(E + (r + 1) * 136 + 64 + cg);
      const uint4 z4 = make_uint4(0, 0, 0, 0);
      if (t == 0) { ea0 = z4; ev0 = z4; }
      if (t == T - 1) { ea2 = z4; ev2 = z4; }
      unsigned a0a[4] = {ea0.x, ea0.y, ea0.z, ea0.w}, a1a[4] = {ea1.x, ea1.y, ea1.z, ea1.w}, a2a[4] = {ea2.x, ea2.y, ea2.z, ea2.w};
      unsigned v0a[4] = {ev0.x, ev0.y, ev0.z, ev0.w}, v1a[4] = {ev1.x, ev1.y, ev1.z, ev1.w}, v2a[4] = {ev2.x, ev2.y, ev2.z, ev2.w};
      float wa0[8], wa1[8], wa2[8], wv0[8], wv1[8], wv2[8];
      const int j8 = j0 + cg;
      ld8(cw + j8, wa0); ld8(cw + 5632 + j8, wa1); ld8(cw + 11264 + j8, wa2);
      ld8(cw + 2816 + j8, wv0); ld8(cw + 5632 + 2816 + j8, wv1); ld8(cw + 11264 + 2816 + j8, wv2);
      unsigned o[4];
#pragma unroll
      for (int e = 0; e < 4; ++e) {
        float al = wa0[2 * e] * lo2f(a0a[e]) + wa1[2 * e] * lo2f(a1a[e]) + wa2[2 * e] * lo2f(a2a[e]);
        float ah = wa0[2 * e + 1] * hi2f(a0a[e]) + wa1[2 * e + 1] * hi2f(a1a[e]) + wa2[2 * e + 1] * hi2f(a2a[e]);
        float vl = wv0[2 * e] * lo2f(v0a[e]) + wv1[2 * e] * lo2f(v1a[e]) + wv2[2 * e] * lo2f(v2a[e]);
        float vh = wv0[2 * e + 1] * hi2f(v0a[e]) + wv1[2 * e + 1] * hi2f(v1a[e]) + wv2[2 * e + 1] * hi2f(v2a[e]);
        o[e] = pack2(siluf(al) * vl, siluf(ah) * vh);
      }
      *(uint4*)(ACT + (long)(sb + t) * 2816 + j8) = make_uint4(o[0], o[1], o[2], o[3]);
    }
  }
}

__device__ void ffn_up_fused_phase(const P& p, int l, char* smem) {
  u16* sA = (u16*)smem; u16* sB = sA + 256 * 72;
  u16* E = (u16*)smem;
  const u16* HN = (const u16*)(p.ws + OFF_HN);
  const u16* W = (const u16*)(p.ws + (size_t)l * SZ_WL + OW_UP);
  const float* cw = p.in[23] + (size_t)l * 3 * 5632;
  u16* ACT = (u16*)(p.ws + OFF_BR);
  const int tid = tidx(), lane = tid & 63, wid = tid >> 6, wr = wid >> 1, wc = wid & 1, fr = lane & 15, fq = lane >> 4;
  const int G = gridDim.x, bq = bidx();
  const int bsw = (G & 7) == 0 ? (bq & 7) * (G >> 3) + (bq >> 3) : bq;
  const int ntiles = 424 * 44;
  for (int tile = bsw; tile < ntiles; tile += G) {
    const int mgp = tile / 352, rr = tile - mgp * 352;
    const int nbk = rr >> 5, qq = rr & 31;
    const int mi = mgp * 8 + (qq >> 2), jt = nbk * 4 + (qq & 3);
    int seq, mt;
    if (mi < 288) { seq = mi / 9; mt = mi - seq * 9; } else { int q = mi - 288; seq = 32 + q / 17; mt = q - (q / 17) * 17; }
    const int T = seq < 32 ? TP : TS;
    const int sb = seq_base(seq);
    const int tfirst = 254 * mt - 1;
    const int j0 = jt * 64;
    f32x4 acc[8][4];
#pragma unroll
    for (int m = 0; m < 8; ++m)
#pragma unroll
      for (int n = 0; n < 4; ++n) acc[m][n] = (f32x4){0.f, 0.f, 0.f, 0.f};
    {
      const int lr = tid >> 3, lk = (tid & 7) * 8;
      const u16* pA = HN + (long)(sb + tfirst + lr) * 1024 + lk;
      const u16* pBa = W + (long)(j0 + lr) * 1024 + lk;
      const u16* pBv = W + (long)(2816 + j0 + lr) * 1024 + lk;
      uint4 a0, a1, a2, a3, a4, a5, a6, a7, b0, b1, b2, b3;
#define UP_LOAD(k) do { \
      a0 = *(const uint4*)(pA + (k)); a1 = *(const uint4*)(pA + (k) + 32 * 1024); a2 = *(const uint4*)(pA + (k) + 64 * 1024); a3 = *(const uint4*)(pA + (k) + 96 * 1024); \
      a4 = *(const uint4*)(pA + (k) + 128 * 1024); a5 = *(const uint4*)(pA + (k) + 160 * 1024); a6 = *(const uint4*)(pA + (k) + 192 * 1024); a7 = *(const uint4*)(pA + (k) + 224 * 1024); \
      b0 = *(const uint4*)(pBa + (k)); b1 = *(const uint4*)(pBa + (k) + 32 * 1024); b2 = *(const uint4*)(pBv + (k)); b3 = *(const uint4*)(pBv + (k) + 32 * 1024); } while (0)
      UP_LOAD(0);
      u16* wA = sA + lr * 72 + lk;
      for (int kt = 0; kt < 16; ++kt) {
        __syncthreads();
        *(uint4*)(wA) = a0; *(uint4*)(wA + 32 * 72) = a1; *(uint4*)(wA + 64 * 72) = a2; *(uint4*)(wA + 96 * 72) = a3;
        *(uint4*)(wA + 128 * 72) = a4; *(uint4*)(wA + 160 * 72) = a5; *(uint4*)(wA + 192 * 72) = a6; *(uint4*)(wA + 224 * 72) = a7;
        *(uint4*)(wA + 256 * 72) = b0; *(uint4*)(wA + 288 * 72) = b1; *(uint4*)(wA + 320 * 72) = b2; *(uint4*)(wA + 352 * 72) = b3;
        __syncthreads();
        const int k = (kt + 1 < 16 ? kt + 1 : kt) * 64;
        UP_LOAD(k);
        gemm_compute<true, 8>(acc, sA, sB, wr, wc, fr, fq);
      }
#undef UP_LOAD
    }
    unsigned pk[8][4][2];
#pragma unroll
    for (int m = 0; m < 8; ++m)
#pragma unroll
      for (int n = 0; n < 4; ++n) { pk[m][n][0] = pack2(acc[m][n][0], acc[m][n][1]); pk[m][n][1] = pack2(acc[m][n][2], acc[m][n][3]); }
    __syncthreads();
    if (wr == 0) {
#pragma unroll
      for (int m = 0; m < 8; ++m)
#pragma unroll
        for (int n = 0; n < 4; ++n)
          *(uint2*)(E + (m * 16 + fr) * 136 + wc * 64 + n * 16 + fq * 4) = make_uint2(pk[m][n][0], pk[m][n][1]);
    } else if (fr == 0) {
#pragma unroll
      for (int n = 0; n < 4; ++n)
        *(uint2*)(E + 128 * 136 + wc * 64 + n * 16 + fq * 4) = make_uint2(pk[0][n][0], pk[0][n][1]);
    }
    __syncthreads();
    ffn_gate_rows(E, 1, tfirst, T, sb, j0, cw, ACT, tid);
    __syncthreads();
    if (wr == 1) {
#pragma unroll
      for (int m = 0; m < 8; ++m)
#pragma unroll
        for (int n = 0; n < 4; ++n)
          *(uint2*)(E + (1 + m * 16 + fr) * 136 + wc * 64 + n * 16 + fq * 4) = make_uint2(pk[m][n][0], pk[m][n][1]);
    } else if (fr == 15) {
#pragma unroll
      for (int n = 0; n < 4; ++n)
        *(uint2*)(E + wc * 64 + n * 16 + fq * 4) = make_uint2(pk[7][n][0], pk[7][n][1]);
    }
    __syncthreads();
    ffn_gate_rows(E, 1, tfirst + 127, T, sb, j0, cw, ACT, tid);
  }
}

__device__ void merge_phase(const P& p, int l, char* smem) {
  u16* sA = (u16*)smem; u16* sB = sA + 128 * 72;
  const u16* HN = (const u16*)(p.ws + OFF_HN);
  const char* wl = p.ws + (size_t)l * SZ_WL;
  const u16* Wg = (const u16*)(wl + OW_IN) + (size_t)5136 * 1024;
  const u16* Wb = (const u16*)(wl + OW_BR);
  u16* MG = (u16*)((char*)p.out + OD_PROJ);
  const int nN = 8, nM = NT / 128;
  const int G = gridDim.x, bq = bidx();
  const int bsw = (G & 7) == 0 ? (bq & 7) * (G >> 3) + (bq >> 3) : bq;
  for (int tile = bsw; tile < nM * nN; tile += G) {
    int m0 = (tile / nN) * 128, n0 = (tile % nN) * 128;
    unsigned mgp[4][4][2];
#pragma unroll
    for (int m = 0; m < 4; ++m)
#pragma unroll
      for (int n = 0; n < 4; ++n) { mgp[m][n][0] = 0u; mgp[m][n][1] = 0u; }
    for (int k = 0; k < 4; ++k) {
      unsigned gate[4][4][2];
      {
        f32x4 acc[4][4];
#pragma unroll
        for (int m = 0; m < 4; ++m)
#pragma unroll
          for (int n = 0; n < 4; ++n) acc[m][n] = (f32x4){0.f, 0.f, 0.f, 0.f};
        GA g{HN, 1024, NT, Wg + (size_t)k * 1024 * 1024, 1024, 1024, 1024};
        gemm_main_db_4<true>(g, m0, n0, acc, sA);
#pragma unroll
        for (int m = 0; m < 4; ++m)
#pragma unroll
          for (int n = 0; n < 4; ++n) {
            gate[m][n][0] = pack2(sigmf(acc[m][n][0]), sigmf(acc[m][n][1]));
            gate[m][n][1] = pack2(sigmf(acc[m][n][2]), sigmf(acc[m][n][3]));
          }
      }
      {
        f32x4 acc[4][4];
#pragma unroll
        for (int m = 0; m < 4; ++m)
#pragma unroll
          for (int n = 0; n < 4; ++n) acc[m][n] = (f32x4){0.f, 0.f, 0.f, 0.f};
        GA g{(const u16*)(p.ws + OFF_BR + (size_t)k * SZ_BR), 512, NT, Wb + (size_t)k * 1024 * 512, 512, 1024, 512};
        gemm_main_db_4<true>(g, m0, n0, acc, sA);
#pragma unroll
        for (int m = 0; m < 4; ++m)
#pragma unroll
          for (int n = 0; n < 4; ++n) {
            mgp[m][n][0] = pack2(lo2f(mgp[m][n][0]) + lo2f(gate[m][n][0]) * acc[m][n][0], hi2f(mgp[m][n][0]) + hi2f(gate[m][n][0]) * acc[m][n][1]);
            mgp[m][n][1] = pack2(lo2f(mgp[m][n][1]) + lo2f(gate[m][n][1]) * acc[m][n][2], hi2f(mgp[m][n][1]) + hi2f(gate[m][n][1]) * acc[m][n][3]);
          }
      }
    }
    const int lane = tidx() & 63, wid = tidx() >> 6, wr = wid >> 1, wc = wid & 1, fr = lane & 15, fq = lane >> 4;
#pragma unroll
    for (int m = 0; m < 4; ++m)
#pragma unroll
      for (int n = 0; n < 4; ++n) {
        int row = m0 + wr * 64 + m * 16 + fr, col = n0 + wc * 64 + n * 16 + fq * 4;
        *(uint2*)(MG + (long)row * 1024 + col) = make_uint2(mgp[m][n][0], mgp[m][n][1]);
      }
  }
}

__global__ void __launch_bounds__(256, 2) hybrid_fwd(P p) {
  cg::grid_group grid = cg::this_grid();
  __shared__ __attribute__((aligned(16))) char smem[55296];
  u16* H = (u16*)(p.ws + OFF_H);
  u16* HN = (u16*)(p.ws + OFF_HN);
  u16* PROJ = (u16*)((char*)p.out + OD_PROJ);

  __shared__ uint4 xb_words;
  if (threadIdx.x == 0) xb_words = make_uint4(0u, 0u, 0u, 0u);
  __syncthreads();
  XcdBarrier xb = xcd_barrier_post((unsigned*)(p.ws + OFF_BAR), (volatile LAS unsigned*)&xb_words);
  prep_phase(p, smem);
  grid.sync();

  for (int l = 0; l < 2; ++l) {
    const char* wl = p.ws + (size_t)l * SZ_WL;
    for (int rep = 0; rep < REPE; ++rep) rmsnorm_phase(H, p.in[3] + l * 1024, HN, nullptr, 0);
    for (int rep = 0; rep < REPE; ++rep) hyena_hid_phase(p, l);
    GSYNC();
    {
      GA g{HN, 1024, NT, (const u16*)(wl + OW_FN), 1024, 1024, 1024};
      gemm_phase256<false>(g, [&](int row, int col, f32x4 v) {
        if (row >= NT) return;
        int t, T; row_info(row, t, T);
        const int Th = T == TP ? THP : THS;
        long gb = T == TP ? (long)(row / TP) * (512l * 2 * THP) : GT_SAMPLE0 + (long)((row - ROWS_P) / TS) * (512l * 2 * THS);
        int c = col & 511, half = col >> 9;
        *(uint2*)(PROJ + gb + (long)(c * 2 + half) * Th + t) = make_uint2(pack2(v[0], v[1]), pack2(v[2], v[3]));
      }, smem, REPG);
      for (long i = (long)bidx() * 256 + tidx(); i < 40l * 1024 * 6; i += (long)gridDim.x * 256) {
        int rowi = (int)(i / 6), v6 = (int)(i % 6);
        int seq = rowi >> 10, ch = rowi & 1023;
        long off = seq < 32 ? (long)seq * (512l * 2 * THP) + (long)ch * THP + TP : GT_SAMPLE0 + (long)(seq - 32) * (512l * 2 * THS) + (long)ch * THS + TS;
        unsigned zz = 0; asm volatile("" : "+v"(zz));
        *(uint4*)(PROJ + off + v6 * 8) = make_uint4(zz, zz, zz, zz);
      }
    }
    GSYNC();
    {
      u16* BR0 = (u16*)(p.ws + OFF_BR);
      u16* sA = (u16*)smem; u16* sB = sA + 128 * 72;
      const int tiles_s = 8 * 17 * 4, tiles_p = 32 * 9 * 4;
      const int Gd = gridDim.x, bd = bidx();
      const bool bal = (Gd == 512);
      const int nslot = bal ? 4 : (tiles_s + tiles_p + Gd - 1) / Gd;
      for (int rep = 0; rep < REPG; ++rep)
      for (int slot = 0; slot < nslot; ++slot) {
        int tile;
        if (bal) {
          if (slot == 0) tile = bd;
          else if (bd < 32) tile = slot == 1 ? 512 + bd : (slot == 2 ? tiles_s + bd : -1);
          else { int pi = 32 + (bd - 32) + 480 * (slot - 1); tile = pi < tiles_p ? tiles_s + pi : -1; }
        } else tile = bd + slot * Gd;
        if (tile < 0 || tile >= tiles_s + tiles_p) continue;
        int seq, mt, nt, T, Th;
        if (tile < tiles_s) { mt = tile / 32; int r = tile % 32; seq = 32 + (r >> 2); nt = r & 3; T = TS; Th = THS; }
        else { int q = tile - tiles_s; mt = q / 128; int r = q % 128; seq = r >> 2; nt = r & 3; T = TP; Th = THP; }
        const int sb = seq_base(seq);
        const u16* Am = (const u16*)((char*)p.out + (T == TS ? OD_DFTS : OD_DFTP));
        const u16* Bm = PROJ + (seq < 32 ? (long)seq * (512l * 2 * THP) : GT_SAMPLE0 + (long)(seq - 32) * (512l * 2 * THS));
        f32x4 accP[4][4], accQ[4][4];
#pragma unroll
        for (int m = 0; m < 4; ++m)
#pragma unroll
          for (int n = 0; n < 4; ++n) { accP[m][n] = (f32x4){0.f, 0.f, 0.f, 0.f}; accQ[m][n] = (f32x4){0.f, 0.f, 0.f, 0.f}; }
        {
          GA g{Am, 2l * Th, T, Bm, 2l * Th, 512, Th};
          gemm_main_db_4<true>(g, mt * 128, nt * 128, accP, sA);
        }
        {
          GA g{Am + Th, 2l * Th, T, Bm + Th, 2l * Th, 512, Th};
          gemm_main_db_4<true>(g, mt * 128, nt * 128, accQ, sA);
        }
        const float sc = rsqrtf((float)T * 128.f);
        const int lane = tidx() & 63, wid = tidx() >> 6, wr = wid >> 1, wc = wid & 1, fr = lane & 15, fq = lane >> 4;
#pragma unroll
        for (int m = 0; m < 4; ++m)
#pragma unroll
          for (int n = 0; n < 4; ++n) {
            int row = mt * 128 + wr * 64 + m * 16 + fr, col = nt * 128 + wc * 64 + n * 16 + fq * 4;
            f32x4 pv = accP[m][n], qv = accQ[m][n];
            if (row <= T / 2)
              *(uint2*)(BR0 + (long)(sb + row) * 512 + col) = make_uint2(pack2((pv[0] - qv[0]) * sc, (pv[1] - qv[1]) * sc), pack2((pv[2] - qv[2]) * sc, (pv[3] - qv[3]) * sc));
            if (row >= 1 && row < T / 2)
              *(uint2*)(BR0 + (long)(sb + T - row) * 512 + col) = make_uint2(pack2((pv[0] + qv[0]) * sc, (pv[1] + qv[1]) * sc), pack2((pv[2] + qv[2]) * sc, (pv[3] + qv[3]) * sc));
          }
      }
    }
    GSYNC();
    {
      GA g{HN, 1024, NT, (const u16*)(wl + OW_IN) + (size_t)512 * 1024, 1024, 1552, 1024};
      gemm_phase256<true>(g, [&](int row, int col, f32x4 v) {
        if (col < 1552 && row < NT) *(uint2*)(PROJ + (long)row * 1552 + col) = make_uint2(pack2(v[0], v[1]), pack2(v[2], v[3]));
      }, smem, REPG);
    }
    GSYNC();
    ssd_conv_phase(p, l);
    GSYNC();
    for (int rep = 0; rep < REPS; ++rep) ssd_scan_phase(p, l, smem);
    { const int kf0 = (int)gridDim.x > 384 ? 384 : 0; hyena_kf_phase(p, l, kf0, (int)gridDim.x - kf0); }
    GSYNC();
    ssd_state_phase(p);
    GSYNC();
    ssd_fix_phase(p);
    GSYNC();
    for (int rep = 0; rep < REPE; ++rep) ssd_post_phase(p, l);
    GSYNC();
    {
      GA g{HN, 1024, NT, (const u16*)(wl + OW_IN) + (size_t)2064 * 1024, 1024, 1536, 1024};
      gemm_phase256<true>(g, [&](int row, int col, f32x4 v) {
        if (row < NT) *(uint2*)(PROJ + (long)row * 1536 + col) = make_uint2(pack2(v[0], v[1]), pack2(v[2], v[3]));
      }, smem, REPG);
    }
    GSYNC();
    for (int rep = 0; rep < REPE; ++rep) hyena_prep_phase(p, l, smem);
    GSYNC();
    for (int rep = 0; rep < REPL; ++rep) longconv_phase<0>(p, l, smem);
    GSYNC();
    for (int rep = 0; rep < REPL; ++rep) longconv_phase<1>(p, l, smem);
    GSYNC();
    hyena_tr_phase(p, smem);
    GSYNC();
    {
      GA g{HN, 1024, NT, (const u16*)(wl + OW_IN) + (size_t)3600 * 1024, 1024, 1536, 1024};
      gemm_phase256<true>(g, [&](int row, int col, f32x4 v) {
        if (row < NT) *(uint2*)(PROJ + (long)row * 1536 + col) = make_uint2(pack2(v[0], v[1]), pack2(v[2], v[3]));
      }, smem, REPG);
    }
    GSYNC();
    for (int rep = 0; rep < REPE; ++rep) sc_phase(p, l);
    GSYNC();
    for (int rep = 0; rep < REPG; ++rep) merge_phase(p, l, smem);
    GSYNC();
    {
      GA g{PROJ, 1024, NT, (const u16*)(wl + OW_OUT), 1024, 1024, 1024};
      gemm_phase256<true>(g, [&](int row, int col, f32x4 v) {
        if (row >= NT) return;
        uint2* hp = (uint2*)(H + (long)row * 1024 + col);
        uint2 o = *hp;
        *hp = make_uint2(pack2(lo2f(o.x) + v[0], hi2f(o.x) + v[1]), pack2(lo2f(o.y) + v[2], hi2f(o.y) + v[3]));
      }, smem, 1);
    }
    GSYNC();
    for (int rep = 0; rep < REPE; ++rep) rmsnorm_phase(H, p.in[22] + l * 1024, HN, nullptr, 0);
    GSYNC();
    for (int rep = 0; rep < REPG; ++rep) ffn_up_fused_phase(p, l, smem);
    GSYNC();
    {
      GA g{(const u16*)(p.ws + OFF_BR), 2816, NT, (const u16*)(wl + OW_DOWN), 2816, 1024, 2816};
      gemm_phase256<true>(g, [&](int row, int col, f32x4 v) {
        if (row >= NT) return;
        uint2* hp = (uint2*)(H + (long)row * 1024 + col);
        uint2 o = *hp;
        *hp = make_uint2(pack2(lo2f(o.x) + v[0], hi2f(o.x) + v[1]), pack2(lo2f(o.y) + v[2], hi2f(o.y) + v[3]));
      }, smem, 1);
    }
    GSYNC();
  }
  final_phase(p);
}

extern "C" void kernel_launch(void* const* d_in, const int* in_sizes, int n_in, void* d_out, int out_size,
                              void* d_ws, size_t ws_size, hipStream_t stream) {
  static int grid_blocks = 0;
  if (!grid_blocks) {
    int dev = 0, cus = 0, per_cu = 0;
    (void)hipGetDevice(&dev);
    (void)hipDeviceGetAttribute(&cus, hipDeviceAttributeMultiprocessorCount, dev);
    (void)hipOccupancyMaxActiveBlocksPerMultiprocessor(&per_cu, hybrid_fwd, 256, 0);
    if (per_cu > 2) per_cu = 2;
    grid_blocks = cus * per_cu;
  }
  if (ws_size < WS_TOTAL) { fprintf(stderr, "workspace too small: %zu < %zu\n", ws_size, (size_t)WS_NEED); return; }
  (void)hipMemsetAsync((char*)d_ws + OFF_BAR, 0, XCD_BAR_WORDS_C * 4, stream);
  P p{};
  for (int i = 0; i < 27; ++i) p.in[i] = (const float*)d_in[i];
  p.out = (float*)d_out;
  p.ws = (char*)d_ws;
  void* args[] = {&p};
  hipError_t e = hipLaunchCooperativeKernel((void*)hybrid_fwd, dim3(grid_blocks), dim3(256), args, 0, stream);
  if (e != hipSuccess) fprintf(stderr, "cooperative launch failed: %s (grid %d)\n", hipGetErrorString(e), grid_blocks);
}
```

```cpp
#include <hip/hip_runtime.h>
#include <hip/hip_cooperative_groups.h>
#include <cstdio>
namespace cg = cooperative_groups;

typedef unsigned short u16;
using bf16x8 = __attribute__((ext_vector_type(8))) short;
using f32x4 = __attribute__((ext_vector_type(4))) float;

constexpr int NT = 98944, TP = 2064, TS = 4112, ROWS_P = 32 * 2064;
constexpr int DIN = 9232;
constexpr float EPS = 1e-6f;
constexpr int XCD_BAR_WORDS_C = 3456;
#ifndef REPG
#define REPG 1
#endif
#ifndef REPL
#define REPL 1
#endif
#ifndef REPS
#define REPS 1
#endif
#ifndef REPE
#define REPE 1
#endif
#ifndef REPY
#define REPY 1
#endif
#define GSYNC() do { for (int rs_ = 0; rs_ < REPY; ++rs_) xcd_barrier_impl(xb.bar, xb.x, xb.st); } while (0)

constexpr size_t SZ_WL = 44597248ull;
constexpr size_t OW_IN = 0, OW_FN = 18907136ull, OW_BR = OW_FN + 2097152ull, OW_OUT = OW_BR + 4194304ull,
                 OW_UP = OW_OUT + 2097152ull, OW_DOWN = OW_UP + 11534336ull;
constexpr size_t OFF_H = 2 * SZ_WL;
constexpr size_t SZ_ACT = (size_t)NT * 1024 * 2;
constexpr size_t OFF_HN = OFF_H + SZ_ACT;
constexpr size_t OFF_BR = OFF_HN + SZ_ACT;
constexpr size_t SZ_BR = (size_t)NT * 512 * 2;
constexpr size_t OFF_X2T = OFF_BR + 4 * SZ_BR;
constexpr size_t OFF_KF = OFF_X2T + SZ_BR;
constexpr size_t SZ_KF = 2ull * 512 * (4128 + 8224) * 2;
constexpr size_t OFF_HID = OFF_KF + SZ_KF;
constexpr size_t SZ_HID = (size_t)(TP + TS) * 64 * 4;
constexpr size_t OFF_L1 = OFF_HID + SZ_HID;
constexpr size_t WS_NEED = OFF_BR + (size_t)NT * 2816 * 2;
constexpr size_t OFF_BAR = (WS_NEED + 4095) / 4096 * 4096;
constexpr size_t WS_TOTAL = OFF_BAR + XCD_BAR_WORDS_C * 4;
constexpr int THP = 2112, THS = 4160;
constexpr int MHP = 9 * 128, MHS = 17 * 128;
constexpr size_t OD_DFTP = 0, OD_DFTS = (size_t)MHP * 2 * THP * 2, OD_PROJ = OD_DFTS + (size_t)MHS * 2 * THS * 2;
constexpr size_t OD_HS = OD_PROJ + (size_t)NT * 1552 * 2;
constexpr size_t OD_DS = OD_HS + 4ull * 56 * 4 * 8192 * 4;
constexpr size_t OD_CSG = OD_DS + 4ull * 56 * 4 * 4;
constexpr int SEGC = 33;
constexpr long GT_SAMPLE0 = 32l * 512 * 2 * THP;

struct P {
  const float* in[27];
  float* out;
  char* ws;
};

__device__ __forceinline__ u16 f2bf(float f) {
  unsigned u = __float_as_uint(f);
  u += 0x7fffu + ((u >> 16) & 1u);
  return (u16)(u >> 16);
}
__device__ __forceinline__ float bf2f(u16 h) { return __uint_as_float(((unsigned)h) << 16); }
__device__ __forceinline__ unsigned pack2(float a, float b) { return (unsigned)f2bf(a) | ((unsigned)f2bf(b) << 16); }
__device__ __forceinline__ float lo2f(unsigned u) { return __uint_as_float(u << 16); }
__device__ __forceinline__ float hi2f(unsigned u) { return __uint_as_float(u & 0xffff0000u); }
__device__ __forceinline__ float siluf(float x) { return x / (1.f + __expf(-x)); }
__device__ __forceinline__ float sigmf(float x) { return 1.f / (1.f + __expf(-x)); }

__device__ __forceinline__ int tidx() { int t = threadIdx.x; asm volatile("" : "+v"(t)); return t; }
__device__ __forceinline__ int bidx() { int b = blockIdx.x; asm volatile("" : "+s"(b)); return b; }
__device__ __forceinline__ void ld8(const float* p, float (&w)[8]) {
  float4 a = *(const float4*)p, b = *(const float4*)(p + 4);
  w[0] = a.x; w[1] = a.y; w[2] = a.z; w[3] = a.w; w[4] = b.x; w[5] = b.y; w[6] = b.z; w[7] = b.w;
}
__device__ __forceinline__ int seq_base(int seq) { return seq < 32 ? seq * TP : ROWS_P + (seq - 32) * TS; }
__device__ __forceinline__ void row_info(int r, int& t, int& T) {
  if (r < ROWS_P) { t = r % TP; T = TP; } else { t = (r - ROWS_P) % TS; T = TS; }
}
__device__ __forceinline__ float bperm(float v, int src_lane) {
  return __int_as_float(__builtin_amdgcn_ds_bpermute(src_lane << 2, __float_as_int(v)));
}
__device__ __forceinline__ float wave_sum(float v) {
  const int lane = tidx() & 63;
#pragma unroll
  for (int o = 32; o > 0; o >>= 1) v += bperm(v, lane ^ o);
  return v;
}


#define XB_TMO      128
#define XB_XCNT(j)  (256  + 64 * (j))
#define XB_XSUB(j)  (1280 + 64 * (j))
#define XB_XGEN(j)  (2304 + 64 * (j))
#define XB_TOP      3328
#define XB_TOPGEN   3392
#define XCD_BAR_WORDS 3456
#define XB_SPIN_CAP (1u << 24)
#define LAS __attribute__((address_space(3)))
__device__ __forceinline__ unsigned xb_ld(unsigned* p)              { return __hip_atomic_load(p, __ATOMIC_RELAXED, __HIP_MEMORY_SCOPE_AGENT); }
__device__ __forceinline__ unsigned xb_add(unsigned* p, unsigned v) { return __hip_atomic_fetch_add(p, v, __ATOMIC_RELAXED, __HIP_MEMORY_SCOPE_AGENT); }
__device__ __forceinline__ unsigned xb_xcc_id() { return (unsigned)__builtin_amdgcn_s_getreg((3 << 11) | 20) & 0xFu; }
#define XB_SPIN(cond, bar) do { unsigned _sp = 0; while (cond) { __builtin_amdgcn_s_sleep(1); \
    if ((++_sp & 255u) == 0u) { if (xb_ld(&(bar)[XB_TMO])) break; if (_sp > XB_SPIN_CAP) { atomicAdd(&(bar)[XB_TMO], 1u); break; } } } } while (0)
struct XcdBarrier { unsigned* bar; unsigned x; volatile LAS unsigned* st; };
__device__ __forceinline__ XcdBarrier xcd_barrier_post(unsigned* bar, volatile LAS unsigned* st) {
  XcdBarrier b; b.bar = bar; b.x = xb_xcc_id(); b.st = st;
  if (threadIdx.x == 0) (void)xb_add(&bar[XB_XCNT(b.x)], 1u);
  return b;
}
__device__ __forceinline__ void xcd_barrier_complete(unsigned* bar, unsigned x, unsigned& nloc, unsigned& nx) {
  const unsigned G = gridDim.x * gridDim.y * gridDim.z;
  unsigned sum, cnt, mine, sp = 0u;
  for (;;) {
    sum = 0u; cnt = 0u; mine = 0u;
#pragma unroll
    for (unsigned j = 0; j < 16; ++j) { const unsigned c = xb_ld(&bar[XB_XCNT(j)]); sum += c; cnt += (c > 0u) ? 1u : 0u; mine = (j == x) ? c : mine; }
    if (sum == G) break;
    __builtin_amdgcn_s_sleep(1);
    if ((++sp & 255u) == 0u) { if (xb_ld(&bar[XB_TMO])) break; if (sp > XB_SPIN_CAP) { atomicAdd(&bar[XB_TMO], 1u); break; } }
  }
  nloc = mine > 0u ? mine : 1u; nx = cnt > 0u ? cnt : 1u;
}
__device__ __noinline__ void xcd_barrier_impl(unsigned* bar, unsigned bx, volatile LAS unsigned* st) {
  XcdBarrier b; b.bar = bar; b.x = bx; b.st = st;
  asm volatile("s_waitcnt vmcnt(0)" ::: "memory");
  __syncthreads();
  if (threadIdx.x == 0) {
    unsigned* bar = b.bar;
    __builtin_amdgcn_s_waitcnt(0);
    unsigned nloc = b.st[0], nx = b.st[1];
    if (nloc == 0u) { xcd_barrier_complete(bar, b.x, nloc, nx); b.st[0] = nloc; b.st[1] = nx; }
    const unsigned old = xb_add(&bar[XB_XSUB(b.x)], 1u);
    const unsigned gen = old / nloc;
    if (old + 1u == (gen + 1u) * nloc) {
      __builtin_amdgcn_fence(__ATOMIC_RELEASE, "agent");
      asm volatile("s_waitcnt vmcnt(0)" ::: "memory");
      const unsigned og = xb_add(&bar[XB_TOP], 1u);
      const unsigned tg = og / nx;
      if (og + 1u == (tg + 1u) * nx) xb_add(&bar[XB_TOPGEN], 1u);
      else XB_SPIN(xb_ld(&bar[XB_TOPGEN]) == tg, bar);
      __builtin_amdgcn_fence(__ATOMIC_ACQUIRE, "agent");
      xb_add(&bar[XB_XGEN(b.x)], 1u);
      asm volatile("s_waitcnt vmcnt(0)" ::: "memory");
    } else {
      XB_SPIN(xb_ld(&bar[XB_XGEN(b.x)]) == gen, bar);
      __builtin_amdgcn_fence(__ATOMIC_ACQUIRE, "agent");
      asm volatile("s_waitcnt vmcnt(0)" ::: "memory");
    }
  }
  __syncthreads();
}

struct GA { const u16* A; long lda; int M; const u16* B; long ldb; int N; int K; };

__device__ __forceinline__ uint4 ld_mask(const u16* base, long ld, int r, int R, int k, int K) {
  const bool ok = (r < R) && (k < K);
  const int rr = r < R ? r : R - 1;
  const int kk = k < K ? k : 0;
  uint4 v = *(const uint4*)(base + (long)rr * ld + kk);
  v.x = ok ? v.x : 0u; v.y = ok ? v.y : 0u; v.z = ok ? v.z : 0u; v.w = ok ? v.w : 0u;
  return v;
}

template <bool SWAP, int MW>
__device__ __forceinline__ void gemm_compute(f32x4 (&acc)[MW][4], const u16* sA, const u16* sB, int wr, int wc, int fr, int fq) {
  constexpr int MG = MW < 4 ? MW : 4;
#pragma unroll
  for (int kk = 0; kk < 2; ++kk) {
    bf16x8 bfr[4];
#pragma unroll
    for (int n = 0; n < 4; ++n) bfr[n] = *(const bf16x8*)(sB + (wc * 64 + n * 16 + fr) * 72 + kk * 32 + fq * 8);
#pragma unroll
    for (int mg = 0; mg < MW / MG; ++mg) {
      bf16x8 af[MG];
#pragma unroll
      for (int m = 0; m < MG; ++m) af[m] = *(const bf16x8*)(sA + (wr * (MW * 16) + (mg * MG + m) * 16 + fr) * 72 + kk * 32 + fq * 8);
#pragma unroll
      for (int m = 0; m < MG; ++m)
#pragma unroll
        for (int n = 0; n < 4; ++n)
          acc[mg * MG + m][n] = SWAP ? __builtin_amdgcn_mfma_f32_16x16x32_bf16(bfr[n], af[m], acc[mg * MG + m][n], 0, 0, 0)
                                     : __builtin_amdgcn_mfma_f32_16x16x32_bf16(af[m], bfr[n], acc[mg * MG + m][n], 0, 0, 0);
    }
  }
}

template <bool SWAP, int MW = 4>
__device__ __forceinline__ void gemm_main(const GA& g, int m0, int n0, f32x4 (&acc)[MW][4], u16* sA, u16* sB) {
  const int tid = tidx(), lane = tid & 63, wid = tid >> 6, wr = wid >> 1, wc = wid & 1, fr = lane & 15, fq = lane >> 4;
  uint4 ra0[MW], rb0[4], ra1[MW], rb1[4];
  const int nk = (g.K + 63) >> 6;
  const int lr = tid >> 3, lk = (tid & 7) * 8;
#pragma unroll
  for (int i = 0; i < MW; ++i) ra0[i] = ld_mask(g.A, g.lda, m0 + lr + i * 32, g.M, lk, g.K);
#pragma unroll
  for (int i = 0; i < 4; ++i) rb0[i] = ld_mask(g.B, g.ldb, n0 + lr + i * 32, g.N, lk, g.K);
#pragma unroll
  for (int i = 0; i < MW; ++i) ra1[i] = ld_mask(g.A, g.lda, m0 + lr + i * 32, g.M, 64 + lk, g.K);
#pragma unroll
  for (int i = 0; i < 4; ++i) rb1[i] = ld_mask(g.B, g.ldb, n0 + lr + i * 32, g.N, 64 + lk, g.K);
  for (int kt = 0; kt < nk; kt += 2) {
    __syncthreads();
#pragma unroll
    for (int i = 0; i < MW; ++i) *(uint4*)(sA + (lr + i * 32) * 72 + lk) = ra0[i];
#pragma unroll
    for (int i = 0; i < 4; ++i) *(uint4*)(sB + (lr + i * 32) * 72 + lk) = rb0[i];
    __syncthreads();
    if (kt + 2 < nk) {
      const int k = (kt + 2) * 64 + lk;
#pragma unroll
      for (int i = 0; i < MW; ++i) ra0[i] = ld_mask(g.A, g.lda, m0 + lr + i * 32, g.M, k, g.K);
#pragma unroll
      for (int i = 0; i < 4; ++i) rb0[i] = ld_mask(g.B, g.ldb, n0 + lr + i * 32, g.N, k, g.K);
    }
    gemm_compute<SWAP, MW>(acc, sA, sB, wr, wc, fr, fq);
    if (kt + 1 < nk) {
      __syncthreads();
#pragma unroll
      for (int i = 0; i < MW; ++i) *(uint4*)(sA + (lr + i * 32) * 72 + lk) = ra1[i];
#pragma unroll
      for (int i = 0; i < 4; ++i) *(uint4*)(sB + (lr + i * 32) * 72 + lk) = rb1[i];
      __syncthreads();
      if (kt + 3 < nk) {
        const int k = (kt + 3) * 64 + lk;
#pragma unroll
        for (int i = 0; i < MW; ++i) ra1[i] = ld_mask(g.A, g.lda, m0 + lr + i * 32, g.M, k, g.K);
#pragma unroll
        for (int i = 0; i < 4; ++i) rb1[i] = ld_mask(g.B, g.ldb, n0 + lr + i * 32, g.N, k, g.K);
      }
      gemm_compute<SWAP, MW>(acc, sA, sB, wr, wc, fr, fq);
    }
  }
}

template <bool SWAP, int MW>
__device__ __forceinline__ void gemm_main1(const GA& g, int m0, int n0, f32x4 (&acc)[MW][4], u16* sA, u16* sB) {
  static_assert(MW == 8, "256-row tile");
  const int tid = tidx(), lane = tid & 63, wid = tid >> 6, wr = wid >> 1, wc = wid & 1, fr = lane & 15, fq = lane >> 4;
  const int nk = (g.K + 63) >> 6;
  const int lr = tid >> 3, lk = (tid & 7) * 8;
  const u16* pA = g.A + (long)(m0 + lr) * g.lda + lk;
  const u16* pB = g.B + (long)(n0 + lr) * g.ldb + lk;
  const long sa = 32 * g.lda, sb = 32 * g.ldb;
  uint4 a0, a1, a2, a3, a4, a5, a6, a7, b0, b1, b2, b3;
#define GL_LOAD(k) do { \
    a0 = *(const uint4*)(pA + (k)); a1 = *(const uint4*)(pA + (k) + sa); a2 = *(const uint4*)(pA + (k) + 2 * sa); a3 = *(const uint4*)(pA + (k) + 3 * sa); \
    a4 = *(const uint4*)(pA + (k) + 4 * sa); a5 = *(const uint4*)(pA + (k) + 5 * sa); a6 = *(const uint4*)(pA + (k) + 6 * sa); a7 = *(const uint4*)(pA + (k) + 7 * sa); \
    b0 = *(const uint4*)(pB + (k)); b1 = *(const uint4*)(pB + (k) + sb); b2 = *(const uint4*)(pB + (k) + 2 * sb); b3 = *(const uint4*)(pB + (k) + 3 * sb); } while (0)
  GL_LOAD(0);
  u16* wA = sA + lr * 72 + lk;
  u16* wB = sB + lr * 72 + lk;
  for (int kt = 0; kt < nk; ++kt) {
    __syncthreads();
    *(uint4*)(wA) = a0; *(uint4*)(wA + 32 * 72) = a1; *(uint4*)(wA + 64 * 72) = a2; *(uint4*)(wA + 96 * 72) = a3;
    *(uint4*)(wA + 128 * 72) = a4; *(uint4*)(wA + 160 * 72) = a5; *(uint4*)(wA + 192 * 72) = a6; *(uint4*)(wA + 224 * 72) = a7;
    *(uint4*)(wB) = b0; *(uint4*)(wB + 32 * 72) = b1; *(uint4*)(wB + 64 * 72) = b2; *(uint4*)(wB + 96 * 72) = b3;
    __syncthreads();
    const int k = (kt + 1 < nk ? kt + 1 : kt) * 64;
    GL_LOAD(k);
    gemm_compute<SWAP, MW>(acc, sA, sB, wr, wc, fr, fq);
  }
#undef GL_LOAD
}

template <bool SWAP>
__device__ __forceinline__ void gemm_main1_4(const GA& g, int m0, int n0, f32x4 (&acc)[4][4], u16* sA, u16* sB) {
  const int tid = tidx(), lane = tid & 63, wid = tid >> 6, wr = wid >> 1, wc = wid & 1, fr = lane & 15, fq = lane >> 4;
  const int nk = (g.K + 63) >> 6;
  const int lr = tid >> 3, lk = (tid & 7) * 8;
  const u16* pA = g.A + (long)(m0 + lr) * g.lda + lk;
  const u16* pB = g.B + (long)(n0 + lr) * g.ldb + lk;
  const long sa = 32 * g.lda, sb = 32 * g.ldb;
  uint4 a0, a1, a2, a3, b0, b1, b2, b3;
#define GL_LOAD4(k) do { \
    a0 = *(const uint4*)(pA + (k)); a1 = *(const uint4*)(pA + (k) + sa); a2 = *(const uint4*)(pA + (k) + 2 * sa); a3 = *(const uint4*)(pA + (k) + 3 * sa); \
    b0 = *(const uint4*)(pB + (k)); b1 = *(const uint4*)(pB + (k) + sb); b2 = *(const uint4*)(pB + (k) + 2 * sb); b3 = *(const uint4*)(pB + (k) + 3 * sb); } while (0)
  GL_LOAD4(0);
  u16* wA = sA + lr * 72 + lk;
  u16* wB = sB + lr * 72 + lk;
  for (int kt = 0; kt < nk; ++kt) {
    __syncthreads();
    *(uint4*)(wA) = a0; *(uint4*)(wA + 32 * 72) = a1; *(uint4*)(wA + 64 * 72) = a2; *(uint4*)(wA + 96 * 72) = a3;
    *(uint4*)(wB) = b0; *(uint4*)(wB + 32 * 72) = b1; *(uint4*)(wB + 64 * 72) = b2; *(uint4*)(wB + 96 * 72) = b3;
    __syncthreads();
    const int k = (kt + 1 < nk ? kt + 1 : kt) * 64;
    GL_LOAD4(k);
    gemm_compute<SWAP, 4>(acc, sA, sB, wr, wc, fr, fq);
  }
#undef GL_LOAD4
}

template <bool SWAP>
__device__ __forceinline__ void gemm_main2_4(const GA& g, int m0, int n0, f32x4 (&acc)[4][4], u16* sA, u16* sB) {
  const int tid = tidx(), lane = tid & 63, wid = tid >> 6, wr = wid >> 1, wc = wid & 1, fr = lane & 15, fq = lane >> 4;
  const int nk = (g.K + 63) >> 6;
  const int lr = tid >> 3, lk = (tid & 7) * 8;
  const u16* pA = g.A + (long)(m0 + lr) * g.lda + lk;
  const u16* pB = g.B + (long)(n0 + lr) * g.ldb + lk;
  const long sa = 32 * g.lda, sb = 32 * g.ldb;
  uint4 a0, a1, a2, a3, b0, b1, b2, b3, c0, c1, c2, c3, d0, d1, d2, d3;
#define G2_LOAD(k, A0, A1, A2, A3, B0, B1, B2, B3) do { \
    A0 = *(const uint4*)(pA + (k)); A1 = *(const uint4*)(pA + (k) + sa); A2 = *(const uint4*)(pA + (k) + 2 * sa); A3 = *(const uint4*)(pA + (k) + 3 * sa); \
    B0 = *(const uint4*)(pB + (k)); B1 = *(const uint4*)(pB + (k) + sb); B2 = *(const uint4*)(pB + (k) + 2 * sb); B3 = *(const uint4*)(pB + (k) + 3 * sb); } while (0)
#define G2_STORE(A0, A1, A2, A3, B0, B1, B2, B3) do { \
    *(uint4*)(wA) = A0; *(uint4*)(wA + 32 * 72) = A1; *(uint4*)(wA + 64 * 72) = A2; *(uint4*)(wA + 96 * 72) = A3; \
    *(uint4*)(wB) = B0; *(uint4*)(wB + 32 * 72) = B1; *(uint4*)(wB + 64 * 72) = B2; *(uint4*)(wB + 96 * 72) = B3; } while (0)
  u16* wA = sA + lr * 72 + lk;
  u16* wB = sB + lr * 72 + lk;
  G2_LOAD(0, a0, a1, a2, a3, b0, b1, b2, b3);
  G2_LOAD((nk > 1 ? 64 : 0), c0, c1, c2, c3, d0, d1, d2, d3);
  for (int kt = 0; kt < nk; kt += 2) {
    __syncthreads();
    G2_STORE(a0, a1, a2, a3, b0, b1, b2, b3);
    __syncthreads();
    { const int k = (kt + 2 < nk ? kt + 2 : kt) * 64; G2_LOAD(k, a0, a1, a2, a3, b0, b1, b2, b3); }
    gemm_compute<SWAP, 4>(acc, sA, sB, wr, wc, fr, fq);
    if (kt + 1 < nk) {
      __syncthreads();
      G2_STORE(c0, c1, c2, c3, d0, d1, d2, d3);
      __syncthreads();
      { const int k = (kt + 3 < nk ? kt + 3 : kt + 1) * 64; G2_LOAD(k, c0, c1, c2, c3, d0, d1, d2, d3); }
      gemm_compute<SWAP, 4>(acc, sA, sB, wr, wc, fr, fq);
    }
  }
#undef G2_LOAD
#undef G2_STORE
}

template <bool SWAP>
__device__ __forceinline__ void gemm_main_db_4(const GA& g, int m0, int n0, f32x4 (&acc)[4][4], u16* lds) {
  const int tid = tidx(), lane = tid & 63, wid = tid >> 6, wr = wid >> 1, wc = wid & 1, fr = lane & 15, fq = lane >> 4;
  const int nk = g.K >> 5;
  const int lr = tid >> 2, lk = (tid & 3) * 8;
  const u16* pA = g.A + (long)(m0 + lr) * g.lda + lk;
  const u16* pB = g.B + (long)(n0 + lr) * g.ldb + lk;
  const long sa = 64 * g.lda, sb = 64 * g.ldb;
  uint4 a0, a1, b0, b1;
  a0 = *(const uint4*)(pA); a1 = *(const uint4*)(pA + sa); b0 = *(const uint4*)(pB); b1 = *(const uint4*)(pB + sb);
  u16* w = lds + lr * 40 + lk;
  *(uint4*)(w) = a0; *(uint4*)(w + 64 * 40) = a1; *(uint4*)(w + 5120) = b0; *(uint4*)(w + 5120 + 64 * 40) = b1;
  { const int k = (nk > 1 ? 32 : 0); a0 = *(const uint4*)(pA + k); a1 = *(const uint4*)(pA + k + sa); b0 = *(const uint4*)(pB + k); b1 = *(const uint4*)(pB + k + sb); }
  __syncthreads();
  for (int kt = 0; kt < nk; ++kt) {
    const u16* cA = lds + (kt & 1) * 10240;
    const u16* cB = cA + 5120;
    bf16x8 af[4], bfr[4];
#pragma unroll
    for (int m = 0; m < 4; ++m) af[m] = *(const bf16x8*)(cA + (wr * 64 + m * 16 + fr) * 40 + fq * 8);
#pragma unroll
    for (int n = 0; n < 4; ++n) bfr[n] = *(const bf16x8*)(cB + (wc * 64 + n * 16 + fr) * 40 + fq * 8);
    if (kt + 1 < nk) {
      u16* wn = w + ((kt + 1) & 1) * 10240;
      *(uint4*)(wn) = a0; *(uint4*)(wn + 64 * 40) = a1; *(uint4*)(wn + 5120) = b0; *(uint4*)(wn + 5120 + 64 * 40) = b1;
    }
    { const int k = (kt + 2 < nk ? kt + 2 : kt) * 32; a0 = *(const uint4*)(pA + k); a1 = *(const uint4*)(pA + k + sa); b0 = *(const uint4*)(pB + k); b1 = *(const uint4*)(pB + k + sb); }
#pragma unroll
    for (int m = 0; m < 4; ++m)
#pragma unroll
      for (int n = 0; n < 4; ++n)
        acc[m][n] = SWAP ? __builtin_amdgcn_mfma_f32_16x16x32_bf16(bfr[n], af[m], acc[m][n], 0, 0, 0)
                         : __builtin_amdgcn_mfma_f32_16x16x32_bf16(af[m], bfr[n], acc[m][n], 0, 0, 0);
    __syncthreads();
  }
}

template <bool SWAP, class Epi>
__device__ __forceinline__ void gemm_phase256(const GA& g, Epi epi, char* smem, int reps = 1) {
  u16* sA = (u16*)smem; u16* sB = sA + 256 * 72;
  const int nM = (g.M + 255) >> 8, nN = (g.N + 127) >> 7;
  const int G = gridDim.x, bq = bidx();
  const int bsw = (G & 7) == 0 ? (bq & 7) * (G >> 3) + (bq >> 3) : bq;
  for (int rep = 0; rep < reps; ++rep)
  for (int tile = bsw; tile < nM * nN; tile += G) {
    int m0 = (tile / nN) * 256, n0 = (tile % nN) * 128;
    f32x4 acc[8][4];
#pragma unroll
    for (int m = 0; m < 8; ++m)
#pragma unroll
      for (int n = 0; n < 4; ++n) acc[m][n] = (f32x4){0.f, 0.f, 0.f, 0.f};
    gemm_main1<SWAP, 8>(g, m0, n0, acc, sA, sB);
    gemm_epi<SWAP, 8>(m0, n0, acc, epi);
  }
}

template <bool SWAP, int MW = 4, class Epi>
__device__ __forceinline__ void gemm_epi(int m0, int n0, f32x4 (&acc)[MW][4], Epi epi) {
  const int lane = tidx() & 63, wid = tidx() >> 6, wr = wid >> 1, wc = wid & 1, fr = lane & 15, fq = lane >> 4;
#pragma unroll
  for (int m = 0; m < MW; ++m)
#pragma unroll
    for (int n = 0; n < 4; ++n) {
      int row, col;
      if (SWAP) { row = m0 + wr * (MW * 16) + m * 16 + fr; col = n0 + wc * 64 + n * 16 + fq * 4; }
      else { row = m0 + wr * (MW * 16) + m * 16 + fq * 4; col = n0 + wc * 64 + n * 16 + fr; }
      epi(row, col, acc[m][n]);
    }
}

template <bool SWAP, class Epi>
__device__ __forceinline__ void gemm_phase(const GA& g, Epi epi, char* smem, int reps = 1) {
  u16* sA = (u16*)smem; u16* sB = sA + 128 * 72;
  const int nM = (g.M + 127) >> 7, nN = (g.N + 127) >> 7;
  const int G = gridDim.x, bq = bidx();
  const int bsw = (G & 7) == 0 ? (bq & 7) * (G >> 3) + (bq >> 3) : bq;
  for (int rep = 0; rep < reps; ++rep)
  for (int tile = bsw; tile < nM * nN; tile += G) {
    int m0 = (tile / nN) * 128, n0 = (tile % nN) * 128;
    f32x4 acc[4][4];
#pragma unroll
    for (int m = 0; m < 4; ++m)
#pragma unroll
      for (int n = 0; n < 4; ++n) acc[m][n] = (f32x4){0.f, 0.f, 0.f, 0.f};
    gemm_main<SWAP, 4>(g, m0, n0, acc, sA, sB);
    gemm_epi<SWAP, 4>(m0, n0, acc, epi);
  }
}

__device__ void transpose_cvt(const float* W, int K, int N, u16* out, char* smem) {
  float* tile = (float*)smem;
  const int tk = (K + 63) / 64, tn = (N + 63) / 64;
  const int tx = tidx() & 63, ty = tidx() >> 6;
  for (int id = bidx(); id < tk * tn; id += gridDim.x) {
    int k0 = (id / tn) * 64, n0 = (id % tn) * 64;
    __syncthreads();
    for (int i = ty; i < 64; i += 4) {
      int k = k0 + i, n = n0 + tx;
      tile[i * 65 + tx] = (k < K && n < N) ? __builtin_nontemporal_load(W + (long)k * N + n) : 0.f;
    }
    __syncthreads();
    for (int i = ty; i < 64; i += 4) {
      int n = n0 + i, k = k0 + tx;
      if (n < N && k < K) out[(long)n * K + k] = f2bf(tile[tx * 65 + i]);
    }
  }
}

__device__ void prep_phase(const P& p, char* smem) {
  const int tid = tidx();
  const long gtid = (long)bidx() * 256 + tid, gsz = (long)gridDim.x * 256;
  {
    u16* H = (u16*)(p.ws + OFF_H);
    for (long i = gtid; i < (long)NT * 128; i += gsz) {
      int row = (int)(i >> 7), c8 = (int)(i & 127) * 8;
      int t, T; row_info(row, t, T);
      const float* src;
      if (t < 16) src = p.in[2] + t * 1024 + c8;
      else if (row < ROWS_P) { int s = row / TP; src = p.in[0] + ((long)s * 2048 + (t - 16)) * 1024 + c8; }
      else { int s = (row - ROWS_P) / TS; src = p.in[1] + ((long)s * 4096 + (t - 16)) * 1024 + c8; }
      f32x4 av4 = __builtin_nontemporal_load((const f32x4*)src), bv4 = __builtin_nontemporal_load((const f32x4*)(src + 4));
      float4 a = make_float4(av4[0], av4[1], av4[2], av4[3]), b = make_float4(bv4[0], bv4[1], bv4[2], bv4[3]);
      uint4 o = make_uint4(pack2(a.x, a.y), pack2(a.z, a.w), pack2(b.x, b.y), pack2(b.z, b.w));
      *(uint4*)(H + (long)row * 1024 + c8) = o;
    }
  }
  for (int which = 0; which < 2; ++which) {
    const int T = which ? TS : TP, Th = which ? THS : THP, Mh = T / 2 + 1;
    u16* A = (u16*)((char*)p.out + (which ? OD_DFTS : OD_DFTP));
    for (long i = gtid; i < (long)Mh * Th; i += gsz) {
      int tt = (int)(i / Th), k = (int)(i % Th);
      u16 c = 0, sn = 0;
      if (k < T) {
        int m = (int)(((long)tt * k) % T);
        float x = 2.f * (float)m / (float)T;
        c = f2bf(cospif(x)); sn = f2bf(sinpif(x));
      }
      A[(long)tt * 2 * Th + k] = c;
      A[(long)tt * 2 * Th + Th + k] = sn;
    }
  }
  for (int l = 0; l < 2; ++l) {
    char* wl = p.ws + (size_t)l * SZ_WL;
    transpose_cvt(p.in[4] + (size_t)l * 1024 * DIN, 1024, DIN, (u16*)(wl + OW_IN), smem);
    for (int k = 0; k < 4; ++k)
      transpose_cvt(p.in[20] + ((size_t)l * 4 + k) * 512 * 1024, 512, 1024, (u16*)(wl + OW_BR) + (size_t)k * 1024 * 512, smem);
    transpose_cvt(p.in[21] + (size_t)l * 1024 * 1024, 1024, 1024, (u16*)(wl + OW_OUT), smem);
    transpose_cvt(p.in[24] + (size_t)l * 1024 * 5632, 1024, 5632, (u16*)(wl + OW_UP), smem);
    transpose_cvt(p.in[25] + (size_t)l * 2816 * 1024, 2816, 1024, (u16*)(wl + OW_DOWN), smem);
  }
  {
    float* wt = (float*)smem;
    float* ct = wt + 64 * 129;
    for (int task = bidx(); task < 128; task += gridDim.x) {
      int l = task >> 6, kt = (task & 63) >> 2, g = task & 3;
      const float* win = p.in[4] + (size_t)l * 1024 * DIN;
      u16* Wfn = (u16*)(p.ws + (size_t)l * SZ_WL + OW_FN);
      __syncthreads();
      for (int idx = tid; idx < 64 * 128; idx += 256) {
        int kk = idx >> 7, j = idx & 127;
        wt[kk * 129 + j] = win[(size_t)(kt * 64 + kk) * DIN + g * 128 + j];
      }
      if (tid < 128) { ct[tid] = cospif(tid / 64.f); ct[128 + tid] = sinpif(tid / 64.f); }
      __syncthreads();
      int kk = tid & 63, grp = tid >> 6;
      for (int mm = grp; mm < 256; mm += 4) {
        int half = mm >> 7, m = mm & 127;
        float s = 0.f;
        for (int j = 0; j < 128; ++j) s += wt[kk * 129 + j] * ct[half * 128 + ((j * m) & 127)];
        Wfn[(size_t)(half * 512 + g * 128 + m) * 1024 + kt * 64 + kk] = f2bf(s);
      }
    }
  }
}

__device__ void rmsnorm_phase(const u16* H, const float* w, u16* HN, float* zbuf, long zn4) {
  const int lane = tidx() & 63;
  const int wave = (bidx() * 256 + tidx()) >> 6, nw = gridDim.x * 4;
  if (zbuf) {
    float4 z = make_float4(0.f, 0.f, 0.f, 0.f);
    for (long i = (long)bidx() * 256 + tidx(); i < zn4; i += (long)gridDim.x * 256) ((float4*)zbuf)[i] = z;
  }
  float wlo[8], whi[8];
  ld8(w + lane * 8, wlo); ld8(w + 512 + lane * 8, whi);
  for (int row = wave; row < NT; row += nw) {
    const uint4* hp = (const uint4*)(H + (long)row * 1024);
    uint4 a = hp[lane], b = hp[64 + lane];
    unsigned ua[8] = {a.x, a.y, a.z, a.w, b.x, b.y, b.z, b.w};
    float x[16];
    float ss = 0.f;
#pragma unroll
    for (int i = 0; i < 8; ++i) { x[2 * i] = lo2f(ua[i]); x[2 * i + 1] = hi2f(ua[i]); ss += x[2 * i] * x[2 * i] + x[2 * i + 1] * x[2 * i + 1]; }
    ss = wave_sum(ss);
    float r = rsqrtf(ss * (1.f / 1024.f) + EPS);
    unsigned o[8];
#pragma unroll
    for (int i = 0; i < 8; ++i) {
      const float w0 = i < 4 ? wlo[(i & 3) * 2] : whi[(i & 3) * 2], w1 = i < 4 ? wlo[(i & 3) * 2 + 1] : whi[(i & 3) * 2 + 1];
      o[i] = pack2(x[2 * i] * r * w0, x[2 * i + 1] * r * w1);
    }
    uint4* op = (uint4*)(HN + (long)row * 1024);
    op[lane] = make_uint4(o[0], o[1], o[2], o[3]);
    op[64 + lane] = make_uint4(o[4], o[5], o[6], o[7]);
  }
}

__device__ void final_phase(const P& p) {
  const u16* H = (const u16*)(p.ws + OFF_H);
  const float* w = p.in[26];
  const int lane = tidx() & 63;
  const int wave = (bidx() * 256 + tidx()) >> 6, nw = gridDim.x * 4;
  for (int row = wave; row < NT; row += nw) {
    int t, T; row_info(row, t, T);
    if (t < 16) continue;
    long orow;
    if (row < ROWS_P) orow = (long)(row / TP) * 2048 + (t - 16);
    else orow = 32l * 2048 + (long)((row - ROWS_P) / TS) * 4096 + (t - 16);
    const uint4* hp = (const uint4*)(H + (long)row * 1024);
    uint4 a = hp[lane], b = hp[64 + lane];
    unsigned ua[8] = {a.x, a.y, a.z, a.w, b.x, b.y, b.z, b.w};
    float x[16];
    float ss = 0.f;
#pragma unroll
    for (int i = 0; i < 8; ++i) { x[2 * i] = lo2f(ua[i]); x[2 * i + 1] = hi2f(ua[i]); ss += x[2 * i] * x[2 * i] + x[2 * i + 1] * x[2 * i + 1]; }
    ss = wave_sum(ss);
    float r = rsqrtf(ss * (1.f / 1024.f) + EPS);
    float* op = p.out + orow * 1024;
#pragma unroll
    for (int hgrp = 0; hgrp < 2; ++hgrp) {
      int c = hgrp * 512 + lane * 8;
      float4 o0, o1;
      o0.x = x[hgrp * 8 + 0] * r * w[c + 0]; o0.y = x[hgrp * 8 + 1] * r * w[c + 1];
      o0.z = x[hgrp * 8 + 2] * r * w[c + 2]; o0.w = x[hgrp * 8 + 3] * r * w[c + 3];
      o1.x = x[hgrp * 8 + 4] * r * w[c + 4]; o1.y = x[hgrp * 8 + 5] * r * w[c + 5];
      o1.z = x[hgrp * 8 + 6] * r * w[c + 6]; o1.w = x[hgrp * 8 + 7] * r * w[c + 7];
      __builtin_nontemporal_store((f32x4){o0.x, o0.y, o0.z, o0.w}, (f32x4*)(op + c));
      __builtin_nontemporal_store((f32x4){o1.x, o1.y, o1.z, o1.w}, (f32x4*)(op + c + 4));
    }
  }
}

__device__ __forceinline__ float conv3_at(const u16* PR, long row, int ld, int col, int t, int T, float w0, float w1, float w2) {
  float x1 = bf2f(PR[row * ld + col]);
  float x0 = (t > 0) ? bf2f(PR[(row - 1) * ld + col]) : 0.f;
  float x2 = (t < T - 1) ? bf2f(PR[(row + 1) * ld + col]) : 0.f;
  return w0 * x0 + w1 * x1 + w2 * x2;
}

__device__ void ssd_conv_phase(const P& p, int l) {
  const u16* PR = (const u16*)((char*)p.out + OD_PROJ);
  const float* cw = p.in[5] + l * 3 * 1024;
  const float* cb = p.in[6] + l * 1024;
  u16* XS = (u16*)(p.ws + OFF_BR + 1 * SZ_BR);
  u16* BC = (u16*)(p.ws + OFF_X2T);
  for (long i = (long)bidx() * 256 + tidx(); i < (long)NT * 128; i += (long)gridDim.x * 256) {
    int row = (int)(i >> 7), c8 = (int)(i & 127) * 8;
    int t, T; row_info(row, t, T);
    const u16* pr = PR + (long)row * 1552 + 512 + c8;
    uint4 z4 = make_uint4(0, 0, 0, 0);
    uint4 x1 = *(const uint4*)pr, x0 = z4, x2 = z4;
    if (t > 0) x0 = *(const uint4*)(pr - 1552);
    if (t < T - 1) x2 = *(const uint4*)(pr + 1552);
    unsigned a0[4] = {x0.x, x0.y, x0.z, x0.w}, a1[4] = {x1.x, x1.y, x1.z, x1.w}, a2[4] = {x2.x, x2.y, x2.z, x2.w};
    float w0[8], w1[8], w2[8], wb[8];
    ld8(cw + c8, w0); ld8(cw + 1024 + c8, w1); ld8(cw + 2048 + c8, w2); ld8(cb + c8, wb);
    unsigned o[4];
#pragma unroll
    for (int e = 0; e < 4; ++e) {
      float lo = siluf(w0[2 * e] * lo2f(a0[e]) + w1[2 * e] * lo2f(a1[e]) + w2[2 * e] * lo2f(a2[e]) + wb[2 * e]);
      float hi = siluf(w0[2 * e + 1] * hi2f(a0[e]) + w1[2 * e + 1] * hi2f(a1[e]) + w2[2 * e + 1] * hi2f(a2[e]) + wb[2 * e + 1]);
      o[e] = pack2(lo, hi);
    }
    u16* dst = c8 < 512 ? XS + (long)row * 512 + c8 : BC + (long)row * 512 + (c8 - 512);
    *(uint4*)dst = make_uint4(o[0], o[1], o[2], o[3]);
  }
}

__device__ void ssd_scan_phase(const P& p, int l, char* smem) {
  u16* Cn = (u16*)smem;
  u16* Bn = Cn + 32 * 136;
  u16* BT = Bn + 32 * 136;
  u16* XT = BT + 128 * 40;
  float* dts = (float*)(XT + 4 * 64 * 40);
  float* css = dts + 128;
  const u16* PR = (const u16*)((char*)p.out + OD_PROJ);
  const u16* XS = (const u16*)(p.ws + OFF_BR + 1 * SZ_BR);
  const u16* BC = (const u16*)(p.ws + OFF_X2T);
  const float* dtb = p.in[7] + l * 16;
  const float* alog = p.in[8] + l * 16;
  for (int task = bidx(); task < 384; task += gridDim.x) {
    const int tid = tidx(), lane = tid & 63, r = tid >> 6;
    const int fr = lane & 15, fq = lane >> 4;
    int seq, g, dir, seg;
    if (task < 128) { seq = 32 + (task >> 4); int rem = task & 15; g = rem >> 3; dir = (rem >> 2) & 1; seg = rem & 3; }
    else { int q = task - 128; seq = q >> 3; int rem = q & 7; g = rem >> 2; dir = (rem >> 1) & 1; seg = rem & 1; }
    int base = seq_base(seq), T = seq < 32 ? TP : TS;
    float csoff = 0.f;
    u16* Yd = (u16*)(p.ws + OFF_BR + (size_t)(2 + dir) * SZ_BR);
    f32x4 HT[8][4];
#pragma unroll
    for (int a = 0; a < 8; ++a)
#pragma unroll
      for (int b = 0; b < 4; ++b) HT[a][b] = (f32x4){0.f, 0.f, 0.f, 0.f};
    const int nch = (T + 31) >> 5;
    const int chb = seg * SEGC, che = (chb + SEGC < nch) ? chb + SEGC : nch;
    const int sv_v = tid & 63;
    const u16* colp = sv_v < 32 ? BC + (sv_v < 16 ? g * 128 + 8 * sv_v : 256 + g * 128 + 8 * (sv_v - 16)) : XS + g * 256 + 8 * (sv_v - 32);
    uint4 sv[4];
    u16 rawdt = 0;
#define SCAN_LOADN(i0, C0, NV, S0) _Pragma("unroll") for (int i = 0; i < (NV); ++i) { \
        const int tau = (C0) + r + 4 * ((i0) + i); const bool ok = tau < T; \
        const int tc = ok ? (dir ? T - 1 - tau : tau) : 0; \
        uint4 val = *(const uint4*)(colp + (long)(base + tc) * 512); \
        sv[(S0) + i].x = ok ? val.x : 0u; sv[(S0) + i].y = ok ? val.y : 0u; sv[(S0) + i].z = ok ? val.z : 0u; sv[(S0) + i].w = ok ? val.w : 0u; }
#define SCAN_LOADDT(C0) do { rawdt = 0; if (tid < 128) { int tau = (C0) + (tid & 31); if (tau < T) { int t = dir ? T - 1 - tau : tau; \
        rawdt = PR[(long)(base + t) * 1552 + 1536 + dir * 8 + g * 4 + (tid >> 5)]; } } } while (0)
#define SCAN_STORE(i0) _Pragma("unroll") for (int i = 0; i < 4; ++i) { \
        const int tl = r + 4 * ((i0) + i); const int v = sv_v; \
        uint4 val = sv[i]; unsigned w4[4] = {val.x, val.y, val.z, val.w}; \
        if (v < 16) { \
          *(uint4*)(Bn + tl * 136 + 8 * v) = val; \
          _Pragma("unroll") for (int e = 0; e < 4; ++e) { BT[(8 * v + 2 * e) * 40 + tl] = (u16)(w4[e] & 0xffffu); BT[(8 * v + 2 * e + 1) * 40 + tl] = (u16)(w4[e] >> 16); } \
        } else if (v < 32) { \
          *(uint4*)(Cn + tl * 136 + 8 * (v - 16)) = val; \
        } else { \
          int h = (v - 32) >> 3, p0 = ((v - 32) & 7) * 8; \
          float dt = dts[h * 32 + tl]; \
          _Pragma("unroll") for (int e = 0; e < 4; ++e) { \
            XT[(h * 64 + p0 + 2 * e) * 40 + tl] = f2bf(lo2f(w4[e]) * dt); \
            XT[(h * 64 + p0 + 2 * e + 1) * 40 + tl] = f2bf(hi2f(w4[e]) * dt); } } }
    SCAN_LOADDT(chb * 32);
    SCAN_LOADN(0, chb * 32, 2, 0)
    for (int ch = chb; ch < che; ++ch) {
      const int c0 = ch * 32;
      __syncthreads();
      if (tid < 128) {
        int h = tid >> 5, tl = tid & 31, tau = c0 + tl;
        int hi = dir * 8 + g * 4 + h;
        float dt = 0.f;
        if (tau < T) {
          float dr = bf2f(rawdt) + dtb[hi];
          dt = dr > 20.f ? dr : __logf(1.f + __expf(dr));
        }
        float v = -dt * __expf(alog[hi]);
#pragma unroll
        for (int o = 1; o < 32; o <<= 1) { float u = bperm(v, (lane - o) & 63); if (tl >= o) v += u; }
        dts[h * 32 + tl] = dt; css[h * 32 + tl] = v;
      }
      __syncthreads();
      SCAN_LOADN(2, c0, 2, 2)
      SCAN_STORE(0)
      SCAN_LOADN(4, c0, 4, 0)
      SCAN_STORE(4)
      __syncthreads();
      if (ch + 1 < che) { SCAN_LOADDT(c0 + 32); SCAN_LOADN(0, c0 + 32, 2, 0) }
      const float* cs = css + r * 32;
      const u16* xt = XT + r * 64 * 40;
      if (lane < 32) {
        int tau = c0 + lane;
        if (tau < T) { int t = dir ? T - 1 - tau : tau; ((float*)((char*)p.out + OD_CSG))[((long)(base + t) * 2 + dir) * 8 + g * 4 + r] = csoff + cs[lane]; }
      }
      f32x4 GT00 = (f32x4){0.f, 0.f, 0.f, 0.f}, GT01 = GT00, GT11 = GT00;
#pragma unroll
      for (int kk = 0; kk < 4; ++kk) {
        bf16x8 b0 = *(const bf16x8*)(Bn + (fr) * 136 + kk * 32 + fq * 8);
        bf16x8 b1 = *(const bf16x8*)(Bn + (16 + fr) * 136 + kk * 32 + fq * 8);
        bf16x8 c0v = *(const bf16x8*)(Cn + (fr) * 136 + kk * 32 + fq * 8);
        bf16x8 c1v = *(const bf16x8*)(Cn + (16 + fr) * 136 + kk * 32 + fq * 8);
        GT00 = __builtin_amdgcn_mfma_f32_16x16x32_bf16(b0, c0v, GT00, 0, 0, 0);
        GT01 = __builtin_amdgcn_mfma_f32_16x16x32_bf16(b0, c1v, GT01, 0, 0, 0);
        GT11 = __builtin_amdgcn_mfma_f32_16x16x32_bf16(b1, c1v, GT11, 0, 0, 0);
      }
      const float csl0 = cs[fr], csl1 = cs[16 + fr];
      float m00[4], m01[4], m11[4];
#pragma unroll
      for (int j = 0; j < 4; ++j) {
        int s0 = 4 * fq + j;
        float css0 = cs[s0], css1 = cs[16 + s0];
        m00[j] = (s0 <= fr) ? GT00[j] * __expf(csl0 - css0) : 0.f;
        m01[j] = GT01[j] * __expf(csl1 - css0);
        m11[j] = (s0 <= fr) ? GT11[j] * __expf(csl1 - css1) : 0.f;
      }
      union { bf16x8 v; unsigned u[4]; } A0, A1;
      A0.u[0] = pack2(m00[0], m00[1]); A0.u[1] = pack2(m00[2], m00[3]); A0.u[2] = 0u; A0.u[3] = 0u;
      A1.u[0] = pack2(m01[0], m01[1]); A1.u[1] = pack2(m01[2], m01[3]); A1.u[2] = pack2(m11[0], m11[1]); A1.u[3] = pack2(m11[2], m11[3]);
      f32x4 Y[2][4];
#pragma unroll
      for (int tp = 0; tp < 4; ++tp) {
        union { bf16x8 v; uint2 h[2]; } xb;
        xb.h[0] = *(const uint2*)(xt + (tp * 16 + fr) * 40 + 4 * fq);
        xb.h[1] = *(const uint2*)(xt + (tp * 16 + fr) * 40 + 16 + 4 * fq);
        f32x4 z = (f32x4){0.f, 0.f, 0.f, 0.f};
        Y[0][tp] = __builtin_amdgcn_mfma_f32_16x16x32_bf16(A0.v, xb.v, z, 0, 0, 0);
        Y[1][tp] = __builtin_amdgcn_mfma_f32_16x16x32_bf16(A1.v, xb.v, z, 0, 0, 0);
      }
      const float e0 = __expf(csl0), e1 = __expf(csl1);
#pragma unroll
      for (int u = 0; u < 4; ++u) {
        union { bf16x8 v; uint2 h[2]; unsigned w[4]; } ca, cbv;
        ca.h[0] = *(const uint2*)(Cn + (fr) * 136 + 32 * u + 4 * fq);
        ca.h[1] = *(const uint2*)(Cn + (fr) * 136 + 32 * u + 16 + 4 * fq);
        cbv.h[0] = *(const uint2*)(Cn + (16 + fr) * 136 + 32 * u + 4 * fq);
        cbv.h[1] = *(const uint2*)(Cn + (16 + fr) * 136 + 32 * u + 16 + 4 * fq);
#pragma unroll
        for (int e = 0; e < 4; ++e) {
          ca.w[e] = pack2(lo2f(ca.w[e]) * e0, hi2f(ca.w[e]) * e0);
          cbv.w[e] = pack2(lo2f(cbv.w[e]) * e1, hi2f(cbv.w[e]) * e1);
        }
#pragma unroll
        for (int tp = 0; tp < 4; ++tp) {
          union { bf16x8 v; unsigned w[4]; } hb;
          hb.w[0] = pack2(HT[2 * u][tp][0], HT[2 * u][tp][1]); hb.w[1] = pack2(HT[2 * u][tp][2], HT[2 * u][tp][3]);
          hb.w[2] = pack2(HT[2 * u + 1][tp][0], HT[2 * u + 1][tp][1]); hb.w[3] = pack2(HT[2 * u + 1][tp][2], HT[2 * u + 1][tp][3]);
          Y[0][tp] = __builtin_amdgcn_mfma_f32_16x16x32_bf16(ca.v, hb.v, Y[0][tp], 0, 0, 0);
          Y[1][tp] = __builtin_amdgcn_mfma_f32_16x16x32_bf16(cbv.v, hb.v, Y[1][tp], 0, 0, 0);
        }
      }
#pragma unroll
      for (int tl = 0; tl < 2; ++tl)
#pragma unroll
        for (int j = 0; j < 4; ++j) {
          int tau = c0 + tl * 16 + 4 * fq + j;
          if (tau < T) {
            int t = dir ? T - 1 - tau : tau;
            u16* yp = Yd + (long)(base + t) * 512 + g * 256 + r * 64 + fr;
#pragma unroll
            for (int tp = 0; tp < 4; ++tp) yp[tp * 16] = f2bf(Y[tl][tp][j]);
          }
        }
      const float csL = cs[31];
      const float eL = __expf(csL);
      float w8[8];
#pragma unroll
      for (int jj = 0; jj < 8; ++jj) w8[jj] = __expf(csL - cs[8 * fq + jj]);
      bf16x8 xs4[4];
#pragma unroll
      for (int tp = 0; tp < 4; ++tp) {
        union { bf16x8 v; unsigned w[4]; } xx;
        xx.v = *(const bf16x8*)(xt + (tp * 16 + fr) * 40 + 8 * fq);
#pragma unroll
        for (int e = 0; e < 4; ++e) xx.w[e] = pack2(lo2f(xx.w[e]) * w8[2 * e], hi2f(xx.w[e]) * w8[2 * e + 1]);
        xs4[tp] = xx.v;
      }
#pragma unroll
      for (int tn = 0; tn < 8; ++tn) {
        bf16x8 bt = *(const bf16x8*)(BT + (tn * 16 + fr) * 40 + 8 * fq);
#pragma unroll
        for (int tp = 0; tp < 4; ++tp) {
          f32x4 hv = HT[tn][tp];
          hv[0] *= eL; hv[1] *= eL; hv[2] *= eL; hv[3] *= eL;
          HT[tn][tp] = __builtin_amdgcn_mfma_f32_16x16x32_bf16(bt, xs4[tp], hv, 0, 0, 0);
        }
      }
      csoff += csL;
    }
#undef SCAN_LOADN
#undef SCAN_LOADDT
#undef SCAN_STORE
    if (seg < (seq < 32 ? 1 : 3)) {
      const int sslot = seq < 32 ? seq : 32 + (seq - 32) * 3 + seg;
      const long sl = (long)((g * 2 + dir) * 56 + sslot) * 4 + r;
      f32x4* hs = (f32x4*)((float*)((char*)p.out + OD_HS) + sl * 8192);
#pragma unroll
      for (int tn = 0; tn < 8; ++tn)
#pragma unroll
        for (int tp = 0; tp < 4; ++tp) hs[(tn * 4 + tp) * 64 + lane] = HT[tn][tp];
      if (lane == 0) ((float*)((char*)p.out + OD_DS))[sl] = __expf(csoff);
    }
  }
}

__device__ void ssd_state_phase(const P& p) {
  float* HS = (float*)((char*)p.out + OD_HS);
  const float* DS = (const float*)((char*)p.out + OD_DS);
  for (long i = (long)bidx() * 256 + tidx(); i < 128l * 2048; i += (long)gridDim.x * 256) {
    int chain = (int)(i >> 11), e = (int)(i & 2047);
    int gd = chain >> 5, sq = (chain >> 2) & 7, h = chain & 3;
    long sl0 = (long)(gd * 56 + 32 + sq * 3) * 4 + h;
    float4 a = ((const float4*)(HS + sl0 * 8192))[e];
    float4 b = ((const float4*)(HS + (sl0 + 4) * 8192))[e];
    float d1 = DS[sl0 + 4];
    b.x += d1 * a.x; b.y += d1 * a.y; b.z += d1 * a.z; b.w += d1 * a.w;
    ((float4*)(HS + (sl0 + 4) * 8192))[e] = b;
    float4 c = ((const float4*)(HS + (sl0 + 8) * 8192))[e];
    float d2 = DS[sl0 + 8];
    c.x += d2 * b.x; c.y += d2 * b.y; c.z += d2 * b.z; c.w += d2 * b.w;
    ((float4*)(HS + (sl0 + 8) * 8192))[e] = c;
  }
}

__device__ void ssd_fix_phase(const P& p) {
  const float* HS = (const float*)((char*)p.out + OD_HS);
  const float* CSG = (const float*)((char*)p.out + OD_CSG);
  const u16* BC = (const u16*)(p.ws + OFF_X2T);
  const int tid = tidx(), lane = tid & 63, r = tid >> 6;
  const int fr = lane & 15, fq = lane >> 4;
  for (int task = bidx(); task < 7168; task += gridDim.x) {
    int seq, gd, ch;
    if (task < 3072) { seq = 32 + task / 384; int rem = task % 384; gd = rem / 96; ch = SEGC + rem % 96; }
    else { int q = task - 3072; seq = q >> 7; int rem = q & 127; gd = rem >> 5; ch = SEGC + (rem & 31); }
    const int g = gd >> 1, dir = gd & 1;
    const int base = seq_base(seq), T = seq < 32 ? TP : TS;
    const int seg = ch / SEGC;
    const int sslot = seq < 32 ? seq : 32 + (seq - 32) * 3 + (seg - 1);
    const f32x4* hs = (const f32x4*)(HS + ((long)(gd * 56 + sslot) * 4 + r) * 8192);
    u16* Yd = (u16*)(p.ws + OFF_BR + (size_t)(2 + dir) * SZ_BR);
    const int c0 = ch * 32;
    const int tau0 = c0 + fr, tau1 = c0 + 16 + fr;
    const bool ok0 = tau0 < T, ok1 = tau1 < T;
    const int t0r = ok0 ? (dir ? T - 1 - tau0 : tau0) : 0, t1r = ok1 ? (dir ? T - 1 - tau1 : tau1) : 0;
    const float e0 = ok0 ? __expf(CSG[((long)(base + t0r) * 2 + dir) * 8 + g * 4 + r]) : 0.f;
    const float e1 = ok1 ? __expf(CSG[((long)(base + t1r) * 2 + dir) * 8 + g * 4 + r]) : 0.f;
    const u16* c0p = BC + (long)(base + t0r) * 512 + 256 + g * 128;
    const u16* c1p = BC + (long)(base + t1r) * 512 + 256 + g * 128;
    f32x4 Y[2][4];
#pragma unroll
    for (int a = 0; a < 2; ++a)
#pragma unroll
      for (int b = 0; b < 4; ++b) Y[a][b] = (f32x4){0.f, 0.f, 0.f, 0.f};
#pragma unroll
    for (int u = 0; u < 4; ++u) {
      union { bf16x8 v; uint2 h[2]; unsigned w[4]; } ca, cbv;
      ca.h[0] = *(const uint2*)(c0p + 32 * u + 4 * fq);
      ca.h[1] = *(const uint2*)(c0p + 32 * u + 16 + 4 * fq);
      cbv.h[0] = *(const uint2*)(c1p + 32 * u + 4 * fq);
      cbv.h[1] = *(const uint2*)(c1p + 32 * u + 16 + 4 * fq);
#pragma unroll
      for (int e = 0; e < 4; ++e) {
        ca.w[e] = pack2(lo2f(ca.w[e]) * e0, hi2f(ca.w[e]) * e0);
        cbv.w[e] = pack2(lo2f(cbv.w[e]) * e1, hi2f(cbv.w[e]) * e1);
      }
#pragma unroll
      for (int tp = 0; tp < 4; ++tp) {
        f32x4 ha = hs[((2 * u) * 4 + tp) * 64 + lane], hb2 = hs[((2 * u + 1) * 4 + tp) * 64 + lane];
        union { bf16x8 v; unsigned w[4]; } hb;
        hb.w[0] = pack2(ha[0], ha[1]); hb.w[1] = pack2(ha[2], ha[3]);
        hb.w[2] = pack2(hb2[0], hb2[1]); hb.w[3] = pack2(hb2[2], hb2[3]);
        Y[0][tp] = __builtin_amdgcn_mfma_f32_16x16x32_bf16(ca.v, hb.v, Y[0][tp], 0, 0, 0);
        Y[1][tp] = __builtin_amdgcn_mfma_f32_16x16x32_bf16(cbv.v, hb.v, Y[1][tp], 0, 0, 0);
      }
    }
#pragma unroll
    for (int tl = 0; tl < 2; ++tl)
#pragma unroll
      for (int j = 0; j < 4; ++j) {
        int tau = c0 + tl * 16 + 4 * fq + j;
        if (tau < T) {
          int t = dir ? T - 1 - tau : tau;
          u16* yp = Yd + (long)(base + t) * 512 + g * 256 + r * 64 + fr;
#pragma unroll
          for (int tp = 0; tp < 4; ++tp) yp[tp * 16] = f2bf(bf2f(yp[tp * 16]) + Y[tl][tp][j]);
        }
      }
  }
}

__device__ void ssd_post_phase(const P& p, int l) {
  const u16* PR = (const u16*)((char*)p.out + OD_PROJ);
  const float* dsk = p.in[9] + l * 8;
  const float* nw = p.in[10] + l * 512;
  const u16* Yf = (const u16*)(p.ws + OFF_BR + 2 * SZ_BR);
  const u16* Yb = (const u16*)(p.ws + OFF_BR + 3 * SZ_BR);
  u16* BR1 = (u16*)(p.ws + OFF_BR + 1 * SZ_BR);
  const int lane = tidx() & 63;
  const int wave = (bidx() * 256 + tidx()) >> 6, nwv = gridDim.x * 4;
  const float4 nw0 = *(const float4*)(nw + lane * 8), nw1 = *(const float4*)(nw + lane * 8 + 4);
  const float nwv8[8] = {nw0.x, nw0.y, nw0.z, nw0.w, nw1.x, nw1.y, nw1.z, nw1.w};
  const float dk = dsk[lane >> 3];
  for (int row = wave; row < NT; row += nwv) {
    uint4 xs4 = *(const uint4*)(BR1 + (long)row * 512 + lane * 8);
    uint4 yf4 = *(const uint4*)(Yf + (long)row * 512 + lane * 8);
    uint4 yb4 = *(const uint4*)(Yb + (long)row * 512 + lane * 8);
    uint4 z4 = *(const uint4*)(PR + (long)row * 1552 + lane * 8);
    unsigned xa[4] = {xs4.x, xs4.y, xs4.z, xs4.w}, fa[4] = {yf4.x, yf4.y, yf4.z, yf4.w};
    unsigned ba[4] = {yb4.x, yb4.y, yb4.z, yb4.w}, za[4] = {z4.x, z4.y, z4.z, z4.w};
    float v[8];
    float ss = 0.f;
#pragma unroll
    for (int e = 0; e < 4; ++e) {
      float y0 = (lo2f(fa[e]) + lo2f(ba[e]) + lo2f(xa[e]) * dk) * siluf(lo2f(za[e]));
      float y1 = (hi2f(fa[e]) + hi2f(ba[e]) + hi2f(xa[e]) * dk) * siluf(hi2f(za[e]));
      v[2 * e] = y0; v[2 * e + 1] = y1; ss += y0 * y0 + y1 * y1;
    }
#pragma unroll
    for (int o = 16; o > 0; o >>= 1) ss += bperm(ss, lane ^ o);
    float rr = rsqrtf(ss * (1.f / 256.f) + EPS);
    unsigned o4[4];
#pragma unroll
    for (int e = 0; e < 4; ++e) o4[e] = pack2(v[2 * e] * rr * nwv8[2 * e], v[2 * e + 1] * rr * nwv8[2 * e + 1]);
    *(uint4*)(BR1 + (long)row * 512 + lane * 8) = make_uint4(o4[0], o4[1], o4[2], o4[3]);
  }
}

__device__ void hyena_hid_phase(const P& p, int l) {
  const float* w1 = p.in[12] + l * 33 * 64;
  const float* b1 = p.in[13] + l * 64;
  const float* w2 = p.in[14] + l * 64 * 64;
  const float* b2 = p.in[15] + l * 64;
  const float* fq = p.in[17] + l * 64;
  float* HID = (float*)(p.ws + OFF_HID);
  const int lane = tidx() & 63;
  const int wave = (bidx() * 256 + tidx()) >> 6, nwv = gridDim.x * 4;
  for (int item = wave; item < TP + TS; item += nwv) {
    int T = item < TP ? TP : TS;
    int lag = item < TP ? item : item - TP;
    float tt = (float)lag / (float)(T - 1);
    float wv = (float)(2.0 * 3.14159265358979323846 / (double)T) * (float)lag;
    float z = 0.f;
    if (lane == 0) z = tt;
    else if (lane < 33) {
      int i = (lane - 1) & 15;
      float fr = 1e-4f + (float)i * ((15.f - 1e-4f) / 15.f);
      z = lane < 17 ? cosf(fr * wv) : -sinf(fr * wv);
    }
    float s = b1[lane];
    for (int e = 0; e < 33; ++e) s += bperm(z, e) * w1[e * 64 + lane];
    float h1 = sinf(fq[lane] * s);
    float s2 = b2[lane];
    for (int i = 0; i < 64; ++i) s2 += bperm(h1, i) * w2[i * 64 + lane];
    HID[(long)item * 64 + lane] = sinf(fq[lane] * s2);
  }
}

__device__ __forceinline__ void hyena_kf_phase(const P& p, int l, int first_block, int nblocks) {
  const float* w3 = p.in[16] + (size_t)l * 64 * 2048;
  const float* HID = (const float*)(p.ws + OFF_HID);
  u16* KF = (u16*)(p.ws + OFF_KF);
  float* L1 = (float*)(p.ws + OFF_L1);
  const int lane = tidx() & 63;
  const int bl = bidx() - first_block;
  const int wave = bl * 4 + (tidx() >> 6), nwv = nblocks * 4;
  for (int it2 = (bl < 0 ? 2048 : wave); it2 < 2048; it2 += nwv) {
    const int item = it2 < 1024 ? 1024 + it2 : it2 - 1024;
    int ti = item >> 10, o = (item >> 9) & 1, c = item & 511;
    int T = ti ? TS : TP;
    const float* hid = HID + (ti ? (long)TP * 64 : 0);
    u16* kf = KF + (ti ? 2l * 512 * 4128 : 0) + (long)(o * 512 + c) * 2 * T;
    float delta = fabsf(-3.0701134573253943f + (float)c * ((-15.350567286626972f + 3.0701134573253943f) / 511.f));
    float asum = 0.f;
    {
      const int col0 = (o * 2) * 512 + c, col1 = col0 + 512;
      float wc0[64], wc1[64];
#pragma unroll
      for (int j = 0; j < 64; ++j) { wc0[j] = w3[j * 2048 + col0]; wc1[j] = w3[j * 2048 + col1]; }
      for (int lb = 0; lb < T; lb += 64) {
        int lag = lb + lane;
        if (lag < T) {
          const float4* hp = (const float4*)(hid + (long)lag * 64);
          float s0 = 0.f, s1 = 0.f;
#pragma unroll
          for (int j4 = 0; j4 < 16; ++j4) {
            float4 hv = hp[j4];
            s0 += hv.x * wc0[j4 * 4] + hv.y * wc0[j4 * 4 + 1] + hv.z * wc0[j4 * 4 + 2] + hv.w * wc0[j4 * 4 + 3];
            s1 += hv.x * wc1[j4 * 4] + hv.y * wc1[j4 * 4 + 1] + hv.z * wc1[j4 * 4 + 2] + hv.w * wc1[j4 * 4 + 3];
          }
          float tt = (float)lag / (float)(T - 1);
          float dec = __expf(-tt * delta);
          float v0 = s0 * dec, v1 = s1 * dec;
          asum += fabsf(v0); kf[T + lag] = f2bf(v0);
          if (lag > 0) { asum += fabsf(v1); kf[T - lag] = f2bf(v1); }
        }
      }
    }
    if (lane == 0) kf[0] = 0;
    asum = wave_sum(asum);
    if (lane == 0) L1[item] = asum;
  }
}

__device__ void hyena_prep_phase(const P& p, int l, char* smem) {
  const u16* PR = (const u16*)((char*)p.out + OD_PROJ);
  const float* cw = p.in[11] + l * 3 * 1536;
  u16* tile = (u16*)smem;
  const int tid = tidx();
  const int ntile = (NT / 64) * 8;
  for (int id = bidx(); id < ntile * 3; id += gridDim.x) {
    int part = id / ntile, rem = id % ntile;
    int r0 = (rem >> 3) * 64, c0 = (rem & 7) * 64;
    __syncthreads();
#pragma unroll
    for (int i = 0; i < 2; ++i) {
      int item = tid + 256 * i;
      int rl = item >> 3, cv = (item & 7) * 8;
      int row = r0 + rl; int t, T; row_info(row, t, T);
      int col = part * 512 + c0 + cv;
      const u16* pr = PR + (long)row * 1536 + col;
      uint4 z4 = make_uint4(0, 0, 0, 0);
      uint4 x1 = *(const uint4*)pr, x0 = z4, x2 = z4;
      if (t > 0) x0 = *(const uint4*)(pr - 1536);
      if (t < T - 1) x2 = *(const uint4*)(pr + 1536);
      float4 wa0 = *(const float4*)(cw + col), wa1 = *(const float4*)(cw + col + 4);
      float4 wb0 = *(const float4*)(cw + 1536 + col), wb1 = *(const float4*)(cw + 1536 + col + 4);
      float4 wc0 = *(const float4*)(cw + 3072 + col), wc1 = *(const float4*)(cw + 3072 + col + 4);
      float w0[8] = {wa0.x, wa0.y, wa0.z, wa0.w, wa1.x, wa1.y, wa1.z, wa1.w};
      float w1[8] = {wb0.x, wb0.y, wb0.z, wb0.w, wb1.x, wb1.y, wb1.z, wb1.w};
      float w2[8] = {wc0.x, wc0.y, wc0.z, wc0.w, wc1.x, wc1.y, wc1.z, wc1.w};
      unsigned a0[4] = {x0.x, x0.y, x0.z, x0.w}, a1[4] = {x1.x, x1.y, x1.z, x1.w}, a2[4] = {x2.x, x2.y, x2.z, x2.w};
#pragma unroll
      for (int e = 0; e < 4; ++e) {
        tile[(cv + 2 * e) * 72 + rl] = f2bf(w0[2 * e] * lo2f(a0[e]) + w1[2 * e] * lo2f(a1[e]) + w2[2 * e] * lo2f(a2[e]));
        tile[(cv + 2 * e + 1) * 72 + rl] = f2bf(w0[2 * e + 1] * hi2f(a0[e]) + w1[2 * e + 1] * hi2f(a1[e]) + w2[2 * e + 1] * hi2f(a2[e]));
      }
    }
    __syncthreads();
    u16* o = (u16*)(p.ws + (part == 0 ? OFF_BR + 2 * SZ_BR : (part == 1 ? OFF_BR + 3 * SZ_BR : OFF_X2T)));
#pragma unroll
    for (int i = 0; i < 2; ++i) {
      int item = tid + 256 * i;
      int cl = item >> 3, tv = (item & 7) * 8;
      *(uint4*)(o + (long)(c0 + cl) * NT + r0 + tv) = *(const uint4*)(tile + cl * 72 + tv);
    }
  }
}

template <bool SAMPLE, int ORD>
__device__ __forceinline__ void longconv_task(const P& p, int l, int c, u16* smem16) {
  constexpr int T = SAMPLE ? TS : TP;
  constexpr int W = SAMPLE ? 256 : 128;
  constexpr int NSTRIP = 17;
  constexpr int DMAX = W;
  constexpr int NEW = SAMPLE ? 1 : 2;
  constexpr int NHF = SAMPLE ? 1 : 2;
  constexpr int NB = SAMPLE ? 18 : 9;
  constexpr int PADL = 320;
  constexpr int LK = SAMPLE ? 8832 : 4672;
  constexpr int TW = SAMPLE ? 32 : 16;
  constexpr int R = SAMPLE ? 8 : 16;
  constexpr int LS = 280;
  constexpr int NV = R * 34;
  constexpr int NLD = (NV + 255) / 256;
  u16* kl = smem16;
  u16* ub = smem16 + 2 * 8832;
  const int tid = tidx(), lane = tid & 63, wave = tid >> 6;
  const u16* KF = (const u16*)(p.ws + OFF_KF) + (SAMPLE ? 2l * 512 * 4128 : 0) + (long)(ORD * 512 + c) * 2 * T;
  __syncthreads();
  for (int v = tid; v < LK / 8; v += 256) {
    int idx = v * 8 - PADL;
    uint4 val = (idx >= 0 && idx <= 2 * T - 8) ? *(const uint4*)(KF + idx) : make_uint4(0, 0, 0, 0);
    *(uint4*)(kl + v * 8) = val;
    unsigned prev = (idx - 1 >= 0 && idx - 1 <= 2 * T - 1) ? (unsigned)KF[idx - 1] : 0u;
    uint4 sh;
    sh.x = (val.x << 16) | prev; sh.y = (val.y << 16) | (val.x >> 16); sh.z = (val.z << 16) | (val.y >> 16); sh.w = (val.w << 16) | (val.z >> 16);
    *(uint4*)(kl + LK + v * 8) = sh;
  }
  const unsigned klw = (unsigned)(size_t)(__attribute__((address_space(3))) u16*)(kl + ((lane & 1) ? 0 : LK + 2));
  const u16* U = (ORD == 0 ? (const u16*)(p.ws + OFF_BR + 2 * SZ_BR) : (const u16*)((char*)p.out + OD_PROJ)) + (long)c * NT;
  const u16* X = (ORD == 0 ? (const u16*)(p.ws + OFF_BR + 3 * SZ_BR) : (const u16*)(p.ws + OFF_X2T)) + (long)c * NT;
  const float invl1 = 1.f / ((const float*)(p.ws + OFF_L1))[(SAMPLE ? 1024 : 0) + ORD * 512 + c];
  const float bias = p.in[18][(l * 2 + ORD) * 512 + c];
  const int n = lane & 15, g = lane >> 4;
  const int toff = SAMPLE ? 16 * (n >> 3) : 0;
  const int lrow = SAMPLE ? (n & 7) : n;
  const int lane_s = toff + 8 * g;
  const bf16x8 zero8 = (bf16x8){0, 0, 0, 0, 0, 0, 0, 0};
  int srow[NLD], scol[NLD];
#pragma unroll
  for (int i = 0; i < NLD; ++i) { int v = tid + 256 * i; srow[i] = v / 34; scol[i] = (v - srow[i] * 34) * 8; }
  for (int hf = 0; hf < NHF; ++hf) {
    const int rowbase_blk = SAMPLE ? ROWS_P : hf * 16 * TP;
    for (int rnd = 0; rnd < 5; ++rnd) {
      const int strip = rnd * 4 + wave;
      const bool active = strip < NSTRIP;
      const int t0 = strip * W;
      f32x4 acc[8];
      bf16x8 ring[8];
#pragma unroll
      for (int q = 0; q < 8; ++q) { acc[q] = (f32x4){0.f, 0.f, 0.f, 0.f}; ring[q] = zero8; }
      uint4 st[NLD];
#pragma unroll
      for (int i = 0; i < NLD; ++i) {
        int s = -32 + scol[i];
        bool ok = (tid + 256 * i < NV) && s >= 0 && s <= T - 8;
        st[i] = ok ? *(const uint4*)(U + rowbase_blk + srow[i] * T + s) : make_uint4(0, 0, 0, 0);
      }
      __syncthreads();
#pragma unroll
      for (int i = 0; i < NLD; ++i) if (tid + 256 * i < NV) *(uint4*)(ub + srow[i] * LS + scol[i]) = st[i];
      __syncthreads();
      unsigned x0 = 0, x1 = 0, x2 = 0, x3 = 0;
      if (active) {
        const int li0 = t0 + DMAX + n - 8 * g + T + PADL;
        const unsigned ad = klw + (((li0 - 7) >> 1) << 2);
        asm volatile("ds_read_b32 %0, %4 offset:12\n\tds_read_b32 %1, %4 offset:8\n\tds_read_b32 %2, %4 offset:4\n\tds_read_b32 %3, %4"
                     : "=&v"(x0), "=&v"(x1), "=&v"(x2), "=&v"(x3) : "v"(ad));
      }
      for (int ib = 0; ib < NB; ++ib) {
        const u16* cur = ub + (ib & 1) * (R * LS);
        if (ib + 1 < NB) {
#pragma unroll
          for (int i = 0; i < NLD; ++i) {
            int s = 256 * (ib + 1) - 32 + scol[i];
            bool ok = (tid + 256 * i < NV) && s >= 0 && s <= T - 8;
            st[i] = ok ? *(const uint4*)(U + rowbase_blk + srow[i] * T + s) : make_uint4(0, 0, 0, 0);
          }
        }
        if (active) {
#pragma unroll
          for (int u = 0; u < 8; ++u) {
            const int it = ib * 8 + u;
#pragma unroll
            for (int j = 0; j < NEW; ++j)
              ring[(8 - NEW + j + NEW * u) & 7] = *(const bf16x8*)(cur + lrow * LS + 16 * j + 32 * u + lane_s);
            asm volatile("s_waitcnt lgkmcnt(0)" : "+v"(x0), "+v"(x1), "+v"(x2), "+v"(x3));
            union { bf16x8 v; unsigned w[4]; } avu;
            avu.w[0] = (x0 >> 16) | (x0 << 16); avu.w[1] = (x1 >> 16) | (x1 << 16);
            avu.w[2] = (x2 >> 16) | (x2 << 16); avu.w[3] = (x3 >> 16) | (x3 << 16);
            const bf16x8 av = avu.v;
            {
              const int li0 = t0 + DMAX - 32 * (it + 1) + n - 8 * g + T + PADL;
              const unsigned ad = klw + (((li0 - 7) >> 1) << 2);
              asm volatile("ds_read_b32 %0, %4 offset:12\n\tds_read_b32 %1, %4 offset:8\n\tds_read_b32 %2, %4 offset:4\n\tds_read_b32 %3, %4"
                           : "=&v"(x0), "=&v"(x1), "=&v"(x2), "=&v"(x3) : "v"(ad));
            }
#pragma unroll
            for (int q = 0; q < 8; ++q)
              acc[q] = __builtin_amdgcn_mfma_f32_16x16x32_bf16(av, ring[(q + NEW * u) & 7], acc[q], 0, 0, 0);
          }
        }
        if (ib + 1 < NB) {
          u16* nb = ub + ((ib + 1) & 1) * (R * LS);
#pragma unroll
          for (int i = 0; i < NLD; ++i) if (tid + 256 * i < NV) *(uint4*)(nb + srow[i] * LS + scol[i]) = st[i];
        }
        __syncthreads();
      }
      if (active) {
#pragma unroll
        for (int q = 0; q < 8; ++q) {
          const int t = t0 + TW * q + toff + 4 * g;
          const int rb = rowbase_blk + lrow * T;
          if (t < T) {
            uint2 uu = *(const uint2*)(U + rb + t);
            uint2 xx = *(const uint2*)(X + rb + t);
            float uv[4] = {lo2f(uu.x), hi2f(uu.x), lo2f(uu.y), hi2f(uu.y)};
            float xv[4] = {lo2f(xx.x), hi2f(xx.x), lo2f(xx.y), hi2f(xx.y)};
            float zv[4];
#pragma unroll
            for (int j = 0; j < 4; ++j) zv[j] = xv[j] * (acc[q][j] * invl1 + uv[j] * bias);
            u16* Z = (ORD == 0 ? (u16*)((char*)p.out + OD_PROJ) : (u16*)(p.ws + OFF_BR + 3 * SZ_BR)) + (long)c * NT;
            *(uint2*)(Z + rb + t) = make_uint2(pack2(zv[0], zv[1]), pack2(zv[2], zv[3]));
          }
        }
      }
    }
  }
}

template <int ORD>
__device__ void longconv_phase(const P& p, int l, char* smem) {
  u16* kl = (u16*)smem;
  for (int task = bidx(); task < 1024; task += gridDim.x) {
    int c = task & 511;
    if (task >= 512) longconv_task<true, ORD>(p, l, c, kl);
    else longconv_task<false, ORD>(p, l, c, kl);
  }
}

__device__ void hyena_tr_phase(const P& p, char* smem) {
  const u16* ZT = (const u16*)(p.ws + OFF_BR + 3 * SZ_BR);
  u16* BR2 = (u16*)(p.ws + OFF_BR + 2 * SZ_BR);
  u16* tile = (u16*)smem;
  const int tid = tidx();
  const int ntile = (NT / 64) * 8;
  for (int id = bidx(); id < ntile; id += gridDim.x) {
    int r0 = (id >> 3) * 64, c0 = (id & 7) * 64;
    __syncthreads();
#pragma unroll
    for (int i = 0; i < 2; ++i) {
      int item = tid + 256 * i;
      int cl = item >> 3, tv = (item & 7) * 8;
      uint4 v = *(const uint4*)(ZT + (long)(c0 + cl) * NT + r0 + tv);
      unsigned w4[4] = {v.x, v.y, v.z, v.w};
#pragma unroll
      for (int e = 0; e < 4; ++e) { tile[(tv + 2 * e) * 72 + cl] = (u16)(w4[e] & 0xffffu); tile[(tv + 2 * e + 1) * 72 + cl] = (u16)(w4[e] >> 16); }
    }
    __syncthreads();
#pragma unroll
    for (int i = 0; i < 2; ++i) {
      int item = tid + 256 * i;
      int rl = item >> 3, cv = (item & 7) * 8;
      *(uint4*)(BR2 + (long)(r0 + rl) * 512 + c0 + cv) = *(const uint4*)(tile + rl * 72 + cv);
    }
  }
}

__device__ void sc_phase(const P& p, int l) {
  const u16* PR = (const u16*)((char*)p.out + OD_PROJ);
  const float* cw = p.in[19] + l * 3 * 512;
  u16* BR3 = (u16*)(p.ws + OFF_BR + 3 * SZ_BR);
  for (long i = (long)bidx() * 256 + tidx(); i < (long)NT * 64; i += (long)gridDim.x * 256) {
    int row = (int)(i >> 6), c8 = (int)(i & 63) * 8;
    int t, T; row_info(row, t, T);
    const u16* pr = PR + (long)row * 1536;
    uint4 bg = *(const uint4*)(pr + c8);
    uint4 z4 = make_uint4(0, 0, 0, 0);
    uint4 c1 = *(const uint4*)(pr + 512 + c8), x1 = *(const uint4*)(pr + 1024 + c8);
    uint4 c0 = z4, x0 = z4, c2 = z4, x2 = z4;
    if (t > 0) { c0 = *(const uint4*)(pr - 1536 + 512 + c8); x0 = *(const uint4*)(pr - 1536 + 1024 + c8); }
    if (t < T - 1) { c2 = *(const uint4*)(pr + 1536 + 512 + c8); x2 = *(const uint4*)(pr + 1536 + 1024 + c8); }
    unsigned bga[4] = {bg.x, bg.y, bg.z, bg.w};
    unsigned c0a[4] = {c0.x, c0.y, c0.z, c0.w}, x0a[4] = {x0.x, x0.y, x0.z, x0.w};
    unsigned c1a[4] = {c1.x, c1.y, c1.z, c1.w}, x1a[4] = {x1.x, x1.y, x1.z, x1.w};
    unsigned c2a[4] = {c2.x, c2.y, c2.z, c2.w}, x2a[4] = {x2.x, x2.y, x2.z, x2.w};
    float w0[8], w1[8], w2[8];
    ld8(cw + c8, w0); ld8(cw + 512 + c8, w1); ld8(cw + 1024 + c8, w2);
    unsigned o[4];
#pragma unroll
    for (int e = 0; e < 4; ++e) {
      float lo = lo2f(bga[e]) * (w0[2 * e] * lo2f(c0a[e]) * lo2f(x0a[e]) + w1[2 * e] * lo2f(c1a[e]) * lo2f(x1a[e]) + w2[2 * e] * lo2f(c2a[e]) * lo2f(x2a[e]));
      float hi = hi2f(bga[e]) * (w0[2 * e + 1] * hi2f(c0a[e]) * hi2f(x0a[e]) + w1[2 * e + 1] * hi2f(c1a[e]) * hi2f(x1a[e]) + w2[2 * e + 1] * hi2f(c2a[e]) * hi2f(x2a[e]));
      o[e] = pack2(lo, hi);
    }
    *(uint4*)(BR3 + (long)row * 512 + c8) = make_uint4(o[0], o[1], o[2], o[3]);
  }
}

__device__ void ffn_act_phase(const P& p, int l, int rb, int re) {
  const u16* UP = (const u16*)((char*)p.out + OD_PROJ);
  const float* cw = p.in[23] + (size_t)l * 3 * 5632;
  u16* ACT = (u16*)(p.ws + OFF_BR);
  const long nitem = (long)(re - rb) * 352;
  for (long i = (long)bidx() * 256 + tidx(); i < nitem; i += (long)gridDim.x * 256) {
    int lr = (int)(i / 352), j8 = (int)(i % 352) * 8;
    int row = rb + lr;
    int t, T; row_info(row, t, T);
    const u16* pr = UP + (long)lr * 5632;
    uint4 z4 = make_uint4(0, 0, 0, 0);
    uint4 a1 = *(const uint4*)(pr + j8), v1 = *(const uint4*)(pr + 2816 + j8);
    uint4 a0 = z4, v0 = z4, a2 = z4, v2 = z4;
    if (t > 0) { a0 = *(const uint4*)(pr - 5632 + j8); v0 = *(const uint4*)(pr - 5632 + 2816 + j8); }
    if (t < T - 1) { a2 = *(const uint4*)(pr + 5632 + j8); v2 = *(const uint4*)(pr + 5632 + 2816 + j8); }
    unsigned a0a[4] = {a0.x, a0.y, a0.z, a0.w}, a1a[4] = {a1.x, a1.y, a1.z, a1.w}, a2a[4] = {a2.x, a2.y, a2.z, a2.w};
    unsigned v0a[4] = {v0.x, v0.y, v0.z, v0.w}, v1a[4] = {v1.x, v1.y, v1.z, v1.w}, v2a[4] = {v2.x, v2.y, v2.z, v2.w};
    float wa0[8], wa1[8], wa2[8], wv0[8], wv1[8], wv2[8];
    ld8(cw + j8, wa0); ld8(cw + 5632 + j8, wa1); ld8(cw + 11264 + j8, wa2);
    ld8(cw + 2816 + j8, wv0); ld8(cw + 5632 + 2816 + j8, wv1); ld8(cw + 11264 + 2816 + j8, wv2);
    unsigned o[4];
#pragma unroll
    for (int e = 0; e < 4; ++e) {
      float al = wa0[2 * e] * lo2f(a0a[e]) + wa1[2 * e] * lo2f(a1a[e]) + wa2[2 * e] * lo2f(a2a[e]);
      float ah = wa0[2 * e + 1] * hi2f(a0a[e]) + wa1[2 * e + 1] * hi2f(a1a[e]) + wa2[2 * e + 1] * hi2f(a2a[e]);
      float vl = wv0[2 * e] * lo2f(v0a[e]) + wv1[2 * e] * lo2f(v1a[e]) + wv2[2 * e] * lo2f(v2a[e]);
      float vh = wv0[2 * e + 1] * hi2f(v0a[e]) + wv1[2 * e + 1] * hi2f(v1a[e]) + wv2[2 * e + 1] * hi2f(v2a[e]);
      o[e] = pack2(siluf(al) * vl, siluf(ah) * vh);
    }
    *(uint4*)(ACT + (long)row * 2816 + j8) = make_uint4(o[0], o[1], o[2], o[3]);
  }
}

__device__ __forceinline__ void ffn_gate_rows(const u16* E, int rfirst, int tpos0, int T, int sb, int j0, const float* cw, u16* ACT, int tid) {
#pragma unroll
  for (int it = 0; it < 4; ++it) {
    const int item = tid + 256 * it;
    const int r = rfirst + (item >> 3), cg = (item & 7) * 8;
    const int t = tpos0 + r;
    if ((item >> 3) < 127 && t < T) {
      uint4 ea0 = *(const uint4*)(E + (r - 1) * 136 + cg), ea1 = *(const uint4*)(E + r * 136 + cg), ea2 = *(const uint4*)(E + (r + 1) * 136 + cg);
      uint4 ev0 = *(const uint4*)(E + (r - 1) * 136 + 64 + cg), ev1 = *(const uint4*)(E + r * 136 + 64 + cg), ev2 = *(const uint4*)(E + (r + 1) * 136 + 64 + cg);
      const uint4 z4 = make_uint4(0, 0, 0, 0);
      if (t == 0) { ea0 = z4; ev0 = z4; }
      if (t == T - 1) { ea2 = z4; ev2 = z4; }
      unsigned a0a[4] = {ea0.x, ea0.y, ea0.z, ea0.w}, a1a[4] = {ea1.x, ea1.y, ea1.z, ea1.w}, a2a[4] = {ea2.x, ea2.y, ea2.z, ea2.w};
      unsigned v0a[4] = {ev0.x, ev0.y, ev0.z, ev0.w}, v1a[4] = {ev1.x, ev1.y, ev1.z, ev1.w}, v2a[4] = {ev2.x, ev2.y, ev2.z, ev2.w};
      float wa0[8], wa1[8], wa2[8], wv0[8], wv1[8], wv2[8];
      const int j8 = j0 + cg;
      ld8(cw + j8, wa0); ld8(cw + 5632 + j8, wa1); ld8(cw + 11264 + j8, wa2);
      ld8(cw + 2816 + j8, wv0); ld8(cw + 5632 + 2816 + j8, wv1); ld8(cw + 11264 + 2816 + j8, wv2);
      unsigned o[4];
#pragma unroll
      for (int e = 0; e < 4; ++e) {
        float al = wa0[2 * e] * lo2f(a0a[e]) + wa1[2 * e] * lo2f(a1a[e]) + wa2[2 * e] * lo2f(a2a[e]);
        float ah = wa0[2 * e + 1] * hi2f(a0a[e]) + wa1[2 * e + 1] * hi2f(a1a[e]) + wa2[2 * e + 1] * hi2f(a2a[e]);
        float vl = wv0[2 * e] * lo2f(v0a[e]) + wv1[2 * e] * lo2f(v1a[e]) + wv2[2 * e] * lo2f(v2a[e]);
        float vh = wv0[2 * e + 1] * hi2f(v0a[e]) + wv1[2 * e + 1] * hi2f(v1a[e]) + wv2[2 * e + 1] * hi2f(v2a[e]);
        o[e] = pack2(siluf(al) * vl, siluf(ah) * vh);
      }
      *(uint4*)(ACT + (long)(sb + t) * 2816 + j8) = make_uint4(o[0], o[1], o[2], o[3]);
    }
  }
}

__device__ void ffn_up_fused_phase(const P& p, int l, char* smem) {
  u16* sA = (u16*)smem; u16* sB = sA + 256 * 72;
  u16* E = (u16*)smem;
  const u16* HN = (const u16*)(p.ws + OFF_HN);
  const u16* W = (const u16*)(p.ws + (size_t)l * SZ_WL + OW_UP);
  const float* cw = p.in[23] + (size_t)l * 3 * 5632;
  u16* ACT = (u16*)(p.ws + OFF_BR);
  const int tid = tidx(), lane = tid & 63, wid = tid >> 6, wr = wid >> 1, wc = wid & 1, fr = lane & 15, fq = lane >> 4;
  const int G = gridDim.x, bq = bidx();
  const int bsw = (G & 7) == 0 ? (bq & 7) * (G >> 3) + (bq >> 3) : bq;
  const int ntiles = 424 * 44;
  for (int tile = bsw; tile < ntiles; tile += G) {
    const int mgp = tile / 352, rr = tile - mgp * 352;
    const int nbk = rr >> 5, qq = rr & 31;
    const int mi = mgp * 8 + (qq >> 2), jt = nbk * 4 + (qq & 3);
    int seq, mt;
    if (mi < 288) { seq = mi / 9; mt = mi - seq * 9; } else { int q = mi - 288; seq = 32 + q / 17; mt = q - (q / 17) * 17; }
    const int T = seq < 32 ? TP : TS;
    const int sb = seq_base(seq);
    const int tfirst = 254 * mt - 1;
    const int j0 = jt * 64;
    f32x4 acc[8][4];
#pragma unroll
    for (int m = 0; m < 8; ++m)
#pragma unroll
      for (int n = 0; n < 4; ++n) acc[m][n] = (f32x4){0.f, 0.f, 0.f, 0.f};
    {
      const int lr = tid >> 3, lk = (tid & 7) * 8;
      const u16* pA = HN + (long)(sb + tfirst + lr) * 1024 + lk;
      const u16* pBa = W + (long)(j0 + lr) * 1024 + lk;
      const u16* pBv = W + (long)(2816 + j0 + lr) * 1024 + lk;
      uint4 a0, a1, a2, a3, a4, a5, a6, a7, b0, b1, b2, b3;
#define UP_LOAD(k) do { \
      a0 = *(const uint4*)(pA + (k)); a1 = *(const uint4*)(pA + (k) + 32 * 1024); a2 = *(const uint4*)(pA + (k) + 64 * 1024); a3 = *(const uint4*)(pA + (k) + 96 * 1024); \
      a4 = *(const uint4*)(pA + (k) + 128 * 1024); a5 = *(const uint4*)(pA + (k) + 160 * 1024); a6 = *(const uint4*)(pA + (k) + 192 * 1024); a7 = *(const uint4*)(pA + (k) + 224 * 1024); \
      b0 = *(const uint4*)(pBa + (k)); b1 = *(const uint4*)(pBa + (k) + 32 * 1024); b2 = *(const uint4*)(pBv + (k)); b3 = *(const uint4*)(pBv + (k) + 32 * 1024); } while (0)
      UP_LOAD(0);
      u16* wA = sA + lr * 72 + lk;
      for (int kt = 0; kt < 16; ++kt) {
        __syncthreads();
        *(uint4*)(wA) = a0; *(uint4*)(wA + 32 * 72) = a1; *(uint4*)(wA + 64 * 72) = a2; *(uint4*)(wA + 96 * 72) = a3;
        *(uint4*)(wA + 128 * 72) = a4; *(uint4*)(wA + 160 * 72) = a5; *(uint4*)(wA + 192 * 72) = a6; *(uint4*)(wA + 224 * 72) = a7;
        *(uint4*)(wA + 256 * 72) = b0; *(uint4*)(wA + 288 * 72) = b1; *(uint4*)(wA + 320 * 72) = b2; *(uint4*)(wA + 352 * 72) = b3;
        __syncthreads();
        const int k = (kt + 1 < 16 ? kt + 1 : kt) * 64;
        UP_LOAD(k);
        gemm_compute<true, 8>(acc, sA, sB, wr, wc, fr, fq);
      }
#undef UP_LOAD
    }
    unsigned pk[8][4][2];
#pragma unroll
    for (int m = 0; m < 8; ++m)
#pragma unroll
      for (int n = 0; n < 4; ++n) { pk[m][n][0] = pack2(acc[m][n][0], acc[m][n][1]); pk[m][n][1] = pack2(acc[m][n][2], acc[m][n][3]); }
    __syncthreads();
    if (wr == 0) {
#pragma unroll
      for (int m = 0; m < 8; ++m)
#pragma unroll
        for (int n = 0; n < 4; ++n)
          *(uint2*)(E + (m * 16 + fr) * 136 + wc * 64 + n * 16 + fq * 4) = make_uint2(pk[m][n][0], pk[m][n][1]);
    } else if (fr == 0) {
#pragma unroll
      for (int n = 0; n < 4; ++n)
        *(uint2*)(E + 128 * 136 + wc * 64 + n * 16 + fq * 4) = make_uint2(pk[0][n][0], pk[0][n][1]);
    }
    __syncthreads();
    ffn_gate_rows(E, 1, tfirst, T, sb, j0, cw, ACT, tid);
    __syncthreads();
    if (wr == 1) {
#pragma unroll
      for (int m = 0; m < 8; ++m)
#pragma unroll
        for (int n = 0; n < 4; ++n)
          *(uint2*)(E + (1 + m * 16 + fr) * 136 + wc * 64 + n * 16 + fq * 4) = make_uint2(pk[m][n][0], pk[m][n][1]);
    } else if (fr == 15) {
#pragma unroll
      for (int n = 0; n < 4; ++n)
        *(uint2*)(E + wc * 64 + n * 16 + fq * 4) = make_uint2(pk[7][n][0], pk[7][n][1]);
    }
    __syncthreads();
    ffn_gate_rows(E, 1, tfirst + 127, T, sb, j0, cw, ACT, tid);
  }
}

__device__ void merge_phase(const P& p, int l, char* smem) {
  u16* sA = (u16*)smem; u16* sB = sA + 128 * 72;
  const u16* HN = (const u16*)(p.ws + OFF_HN);
  const char* wl = p.ws + (size_t)l * SZ_WL;
  const u16* Wg = (const u16*)(wl + OW_IN) + (size_t)5136 * 1024;
  const u16* Wb = (const u16*)(wl + OW_BR);
  u16* MG = (u16*)((char*)p.out + OD_PROJ);
  const int nN = 8, nM = NT / 128;
  const int G = gridDim.x, bq = bidx();
  const int bsw = (G & 7) == 0 ? (bq & 7) * (G >> 3) + (bq >> 3) : bq;
  for (int tile = bsw; tile < nM * nN; tile += G) {
    int m0 = (tile / nN) * 128, n0 = (tile % nN) * 128;
    unsigned mgp[4][4][2];
#pragma unroll
    for (int m = 0; m < 4; ++m)
#pragma unroll
      for (int n = 0; n < 4; ++n) { mgp[m][n][0] = 0u; mgp[m][n][1] = 0u; }
    for (int k = 0; k < 4; ++k) {
      unsigned gate[4][4][2];
      {
        f32x4 acc[4][4];
#pragma unroll
        for (int m = 0; m < 4; ++m)
#pragma unroll
          for (int n = 0; n < 4; ++n) acc[m][n] = (f32x4){0.f, 0.f, 0.f, 0.f};
        GA g{HN, 1024, NT, Wg + (size_t)k * 1024 * 1024, 1024, 1024, 1024};
        gemm_main_db_4<true>(g, m0, n0, acc, sA);
#pragma unroll
        for (int m = 0; m < 4; ++m)
#pragma unroll
          for (int n = 0; n < 4; ++n) {
            gate[m][n][0] = pack2(sigmf(acc[m][n][0]), sigmf(acc[m][n][1]));
            gate[m][n][1] = pack2(sigmf(acc[m][n][2]), sigmf(acc[m][n][3]));
          }
      }
      {
        f32x4 acc[4][4];
#pragma unroll
        for (int m = 0; m < 4; ++m)
#pragma unroll
          for (int n = 0; n < 4; ++n) acc[m][n] = (f32x4){0.f, 0.f, 0.f, 0.f};
        GA g{(const u16*)(p.ws + OFF_BR + (size_t)k * SZ_BR), 512, NT, Wb + (size_t)k * 1024 * 512, 512, 1024, 512};
        gemm_main_db_4<true>(g, m0, n0, acc, sA);
#pragma unroll
        for (int m = 0; m < 4; ++m)
#pragma unroll
          for (int n = 0; n < 4; ++n) {
            mgp[m][n][0] = pack2(lo2f(mgp[m][n][0]) + lo2f(gate[m][n][0]) * acc[m][n][0], hi2f(mgp[m][n][0]) + hi2f(gate[m][n][0]) * acc[m][n][1]);
            mgp[m][n][1] = pack2(lo2f(mgp[m][n][1]) + lo2f(gate[m][n][1]) * acc[m][n][2], hi2f(mgp[m][n][1]) + hi2f(gate[m][n][1]) * acc[m][n][3]);
          }
      }
    }
    const int lane = tidx() & 63, wid = tidx() >> 6, wr = wid >> 1, wc = wid & 1, fr = lane & 15, fq = lane >> 4;
#pragma unroll
    for (int m = 0; m < 4; ++m)
#pragma unroll
      for (int n = 0; n < 4; ++n) {
        int row = m0 + wr * 64 + m * 16 + fr, col = n0 + wc * 64 + n * 16 + fq * 4;
        *(uint2*)(MG + (long)row * 1024 + col) = make_uint2(mgp[m][n][0], mgp[m][n][1]);
      }
  }
}

__global__ void __launch_bounds__(256, 2) hybrid_fwd(P p) {
  cg::grid_group grid = cg::this_grid();
  __shared__ __attribute__((aligned(16))) char smem[55296];
  u16* H = (u16*)(p.ws + OFF_H);
  u16* HN = (u16*)(p.ws + OFF_HN);
  u16* PROJ = (u16*)((char*)p.out + OD_PROJ);

  __shared__ uint4 xb_words;
  if (threadIdx.x == 0) xb_words = make_uint4(0u, 0u, 0u, 0u);
  __syncthreads();
  XcdBarrier xb = xcd_barrier_post((unsigned*)(p.ws + OFF_BAR), (volatile LAS unsigned*)&xb_words);
  prep_phase(p, smem);
  grid.sync();

  for (int l = 0; l < 2; ++l) {
    const char* wl = p.ws + (size_t)l * SZ_WL;
    for (int rep = 0; rep < REPE; ++rep) rmsnorm_phase(H, p.in[3] + l * 1024, HN, nullptr, 0);
    for (int rep = 0; rep < REPE; ++rep) hyena_hid_phase(p, l);
    GSYNC();
    {
      GA g{HN, 1024, NT, (const u16*)(wl + OW_FN), 1024, 1024, 1024};
      gemm_phase256<false>(g, [&](int row, int col, f32x4 v) {
        if (row >= NT) return;
        int t, T; row_info(row, t, T);
        const int Th = T == TP ? THP : THS;
        long gb = T == TP ? (long)(row / TP) * (512l * 2 * THP) : GT_SAMPLE0 + (long)((row - ROWS_P) / TS) * (512l * 2 * THS);
        int c = col & 511, half = col >> 9;
        *(uint2*)(PROJ + gb + (long)(c * 2 + half) * Th + t) = make_uint2(pack2(v[0], v[1]), pack2(v[2], v[3]));
      }, smem, REPG);
      for (long i = (long)bidx() * 256 + tidx(); i < 40l * 1024 * 6; i += (long)gridDim.x * 256) {
        int rowi = (int)(i / 6), v6 = (int)(i % 6);
        int seq = rowi >> 10, ch = rowi & 1023;
        long off = seq < 32 ? (long)seq * (512l * 2 * THP) + (long)ch * THP + TP : GT_SAMPLE0 + (long)(seq - 32) * (512l * 2 * THS) + (long)ch * THS + TS;
        unsigned zz = 0; asm volatile("" : "+v"(zz));
        *(uint4*)(PROJ + off + v6 * 8) = make_uint4(zz, zz, zz, zz);
      }
    }
    GSYNC();
    {
      u16* BR0 = (u16*)(p.ws + OFF_BR);
      u16* sA = (u16*)smem; u16* sB = sA + 128 * 72;
      const int tiles_s = 8 * 17 * 4, tiles_p = 32 * 9 * 4;
      const int Gd = gridDim.x, bd = bidx();
      const bool bal = (Gd == 512);
      const int nslot = bal ? 4 : (tiles_s + tiles_p + Gd - 1) / Gd;
      for (int rep = 0; rep < REPG; ++rep)
      for (int slot = 0; slot < nslot; ++slot) {
        int tile;
        if (bal) {
          if (slot == 0) tile = bd;
          else if (bd < 32) tile = slot == 1 ? 512 + bd : (slot == 2 ? tiles_s + bd : -1);
          else { int pi = 32 + (bd - 32) + 480 * (slot - 1); tile = pi < tiles_p ? tiles_s + pi : -1; }
        } else tile = bd + slot * Gd;
        if (tile < 0 || tile >= tiles_s + tiles_p) continue;
        int seq, mt, nt, T, Th;
        if (tile < tiles_s) { mt = tile / 32; int r = tile % 32; seq = 32 + (r >> 2); nt = r & 3; T = TS; Th = THS; }
        else { int q = tile - tiles_s; mt = q / 128; int r = q % 128; seq = r >> 2; nt = r & 3; T = TP; Th = THP; }
        const int sb = seq_base(seq);
        const u16* Am = (const u16*)((char*)p.out + (T == TS ? OD_DFTS : OD_DFTP));
        const u16* Bm = PROJ + (seq < 32 ? (long)seq * (512l * 2 * THP) : GT_SAMPLE0 + (long)(seq - 32) * (512l * 2 * THS));
        f32x4 accP[4][4], accQ[4][4];
#pragma unroll
        for (int m = 0; m < 4; ++m)
#pragma unroll
          for (int n = 0; n < 4; ++n) { accP[m][n] = (f32x4){0.f, 0.f, 0.f, 0.f}; accQ[m][n] = (f32x4){0.f, 0.f, 0.f, 0.f}; }
        {
          GA g{Am, 2l * Th, T, Bm, 2l * Th, 512, Th};
          gemm_main2_4<true>(g, mt * 128, nt * 128, accP, sA, sB);
        }
        {
          GA g{Am + Th, 2l * Th, T, Bm + Th, 2l * Th, 512, Th};
          gemm_main2_4<true>(g, mt * 128, nt * 128, accQ, sA, sB);
        }
        const float sc = rsqrtf((float)T * 128.f);
        const int lane = tidx() & 63, wid = tidx() >> 6, wr = wid >> 1, wc = wid & 1, fr = lane & 15, fq = lane >> 4;
#pragma unroll
        for (int m = 0; m < 4; ++m)
#pragma unroll
          for (int n = 0; n < 4; ++n) {
            int row = mt * 128 + wr * 64 + m * 16 + fr, col = nt * 128 + wc * 64 + n * 16 + fq * 4;
            f32x4 pv = accP[m][n], qv = accQ[m][n];
            if (row <= T / 2)
              *(uint2*)(BR0 + (long)(sb + row) * 512 + col) = make_uint2(pack2((pv[0] - qv[0]) * sc, (pv[1] - qv[1]) * sc), pack2((pv[2] - qv[2]) * sc, (pv[3] - qv[3]) * sc));
            if (row >= 1 && row < T / 2)
              *(uint2*)(BR0 + (long)(sb + T - row) * 512 + col) = make_uint2(pack2((pv[0] + qv[0]) * sc, (pv[1] + qv[1]) * sc), pack2((pv[2] + qv[2]) * sc, (pv[3] + qv[3]) * sc));
          }
      }
    }
    GSYNC();
    {
      GA g{HN, 1024, NT, (const u16*)(wl + OW_IN) + (size_t)512 * 1024, 1024, 1552, 1024};
      gemm_phase256<true>(g, [&](int row, int col, f32x4 v) {
        if (col < 1552 && row < NT) *(uint2*)(PROJ + (long)row * 1552 + col) = make_uint2(pack2(v[0], v[1]), pack2(v[2], v[3]));
      }, smem, REPG);
    }
    GSYNC();
    ssd_conv_phase(p, l);
    GSYNC();
    for (int rep = 0; rep < REPS; ++rep) ssd_scan_phase(p, l, smem);
    { const int kf0 = (int)gridDim.x > 384 ? 384 : 0; hyena_kf_phase(p, l, kf0, (int)gridDim.x - kf0); }
    GSYNC();
    ssd_state_phase(p);
    GSYNC();
    ssd_fix_phase(p);
    GSYNC();
    for (int rep = 0; rep < REPE; ++rep) ssd_post_phase(p, l);
    GSYNC();
    {
      GA g{HN, 1024, NT, (const u16*)(wl + OW_IN) + (size_t)2064 * 1024, 1024, 1536, 1024};
      gemm_phase256<true>(g, [&](int row, int col, f32x4 v) {
        if (row < NT) *(uint2*)(PROJ + (long)row * 1536 + col) = make_uint2(pack2(v[0], v[1]), pack2(v[2], v[3]));
      }, smem, REPG);
    }
    GSYNC();
    for (int rep = 0; rep < REPE; ++rep) hyena_prep_phase(p, l, smem);
    GSYNC();
    for (int rep = 0; rep < REPL; ++rep) longconv_phase<0>(p, l, smem);
    GSYNC();
    for (int rep = 0; rep < REPL; ++rep) longconv_phase<1>(p, l, smem);
    GSYNC();
    hyena_tr_phase(p, smem);
    GSYNC();
    {
      GA g{HN, 1024, NT, (const u16*)(wl + OW_IN) + (size_t)3600 * 1024, 1024, 1536, 1024};
      gemm_phase256<true>(g, [&](int row, int col, f32x4 v) {
        if (row < NT) *(uint2*)(PROJ + (long)row * 1536 + col) = make_uint2(pack2(v[0], v[1]), pack2(v[2], v[3]));
      }, smem, REPG);
    }
    GSYNC();
    for (int rep = 0; rep < REPE; ++rep) sc_phase(p, l);
    GSYNC();
    for (int rep = 0; rep < REPG; ++rep) merge_phase(p, l, smem);
    GSYNC();
    {
      GA g{PROJ, 1024, NT, (const u16*)(wl + OW_OUT), 1024, 1024, 1024};
      gemm_phase256<true>(g, [&](int row, int col, f32x4 v) {
        if (row >= NT) return;
        uint2* hp = (uint2*)(H + (long)row * 1024 + col);
        uint2 o = *hp;
        *hp = make_uint2(pack2(lo2f(o.x) + v[0], hi2f(o.x) + v[1]), pack2(lo2f(o.y) + v[2], hi2f(o.y) + v[3]));
      }, smem, 1);
    }
    GSYNC();
    for (int rep = 0; rep < REPE; ++rep) rmsnorm_phase(H, p.in[22] + l * 1024, HN, nullptr, 0);
    GSYNC();
    for (int rep = 0; rep < REPG; ++rep) ffn_up_fused_phase(p, l, smem);
    GSYNC();
    {
      GA g{(const u16*)(p.ws + OFF_BR), 2816, NT, (const u16*)(wl + OW_DOWN), 2816, 1024, 2816};
      gemm_phase256<true>(g, [&](int row, int col, f32x4 v) {
        if (row >= NT) return;
        uint2* hp = (uint2*)(H + (long)row * 1024 + col);
        uint2 o = *hp;
        *hp = make_uint2(pack2(lo2f(o.x) + v[0], hi2f(o.x) + v[1]), pack2(lo2f(o.y) + v[2], hi2f(o.y) + v[3]));
      }, smem, 1);
    }
    GSYNC();
  }
  final_phase(p);
}

extern "C" void kernel_launch(void* const* d_in, const int* in_sizes, int n_in, void* d_out, int out_size,
                              void* d_ws, size_t ws_size, hipStream_t stream) {
  static int grid_blocks = 0;
  if (!grid_blocks) {
    int dev = 0, cus = 0, per_cu = 0;
    (void)hipGetDevice(&dev);
    (void)hipDeviceGetAttribute(&cus, hipDeviceAttributeMultiprocessorCount, dev);
    (void)hipOccupancyMaxActiveBlocksPerMultiprocessor(&per_cu, hybrid_fwd, 256, 0);
    if (per_cu > 2) per_cu = 2;
    grid_blocks = cus * per_cu;
  }
  if (ws_size < WS_TOTAL) { fprintf(stderr, "workspace too small: %zu < %zu\n", ws_size, (size_t)WS_NEED); return; }
  (void)hipMemsetAsync((char*)d_ws + OFF_BAR, 0, XCD_BAR_WORDS_C * 4, stream);
  P p{};
  for (int i = 0; i < 27; ++i) p.in[i] = (const float*)d_in[i];
  p.out = (float*)d_out;
  p.ws = (char*)d_ws;
  void* args[] = {&p};
  hipError_t e = hipLaunchCooperativeKernel((void*)hybrid_fwd, dim3(grid_blocks), dim3(256), args, 0, stream);
  if (e != hipSuccess) fprintf(stderr, "cooperative launch failed: %s (grid %d)\n", hipGetErrorString(e), grid_blocks);
}
```

```cpp
#include <hip/hip_runtime.h>
#include <hip/hip_cooperative_groups.h>
#include <cstdio>
namespace cg = cooperative_groups;

typedef unsigned short u16;
using bf16x8 = __attribute__((ext_vector_type(8))) short;
using f32x4 = __attribute__((ext_vector_type(4))) float;

constexpr int NT = 98944, TP = 2064, TS = 4112, ROWS_P = 32 * 2064;
constexpr int DIN = 9232;
constexpr float EPS = 1e-6f;
constexpr int XCD_BAR_WORDS_C = 3456;
#ifndef REPG
#define REPG 1
#endif
#ifndef REPL
#define REPL 1
#endif
#ifndef REPS
#define REPS 1
#endif
#ifndef REPE
#define REPE 1
#endif
#ifndef REPY
#define REPY 1
#endif
#define GSYNC() do { for (int rs_ = 0; rs_ < REPY; ++rs_) xcd_barrier_impl(xb.bar, xb.x, xb.st); } while (0)

constexpr size_t SZ_WL = 44597248ull;
constexpr size_t OW_IN = 0, OW_FN = 18907136ull, OW_BR = OW_FN + 2097152ull, OW_OUT = OW_BR + 4194304ull,
                 OW_UP = OW_OUT + 2097152ull, OW_DOWN = OW_UP + 11534336ull;
constexpr size_t OFF_H = 2 * SZ_WL;
constexpr size_t SZ_ACT = (size_t)NT * 1024 * 2;
constexpr size_t OFF_HN = OFF_H + SZ_ACT;
constexpr size_t OFF_BR = OFF_HN + SZ_ACT;
constexpr size_t SZ_BR = (size_t)NT * 512 * 2;
constexpr size_t OFF_X2T = OFF_BR + 4 * SZ_BR;
constexpr size_t OFF_KF = OFF_X2T + SZ_BR;
constexpr size_t SZ_KF = 2ull * 512 * (4128 + 8224) * 2;
constexpr size_t OFF_HID = OFF_KF + SZ_KF;
constexpr size_t SZ_HID = (size_t)(TP + TS) * 64 * 4;
constexpr size_t OFF_L1 = OFF_HID + SZ_HID;
constexpr size_t WS_NEED = OFF_BR + (size_t)NT * 2816 * 2;
constexpr size_t OFF_BAR = (WS_NEED + 4095) / 4096 * 4096;
constexpr size_t WS_TOTAL = OFF_BAR + XCD_BAR_WORDS_C * 4;
constexpr int THP = 2112, THS = 4160;
constexpr int MHP = 9 * 128, MHS = 17 * 128;
constexpr size_t OD_DFTP = 0, OD_DFTS = (size_t)MHP * 2 * THP * 2, OD_PROJ = OD_DFTS + (size_t)MHS * 2 * THS * 2;
constexpr size_t OD_HS = OD_PROJ + (size_t)NT * 1552 * 2;
constexpr size_t OD_DS = OD_HS + 4ull * 56 * 4 * 8192 * 4;
constexpr size_t OD_CSG = OD_DS + 4ull * 56 * 4 * 4;
constexpr int SEGC = 33;
constexpr long GT_SAMPLE0 = 32l * 512 * 2 * THP;

struct P {
  const float* in[27];
  float* out;
  char* ws;
};

__device__ __forceinline__ u16 f2bf(float f) {
  unsigned u = __float_as_uint(f);
  u += 0x7fffu + ((u >> 16) & 1u);
  return (u16)(u >> 16);
}
__device__ __forceinline__ float bf2f(u16 h) { return __uint_as_float(((unsigned)h) << 16); }
__device__ __forceinline__ unsigned pack2(float a, float b) { return (unsigned)f2bf(a) | ((unsigned)f2bf(b) << 16); }
__device__ __forceinline__ float lo2f(unsigned u) { return __uint_as_float(u << 16); }
__device__ __forceinline__ float hi2f(unsigned u) { return __uint_as_float(u & 0xffff0000u); }
__device__ __forceinline__ float siluf(float x) { return x / (1.f + __expf(-x)); }
__device__ __forceinline__ float sigmf(float x) { return 1.f / (1.f + __expf(-x)); }

__device__ __forceinline__ int tidx() { int t = threadIdx.x; asm volatile("" : "+v"(t)); return t; }
__device__ __forceinline__ int bidx() { int b = blockIdx.x; asm volatile("" : "+s"(b)); return b; }
__device__ __forceinline__ void ld8(const float* p, float (&w)[8]) {
  float4 a = *(const float4*)p, b = *(const float4*)(p + 4);
  w[0] = a.x; w[1] = a.y; w[2] = a.z; w[3] = a.w; w[4] = b.x; w[5] = b.y; w[6] = b.z; w[7] = b.w;
}
__device__ __forceinline__ int seq_base(int seq) { return seq < 32 ? seq * TP : ROWS_P + (seq - 32) * TS; }
__device__ __forceinline__ void row_info(int r, int& t, int& T) {
  if (r < ROWS_P) { t = r % TP; T = TP; } else { t = (r - ROWS_P) % TS; T = TS; }
}
__device__ __forceinline__ float bperm(float v, int src_lane) {
  return __int_as_float(__builtin_amdgcn_ds_bpermute(src_lane << 2, __float_as_int(v)));
}
__device__ __forceinline__ float wave_sum(float v) {
  const int lane = tidx() & 63;
#pragma unroll
  for (int o = 32; o > 0; o >>= 1) v += bperm(v, lane ^ o);
  return v;
}


#define XB_TMO      128
#define XB_XCNT(j)  (256  + 64 * (j))
#define XB_XSUB(j)  (1280 + 64 * (j))
#define XB_XGEN(j)  (2304 + 64 * (j))
#define XB_TOP      3328
#define XB_TOPGEN   3392
#define XCD_BAR_WORDS 3456
#define XB_SPIN_CAP (1u << 24)
#define LAS __attribute__((address_space(3)))
__device__ __forceinline__ unsigned xb_ld(unsigned* p)              { return __hip_atomic_load(p, __ATOMIC_RELAXED, __HIP_MEMORY_SCOPE_AGENT); }
__device__ __forceinline__ unsigned xb_add(unsigned* p, unsigned v) { return __hip_atomic_fetch_add(p, v, __ATOMIC_RELAXED, __HIP_MEMORY_SCOPE_AGENT); }
__device__ __forceinline__ unsigned xb_xcc_id() { return (unsigned)__builtin_amdgcn_s_getreg((3 << 11) | 20) & 0xFu; }
#define XB_SPIN(cond, bar) do { unsigned _sp = 0; while (cond) { __builtin_amdgcn_s_sleep(1); \
    if ((++_sp & 255u) == 0u) { if (xb_ld(&(bar)[XB_TMO])) break; if (_sp > XB_SPIN_CAP) { atomicAdd(&(bar)[XB_TMO], 1u); break; } } } } while (0)
struct XcdBarrier { unsigned* bar; unsigned x; volatile LAS unsigned* st; };
__device__ __forceinline__ XcdBarrier xcd_barrier_post(unsigned* bar, volatile LAS unsigned* st) {
  XcdBarrier b; b.bar = bar; b.x = xb_xcc_id(); b.st = st;
  if (threadIdx.x == 0) (void)xb_add(&bar[XB_XCNT(b.x)], 1u);
  return b;
}
__device__ __forceinline__ void xcd_barrier_complete(unsigned* bar, unsigned x, unsigned& nloc, unsigned& nx) {
  const unsigned G = gridDim.x * gridDim.y * gridDim.z;
  unsigned sum, cnt, mine, sp = 0u;
  for (;;) {
    sum = 0u; cnt = 0u; mine = 0u;
#pragma unroll
    for (unsigned j = 0; j < 16; ++j) { const unsigned c = xb_ld(&bar[XB_XCNT(j)]); sum += c; cnt += (c > 0u) ? 1u : 0u; mine = (j == x) ? c : mine; }
    if (sum == G) break;
    __builtin_amdgcn_s_sleep(1);
    if ((++sp & 255u) == 0u) { if (xb_ld(&bar[XB_TMO])) break; if (sp > XB_SPIN_CAP) { atomicAdd(&bar[XB_TMO], 1u); break; } }
  }
  nloc = mine > 0u ? mine : 1u; nx = cnt > 0u ? cnt : 1u;
}
__device__ __noinline__ void xcd_barrier_impl(unsigned* bar, unsigned bx, volatile LAS unsigned* st) {
  XcdBarrier b; b.bar = bar; b.x = bx; b.st = st;
  asm volatile("s_waitcnt vmcnt(0)" ::: "memory");
  __syncthreads();
  if (threadIdx.x == 0) {
    unsigned* bar = b.bar;
    __builtin_amdgcn_s_waitcnt(0);
    unsigned nloc = b.st[0], nx = b.st[1];
    if (nloc == 0u) { xcd_barrier_complete(bar, b.x, nloc, nx); b.st[0] = nloc; b.st[1] = nx; }
    const unsigned old = xb_add(&bar[XB_XSUB(b.x)], 1u);
    const unsigned gen = old / nloc;
    if (old + 1u == (gen + 1u) * nloc) {
      __builtin_amdgcn_fence(__ATOMIC_RELEASE, "agent");
      asm volatile("s_waitcnt vmcnt(0)" ::: "memory");
      const unsigned og = xb_add(&bar[XB_TOP], 1u);
      const unsigned tg = og / nx;
      if (og + 1u == (tg + 1u) * nx) xb_add(&bar[XB_TOPGEN], 1u);
      else XB_SPIN(xb_ld(&bar[XB_TOPGEN]) == tg, bar);
      __builtin_amdgcn_fence(__ATOMIC_ACQUIRE, "agent");
      xb_add(&bar[XB_XGEN(b.x)], 1u);
      asm volatile("s_waitcnt vmcnt(0)" ::: "memory");
    } else {
      XB_SPIN(xb_ld(&bar[XB_XGEN(b.x)]) == gen, bar);
      __builtin_amdgcn_fence(__ATOMIC_ACQUIRE, "agent");
      asm volatile("s_waitcnt vmcnt(0)" ::: "memory");
    }
  }
  __syncthreads();
}

struct GA { const u16* A; long lda; int M; const u16* B; long ldb; int N; int K; };

__device__ __forceinline__ uint4 ld_mask(const u16* base, long ld, int r, int R, int k, int K) {
  const bool ok = (r < R) && (k < K);
  const int rr = r < R ? r : R - 1;
  const int kk = k < K ? k : 0;
  uint4 v = *(const uint4*)(base + (long)rr * ld + kk);
  v.x = ok ? v.x : 0u; v.y = ok ? v.y : 0u; v.z = ok ? v.z : 0u; v.w = ok ? v.w : 0u;
  return v;
}

template <bool SWAP, int MW>
__device__ __forceinline__ void gemm_compute(f32x4 (&acc)[MW][4], const u16* sA, const u16* sB, int wr, int wc, int fr, int fq) {
  constexpr int MG = MW < 4 ? MW : 4;
#pragma unroll
  for (int kk = 0; kk < 2; ++kk) {
    bf16x8 bfr[4];
#pragma unroll
    for (int n = 0; n < 4; ++n) bfr[n] = *(const bf16x8*)(sB + (wc * 64 + n * 16 + fr) * 72 + kk * 32 + fq * 8);
#pragma unroll
    for (int mg = 0; mg < MW / MG; ++mg) {
      bf16x8 af[MG];
#pragma unroll
      for (int m = 0; m < MG; ++m) af[m] = *(const bf16x8*)(sA + (wr * (MW * 16) + (mg * MG + m) * 16 + fr) * 72 + kk * 32 + fq * 8);
#pragma unroll
      for (int m = 0; m < MG; ++m)
#pragma unroll
        for (int n = 0; n < 4; ++n)
          acc[mg * MG + m][n] = SWAP ? __builtin_amdgcn_mfma_f32_16x16x32_bf16(bfr[n], af[m], acc[mg * MG + m][n], 0, 0, 0)
                                     : __builtin_amdgcn_mfma_f32_16x16x32_bf16(af[m], bfr[n], acc[mg * MG + m][n], 0, 0, 0);
    }
  }
}

template <bool SWAP, int MW = 4>
__device__ __forceinline__ void gemm_main(const GA& g, int m0, int n0, f32x4 (&acc)[MW][4], u16* sA, u16* sB) {
  const int tid = tidx(), lane = tid & 63, wid = tid >> 6, wr = wid >> 1, wc = wid & 1, fr = lane & 15, fq = lane >> 4;
  uint4 ra0[MW], rb0[4], ra1[MW], rb1[4];
  const int nk = (g.K + 63) >> 6;
  const int lr = tid >> 3, lk = (tid & 7) * 8;
#pragma unroll
  for (int i = 0; i < MW; ++i) ra0[i] = ld_mask(g.A, g.lda, m0 + lr + i * 32, g.M, lk, g.K);
#pragma unroll
  for (int i = 0; i < 4; ++i) rb0[i] = ld_mask(g.B, g.ldb, n0 + lr + i * 32, g.N, lk, g.K);
#pragma unroll
  for (int i = 0; i < MW; ++i) ra1[i] = ld_mask(g.A, g.lda, m0 + lr + i * 32, g.M, 64 + lk, g.K);
#pragma unroll
  for (int i = 0; i < 4; ++i) rb1[i] = ld_mask(g.B, g.ldb, n0 + lr + i * 32, g.N, 64 + lk, g.K);
  for (int kt = 0; kt < nk; kt += 2) {
    __syncthreads();
#pragma unroll
    for (int i = 0; i < MW; ++i) *(uint4*)(sA + (lr + i * 32) * 72 + lk) = ra0[i];
#pragma unroll
    for (int i = 0; i < 4; ++i) *(uint4*)(sB + (lr + i * 32) * 72 + lk) = rb0[i];
    __syncthreads();
    if (kt + 2 < nk) {
      const int k = (kt + 2) * 64 + lk;
#pragma unroll
      for (int i = 0; i < MW; ++i) ra0[i] = ld_mask(g.A, g.lda, m0 + lr + i * 32, g.M, k, g.K);
#pragma unroll
      for (int i = 0; i < 4; ++i) rb0[i] = ld_mask(g.B, g.ldb, n0 + lr + i * 32, g.N, k, g.K);
    }
    gemm_compute<SWAP, MW>(acc, sA, sB, wr, wc, fr, fq);
    if (kt + 1 < nk) {
      __syncthreads();
#pragma unroll
      for (int i = 0; i < MW; ++i) *(uint4*)(sA + (lr + i * 32) * 72 + lk) = ra1[i];
#pragma unroll
      for (int i = 0; i < 4; ++i) *(uint4*)(sB + (lr + i * 32) * 72 + lk) = rb1[i];
      __syncthreads();
      if (kt + 3 < nk) {
        const int k = (kt + 3) * 64 + lk;
#pragma unroll
        for (int i = 0; i < MW; ++i) ra1[i] = ld_mask(g.A, g.lda, m0 + lr + i * 32, g.M, k, g.K);
#pragma unroll
        for (int i = 0; i < 4; ++i) rb1[i] = ld_mask(g.B, g.ldb, n0 + lr + i * 32, g.N, k, g.K);
      }
      gemm_compute<SWAP, MW>(acc, sA, sB, wr, wc, fr, fq);
    }
  }
}

template <bool SWAP, int MW>
__device__ __forceinline__ void gemm_main1(const GA& g, int m0, int n0, f32x4 (&acc)[MW][4], u16* sA, u16* sB) {
  static_assert(MW == 8, "256-row tile");
  const int tid = tidx(), lane = tid & 63, wid = tid >> 6, wr = wid >> 1, wc = wid & 1, fr = lane & 15, fq = lane >> 4;
  const int nk = (g.K + 63) >> 6;
  const int lr = tid >> 3, lk = (tid & 7) * 8;
  const u16* pA = g.A + (long)(m0 + lr) * g.lda + lk;
  const u16* pB = g.B + (long)(n0 + lr) * g.ldb + lk;
  const long sa = 32 * g.lda, sb = 32 * g.ldb;
  uint4 a0, a1, a2, a3, a4, a5, a6, a7, b0, b1, b2, b3;
#define GL_LOAD(k) do { \
    a0 = *(const uint4*)(pA + (k)); a1 = *(const uint4*)(pA + (k) + sa); a2 = *(const uint4*)(pA + (k) + 2 * sa); a3 = *(const uint4*)(pA + (k) + 3 * sa); \
    a4 = *(const uint4*)(pA + (k) + 4 * sa); a5 = *(const uint4*)(pA + (k) + 5 * sa); a6 = *(const uint4*)(pA + (k) + 6 * sa); a7 = *(const uint4*)(pA + (k) + 7 * sa); \
    b0 = *(const uint4*)(pB + (k)); b1 = *(const uint4*)(pB + (k) + sb); b2 = *(const uint4*)(pB + (k) + 2 * sb); b3 = *(const uint4*)(pB + (k) + 3 * sb); } while (0)
  GL_LOAD(0);
  u16* wA = sA + lr * 72 + lk;
  u16* wB = sB + lr * 72 + lk;
  for (int kt = 0; kt < nk; ++kt) {
    __syncthreads();
    *(uint4*)(wA) = a0; *(uint4*)(wA + 32 * 72) = a1; *(uint4*)(wA + 64 * 72) = a2; *(uint4*)(wA + 96 * 72) = a3;
    *(uint4*)(wA + 128 * 72) = a4; *(uint4*)(wA + 160 * 72) = a5; *(uint4*)(wA + 192 * 72) = a6; *(uint4*)(wA + 224 * 72) = a7;
    *(uint4*)(wB) = b0; *(uint4*)(wB + 32 * 72) = b1; *(uint4*)(wB + 64 * 72) = b2; *(uint4*)(wB + 96 * 72) = b3;
    __syncthreads();
    const int k = (kt + 1 < nk ? kt + 1 : kt) * 64;
    GL_LOAD(k);
    gemm_compute<SWAP, MW>(acc, sA, sB, wr, wc, fr, fq);
  }
#undef GL_LOAD
}

template <bool SWAP>
__device__ __forceinline__ void gemm_main1_4(const GA& g, int m0, int n0, f32x4 (&acc)[4][4], u16* sA, u16* sB) {
  const int tid = tidx(), lane = tid & 63, wid = tid >> 6, wr = wid >> 1, wc = wid & 1, fr = lane & 15, fq = lane >> 4;
  const int nk = (g.K + 63) >> 6;
  const int lr = tid >> 3, lk = (tid & 7) * 8;
  const u16* pA = g.A + (long)(m0 + lr) * g.lda + lk;
  const u16* pB = g.B + (long)(n0 + lr) * g.ldb + lk;
  const long sa = 32 * g.lda, sb = 32 * g.ldb;
  uint4 a0, a1, a2, a3, b0, b1, b2, b3;
#define GL_LOAD4(k) do { \
    a0 = *(const uint4*)(pA + (k)); a1 = *(const uint4*)(pA + (k) + sa); a2 = *(const uint4*)(pA + (k) + 2 * sa); a3 = *(const uint4*)(pA + (k) + 3 * sa); \
    b0 = *(const uint4*)(pB + (k)); b1 = *(const uint4*)(pB + (k) + sb); b2 = *(const uint4*)(pB + (k) + 2 * sb); b3 = *(const uint4*)(pB + (k) + 3 * sb); } while (0)
  GL_LOAD4(0);
  u16* wA = sA + lr * 72 + lk;
  u16* wB = sB + lr * 72 + lk;
  for (int kt = 0; kt < nk; ++kt) {
    __syncthreads();
    *(uint4*)(wA) = a0; *(uint4*)(wA + 32 * 72) = a1; *(uint4*)(wA + 64 * 72) = a2; *(uint4*)(wA + 96 * 72) = a3;
    *(uint4*)(wB) = b0; *(uint4*)(wB + 32 * 72) = b1; *(uint4*)(wB + 64 * 72) = b2; *(uint4*)(wB + 96 * 72) = b3;
    __syncthreads();
    const int k = (kt + 1 < nk ? kt + 1 : kt) * 64;
    GL_LOAD4(k);
    gemm_compute<SWAP, 4>(acc, sA, sB, wr, wc, fr, fq);
  }
#undef GL_LOAD4
}

template <bool SWAP>
__device__ __forceinline__ void gemm_main2_4(const GA& g, int m0, int n0, f32x4 (&acc)[4][4], u16* sA, u16* sB) {
  const int tid = tidx(), lane = tid & 63, wid = tid >> 6, wr = wid >> 1, wc = wid & 1, fr = lane & 15, fq = lane >> 4;
  const int nk = (g.K + 63) >> 6;
  const int lr = tid >> 3, lk = (tid & 7) * 8;
  const u16* pA = g.A + (long)(m0 + lr) * g.lda + lk;
  const u16* pB = g.B + (long)(n0 + lr) * g.ldb + lk;
  const long sa = 32 * g.lda, sb = 32 * g.ldb;
  uint4 a0, a1, a2, a3, b0, b1, b2, b3, c0, c1, c2, c3, d0, d1, d2, d3;
#define G2_LOAD(k, A0, A1, A2, A3, B0, B1, B2, B3) do { \
    A0 = *(const uint4*)(pA + (k)); A1 = *(const uint4*)(pA + (k) + sa); A2 = *(const uint4*)(pA + (k) + 2 * sa); A3 = *(const uint4*)(pA + (k) + 3 * sa); \
    B0 = *(const uint4*)(pB + (k)); B1 = *(const uint4*)(pB + (k) + sb); B2 = *(const uint4*)(pB + (k) + 2 * sb); B3 = *(const uint4*)(pB + (k) + 3 * sb); } while (0)
#define G2_STORE(A0, A1, A2, A3, B0, B1, B2, B3) do { \
    *(uint4*)(wA) = A0; *(uint4*)(wA + 32 * 72) = A1; *(uint4*)(wA + 64 * 72) = A2; *(uint4*)(wA + 96 * 72) = A3; \
    *(uint4*)(wB) = B0; *(uint4*)(wB + 32 * 72) = B1; *(uint4*)(wB + 64 * 72) = B2; *(uint4*)(wB + 96 * 72) = B3; } while (0)
  u16* wA = sA + lr * 72 + lk;
  u16* wB = sB + lr * 72 + lk;
  G2_LOAD(0, a0, a1, a2, a3, b0, b1, b2, b3);
  G2_LOAD((nk > 1 ? 64 : 0), c0, c1, c2, c3, d0, d1, d2, d3);
  for (int kt = 0; kt < nk; kt += 2) {
    __syncthreads();
    G2_STORE(a0, a1, a2, a3, b0, b1, b2, b3);
    __syncthreads();
    { const int k = (kt + 2 < nk ? kt + 2 : kt) * 64; G2_LOAD(k, a0, a1, a2, a3, b0, b1, b2, b3); }
    gemm_compute<SWAP, 4>(acc, sA, sB, wr, wc, fr, fq);
    if (kt + 1 < nk) {
      __syncthreads();
      G2_STORE(c0, c1, c2, c3, d0, d1, d2, d3);
      __syncthreads();
      { const int k = (kt + 3 < nk ? kt + 3 : kt + 1) * 64; G2_LOAD(k, c0, c1, c2, c3, d0, d1, d2, d3); }
      gemm_compute<SWAP, 4>(acc, sA, sB, wr, wc, fr, fq);
    }
  }
#undef G2_LOAD
#undef G2_STORE
}

template <bool SWAP>
__device__ __forceinline__ void gemm_main_db_4(const GA& g, int m0, int n0, f32x4 (&acc)[4][4], u16* lds) {
  const int tid = tidx(), lane = tid & 63, wid = tid >> 6, wr = wid >> 1, wc = wid & 1, fr = lane & 15, fq = lane >> 4;
  const int nk = g.K >> 5;
  const int lr = tid >> 2, lk = (tid & 3) * 8;
  const u16* pA = g.A + (long)(m0 + lr) * g.lda + lk;
  const u16* pB = g.B + (long)(n0 + lr) * g.ldb + lk;
  const long sa = 64 * g.lda, sb = 64 * g.ldb;
  uint4 a0, a1, b0, b1;
  a0 = *(const uint4*)(pA); a1 = *(const uint4*)(pA + sa); b0 = *(const uint4*)(pB); b1 = *(const uint4*)(pB + sb);
  u16* w = lds + lr * 40 + lk;
  *(uint4*)(w) = a0; *(uint4*)(w + 64 * 40) = a1; *(uint4*)(w + 5120) = b0; *(uint4*)(w + 5120 + 64 * 40) = b1;
  { const int k = (nk > 1 ? 32 : 0); a0 = *(const uint4*)(pA + k); a1 = *(const uint4*)(pA + k + sa); b0 = *(const uint4*)(pB + k); b1 = *(const uint4*)(pB + k + sb); }
  __syncthreads();
  for (int kt = 0; kt < nk; ++kt) {
    const u16* cA = lds + (kt & 1) * 10240;
    const u16* cB = cA + 5120;
    bf16x8 af[4], bfr[4];
#pragma unroll
    for (int m = 0; m < 4; ++m) af[m] = *(const bf16x8*)(cA + (wr * 64 + m * 16 + fr) * 40 + fq * 8);
#pragma unroll
    for (int n = 0; n < 4; ++n) bfr[n] = *(const bf16x8*)(cB + (wc * 64 + n * 16 + fr) * 40 + fq * 8);
    if (kt + 1 < nk) {
      u16* wn = w + ((kt + 1) & 1) * 10240;
      *(uint4*)(wn) = a0; *(uint4*)(wn + 64 * 40) = a1; *(uint4*)(wn + 5120) = b0; *(uint4*)(wn + 5120 + 64 * 40) = b1;
    }
    { const int k = (kt + 2 < nk ? kt + 2 : kt) * 32; a0 = *(const uint4*)(pA + k); a1 = *(const uint4*)(pA + k + sa); b0 = *(const uint4*)(pB + k); b1 = *(const uint4*)(pB + k + sb); }
#pragma unroll
    for (int m = 0; m < 4; ++m)
#pragma unroll
      for (int n = 0; n < 4; ++n)
        acc[m][n] = SWAP ? __builtin_amdgcn_mfma_f32_16x16x32_bf16(bfr[n], af[m], acc[m][n], 0, 0, 0)
                         : __builtin_amdgcn_mfma_f32_16x16x32_bf16(af[m], bfr[n], acc[m][n], 0, 0, 0);
    __syncthreads();
  }
}

template <bool SWAP, class Epi>
__device__ __forceinline__ void gemm_phase256(const GA& g, Epi epi, char* smem, int reps = 1) {
  u16* sA = (u16*)smem; u16* sB = sA + 256 * 72;
  const int nM = (g.M + 255) >> 8, nN = (g.N + 127) >> 7;
  const int G = gridDim.x, bq = bidx();
  const int bsw = (G & 7) == 0 ? (bq & 7) * (G >> 3) + (bq >> 3) : bq;
  for (int rep = 0; rep < reps; ++rep)
  for (int tile = bsw; tile < nM * nN; tile += G) {
    int m0 = (tile / nN) * 256, n0 = (tile % nN) * 128;
    f32x4 acc[8][4];
#pragma unroll
    for (int m = 0; m < 8; ++m)
#pragma unroll
      for (int n = 0; n < 4; ++n) acc[m][n] = (f32x4){0.f, 0.f, 0.f, 0.f};
    gemm_main1<SWAP, 8>(g, m0, n0, acc, sA, sB);
    gemm_epi<SWAP, 8>(m0, n0, acc, epi);
  }
}

template <bool SWAP, int MW = 4, class Epi>
__device__ __forceinline__ void gemm_epi(int m0, int n0, f32x4 (&acc)[MW][4], Epi epi) {
  const int lane = tidx() & 63, wid = tidx() >> 6, wr = wid >> 1, wc = wid & 1, fr = lane & 15, fq = lane >> 4;
#pragma unroll
  for (int m = 0; m < MW; ++m)
#pragma unroll
    for (int n = 0; n < 4; ++n) {
      int row, col;
      if (SWAP) { row = m0 + wr * (MW * 16) + m * 16 + fr; col = n0 + wc * 64 + n * 16 + fq * 4; }
      else { row = m0 + wr * (MW * 16) + m * 16 + fq * 4; col = n0 + wc * 64 + n * 16 + fr; }
      epi(row, col, acc[m][n]);
    }
}

template <bool SWAP, class Epi>
__device__ __forceinline__ void gemm_phase(const GA& g, Epi epi, char* smem, int reps = 1) {
  u16* sA = (u16*)smem; u16* sB = sA + 128 * 72;
  const int nM = (g.M + 127) >> 7, nN = (g.N + 127) >> 7;
  const int G = gridDim.x, bq = bidx();
  const int bsw = (G & 7) == 0 ? (bq & 7) * (G >> 3) + (bq >> 3) : bq;
  for (int rep = 0; rep < reps; ++rep)
  for (int tile = bsw; tile < nM * nN; tile += G) {
    int m0 = (tile / nN) * 128, n0 = (tile % nN) * 128;
    f32x4 acc[4][4];
#pragma unroll
    for (int m = 0; m < 4; ++m)
#pragma unroll
      for (int n = 0; n < 4; ++n) acc[m][n] = (f32x4){0.f, 0.f, 0.f, 0.f};
    gemm_main<SWAP, 4>(g, m0, n0, acc, sA, sB);
    gemm_epi<SWAP, 4>(m0, n0, acc, epi);
  }
}

__device__ void transpose_cvt(const float* W, int K, int N, u16* out, char* smem) {
  float* tile = (float*)smem;
  const int tk = (K + 63) / 64, tn = (N + 63) / 64;
  const int tx = tidx() & 63, ty = tidx() >> 6;
  for (int id = bidx(); id < tk * tn; id += gridDim.x) {
    int k0 = (id / tn) * 64, n0 = (id % tn) * 64;
    __syncthreads();
    for (int i = ty; i < 64; i += 4) {
      int k = k0 + i, n = n0 + tx;
      tile[i * 65 + tx] = (k < K && n < N) ? __builtin_nontemporal_load(W + (long)k * N + n) : 0.f;
    }
    __syncthreads();
    for (int i = ty; i < 64; i += 4) {
      int n = n0 + i, k = k0 + tx;
      if (n < N && k < K) out[(long)n * K + k] = f2bf(tile[tx * 65 + i]);
    }
  }
}

__device__ void prep_phase(const P& p, char* smem) {
  const int tid = tidx();
  const long gtid = (long)bidx() * 256 + tid, gsz = (long)gridDim.x * 256;
  {
    u16* H = (u16*)(p.ws + OFF_H);
    for (long i = gtid; i < (long)NT * 128; i += gsz) {
      int row = (int)(i >> 7), c8 = (int)(i & 127) * 8;
      int t, T; row_info(row, t, T);
      const float* src;
      if (t < 16) src = p.in[2] + t * 1024 + c8;
      else if (row < ROWS_P) { int s = row / TP; src = p.in[0] + ((long)s * 2048 + (t - 16)) * 1024 + c8; }
      else { int s = (row - ROWS_P) / TS; src = p.in[1] + ((long)s * 4096 + (t - 16)) * 1024 + c8; }
      f32x4 av4 = __builtin_nontemporal_load((const f32x4*)src), bv4 = __builtin_nontemporal_load((const f32x4*)(src + 4));
      float4 a = make_float4(av4[0], av4[1], av4[2], av4[3]), b = make_float4(bv4[0], bv4[1], bv4[2], bv4[3]);
      uint4 o = make_uint4(pack2(a.x, a.y), pack2(a.z, a.w), pack2(b.x, b.y), pack2(b.z, b.w));
      *(uint4*)(H + (long)row * 1024 + c8) = o;
    }
  }
  for (int which = 0; which < 2; ++which) {
    const int T = which ? TS : TP, Th = which ? THS : THP, Mh = T / 2 + 1;
    u16* A = (u16*)((char*)p.out + (which ? OD_DFTS : OD_DFTP));
    for (long i = gtid; i < (long)Mh * Th; i += gsz) {
      int tt = (int)(i / Th), k = (int)(i % Th);
      u16 c = 0, sn = 0;
      if (k < T) {
        int m = (int)(((long)tt * k) % T);
        float x = 2.f * (float)m / (float)T;
        c = f2bf(cospif(x)); sn = f2bf(sinpif(x));
      }
      A[(long)tt * 2 * Th + k] = c;
      A[(long)tt * 2 * Th + Th + k] = sn;
    }
  }
  for (int l = 0; l < 2; ++l) {
    char* wl = p.ws + (size_t)l * SZ_WL;
    transpose_cvt(p.in[4] + (size_t)l * 1024 * DIN, 1024, DIN, (u16*)(wl + OW_IN), smem);
    for (int k = 0; k < 4; ++k)
      transpose_cvt(p.in[20] + ((size_t)l * 4 + k) * 512 * 1024, 512, 1024, (u16*)(wl + OW_BR) + (size_t)k * 1024 * 512, smem);
    transpose_cvt(p.in[21] + (size_t)l * 1024 * 1024, 1024, 1024, (u16*)(wl + OW_OUT), smem);
    transpose_cvt(p.in[24] + (size_t)l * 1024 * 5632, 1024, 5632, (u16*)(wl + OW_UP), smem);
    transpose_cvt(p.in[25] + (size_t)l * 2816 * 1024, 2816, 1024, (u16*)(wl + OW_DOWN), smem);
  }
  {
    float* wt = (float*)smem;
    float* ct = wt + 64 * 129;
    for (int task = bidx(); task < 128; task += gridDim.x) {
      int l = task >> 6, kt = (task & 63) >> 2, g = task & 3;
      const float* win = p.in[4] + (size_t)l * 1024 * DIN;
      u16* Wfn = (u16*)(p.ws + (size_t)l * SZ_WL + OW_FN);
      __syncthreads();
      for (int idx = tid; idx < 64 * 128; idx += 256) {
        int kk = idx >> 7, j = idx & 127;
        wt[kk * 129 + j] = win[(size_t)(kt * 64 + kk) * DIN + g * 128 + j];
      }
      if (tid < 128) { ct[tid] = cospif(tid / 64.f); ct[128 + tid] = sinpif(tid / 64.f); }
      __syncthreads();
      int kk = tid & 63, grp = tid >> 6;
      for (int mm = grp; mm < 256; mm += 4) {
        int half = mm >> 7, m = mm & 127;
        float s = 0.f;
        for (int j = 0; j < 128; ++j) s += wt[kk * 129 + j] * ct[half * 128 + ((j * m) & 127)];
        Wfn[(size_t)(half * 512 + g * 128 + m) * 1024 + kt * 64 + kk] = f2bf(s);
      }
    }
  }
}

__device__ void rmsnorm_phase(const u16* H, const float* w, u16* HN, float* zbuf, long zn4) {
  const int lane = tidx() & 63;
  const int wave = (bidx() * 256 + tidx()) >> 6, nw = gridDim.x * 4;
  if (zbuf) {
    float4 z = make_float4(0.f, 0.f, 0.f, 0.f);
    for (long i = (long)bidx() * 256 + tidx(); i < zn4; i += (long)gridDim.x * 256) ((float4*)zbuf)[i] = z;
  }
  float wlo[8], whi[8];
  ld8(w + lane * 8, wlo); ld8(w + 512 + lane * 8, whi);
  for (int row = wave; row < NT; row += nw) {
    const uint4* hp = (const uint4*)(H + (long)row * 1024);
    uint4 a = hp[lane], b = hp[64 + lane];
    unsigned ua[8] = {a.x, a.y, a.z, a.w, b.x, b.y, b.z, b.w};
    float x[16];
    float ss = 0.f;
#pragma unroll
    for (int i = 0; i < 8; ++i) { x[2 * i] = lo2f(ua[i]); x[2 * i + 1] = hi2f(ua[i]); ss += x[2 * i] * x[2 * i] + x[2 * i + 1] * x[2 * i + 1]; }
    ss = wave_sum(ss);
    float r = rsqrtf(ss * (1.f / 1024.f) + EPS);
    unsigned o[8];
#pragma unroll
    for (int i = 0; i < 8; ++i) {
      const float w0 = i < 4 ? wlo[(i & 3) * 2] : whi[(i & 3) * 2], w1 = i < 4 ? wlo[(i & 3) * 2 + 1] : whi[(i & 3) * 2 + 1];
      o[i] = pack2(x[2 * i] * r * w0, x[2 * i + 1] * r * w1);
    }
    uint4* op = (uint4*)(HN + (long)row * 1024);
    op[lane] = make_uint4(o[0], o[1], o[2], o[3]);
    op[64 + lane] = make_uint4(o[4], o[5], o[6], o[7]);
  }
}

__device__ void final_phase(const P& p) {
  const u16* H = (const u16*)(p.ws + OFF_H);
  const float* w = p.in[26];
  const int lane = tidx() & 63;
  const int wave = (bidx() * 256 + tidx()) >> 6, nw = gridDim.x * 4;
  float wf0[8], wf1[8];
  ld8(w + lane * 8, wf0); ld8(w + 512 + lane * 8, wf1);
  for (int row = wave; row < NT; row += nw) {
    int t, T; row_info(row, t, T);
    if (t < 16) continue;
    long orow;
    if (row < ROWS_P) orow = (long)(row / TP) * 2048 + (t - 16);
    else orow = 32l * 2048 + (long)((row - ROWS_P) / TS) * 4096 + (t - 16);
    const uint4* hp = (const uint4*)(H + (long)row * 1024);
    uint4 a = hp[lane], b = hp[64 + lane];
    unsigned ua[8] = {a.x, a.y, a.z, a.w, b.x, b.y, b.z, b.w};
    float x[16];
    float ss = 0.f;
#pragma unroll
    for (int i = 0; i < 8; ++i) { x[2 * i] = lo2f(ua[i]); x[2 * i + 1] = hi2f(ua[i]); ss += x[2 * i] * x[2 * i] + x[2 * i + 1] * x[2 * i + 1]; }
    ss = wave_sum(ss);
    float r = rsqrtf(ss * (1.f / 1024.f) + EPS);
    float* op = p.out + orow * 1024;
#pragma unroll
    for (int hgrp = 0; hgrp < 2; ++hgrp) {
      int c = hgrp * 512 + lane * 8;
      float4 o0, o1;
      o0.x = x[hgrp * 8 + 0] * r * (hgrp ? wf1[0] : wf0[0]); o0.y = x[hgrp * 8 + 1] * r * (hgrp ? wf1[1] : wf0[1]);
      o0.z = x[hgrp * 8 + 2] * r * (hgrp ? wf1[2] : wf0[2]); o0.w = x[hgrp * 8 + 3] * r * (hgrp ? wf1[3] : wf0[3]);
      o1.x = x[hgrp * 8 + 4] * r * (hgrp ? wf1[4] : wf0[4]); o1.y = x[hgrp * 8 + 5] * r * (hgrp ? wf1[5] : wf0[5]);
      o1.z = x[hgrp * 8 + 6] * r * (hgrp ? wf1[6] : wf0[6]); o1.w = x[hgrp * 8 + 7] * r * (hgrp ? wf1[7] : wf0[7]);
      __builtin_nontemporal_store((f32x4){o0.x, o0.y, o0.z, o0.w}, (f32x4*)(op + c));
      __builtin_nontemporal_store((f32x4){o1.x, o1.y, o1.z, o1.w}, (f32x4*)(op + c + 4));
    }
  }
}

__device__ __forceinline__ float conv3_at(const u16* PR, long row, int ld, int col, int t, int T, float w0, float w1, float w2) {
  float x1 = bf2f(PR[row * ld + col]);
  float x0 = (t > 0) ? bf2f(PR[(row - 1) * ld + col]) : 0.f;
  float x2 = (t < T - 1) ? bf2f(PR[(row + 1) * ld + col]) : 0.f;
  return w0 * x0 + w1 * x1 + w2 * x2;
}

__device__ void ssd_conv_phase(const P& p, int l) {
  const u16* PR = (const u16*)((char*)p.out + OD_PROJ);
  const float* cw = p.in[5] + l * 3 * 1024;
  const float* cb = p.in[6] + l * 1024;
  u16* XS = (u16*)(p.ws + OFF_BR + 1 * SZ_BR);
  u16* BC = (u16*)(p.ws + OFF_X2T);
  for (long i = (long)bidx() * 256 + tidx(); i < (long)NT * 128; i += (long)gridDim.x * 256) {
    int row = (int)(i >> 7), c8 = (int)(i & 127) * 8;
    int t, T; row_info(row, t, T);
    const u16* pr = PR + (long)row * 1552 + 512 + c8;
    uint4 z4 = make_uint4(0, 0, 0, 0);
    uint4 x1 = *(const uint4*)pr, x0 = z4, x2 = z4;
    if (t > 0) x0 = *(const uint4*)(pr - 1552);
    if (t < T - 1) x2 = *(const uint4*)(pr + 1552);
    unsigned a0[4] = {x0.x, x0.y, x0.z, x0.w}, a1[4] = {x1.x, x1.y, x1.z, x1.w}, a2[4] = {x2.x, x2.y, x2.z, x2.w};
    float w0[8], w1[8], w2[8], wb[8];
    ld8(cw + c8, w0); ld8(cw + 1024 + c8, w1); ld8(cw + 2048 + c8, w2); ld8(cb + c8, wb);
    unsigned o[4];
#pragma unroll
    for (int e = 0; e < 4; ++e) {
      float lo = siluf(w0[2 * e] * lo2f(a0[e]) + w1[2 * e] * lo2f(a1[e]) + w2[2 * e] * lo2f(a2[e]) + wb[2 * e]);
      float hi = siluf(w0[2 * e + 1] * hi2f(a0[e]) + w1[2 * e + 1] * hi2f(a1[e]) + w2[2 * e + 1] * hi2f(a2[e]) + wb[2 * e + 1]);
      o[e] = pack2(lo, hi);
    }
    u16* dst = c8 < 512 ? XS + (long)row * 512 + c8 : BC + (long)row * 512 + (c8 - 512);
    *(uint4*)dst = make_uint4(o[0], o[1], o[2], o[3]);
  }
}

__device__ void ssd_scan_phase(const P& p, int l, char* smem) {
  u16* Cn = (u16*)smem;
  u16* Bn = Cn + 32 * 136;
  u16* BT = Bn + 32 * 136;
  u16* XT = BT + 128 * 40;
  float* dts = (float*)(XT + 4 * 64 * 40);
  float* css = dts + 128;
  const u16* PR = (const u16*)((char*)p.out + OD_PROJ);
  const u16* XS = (const u16*)(p.ws + OFF_BR + 1 * SZ_BR);
  const u16* BC = (const u16*)(p.ws + OFF_X2T);
  const float* dtb = p.in[7] + l * 16;
  const float* alog = p.in[8] + l * 16;
  for (int task = bidx(); task < 384; task += gridDim.x) {
    const int tid = tidx(), lane = tid & 63, r = tid >> 6;
    const int fr = lane & 15, fq = lane >> 4;
    int seq, g, dir, seg;
    if (task < 128) { seq = 32 + (task >> 4); int rem = task & 15; g = rem >> 3; dir = (rem >> 2) & 1; seg = rem & 3; }
    else { int q = task - 128; seq = q >> 3; int rem = q & 7; g = rem >> 2; dir = (rem >> 1) & 1; seg = rem & 1; }
    int base = seq_base(seq), T = seq < 32 ? TP : TS;
    float csoff = 0.f;
    u16* Yd = (u16*)(p.ws + OFF_BR + (size_t)(2 + dir) * SZ_BR);
    f32x4 HT[8][4];
#pragma unroll
    for (int a = 0; a < 8; ++a)
#pragma unroll
      for (int b = 0; b < 4; ++b) HT[a][b] = (f32x4){0.f, 0.f, 0.f, 0.f};
    const int nch = (T + 31) >> 5;
    const int chb = seg * SEGC, che = (chb + SEGC < nch) ? chb + SEGC : nch;
    const int sv_v = tid & 63;
    const u16* colp = sv_v < 32 ? BC + (sv_v < 16 ? g * 128 + 8 * sv_v : 256 + g * 128 + 8 * (sv_v - 16)) : XS + g * 256 + 8 * (sv_v - 32);
    uint4 sv[4];
    u16 rawdt = 0;
#define SCAN_LOADN(i0, C0, NV, S0) _Pragma("unroll") for (int i = 0; i < (NV); ++i) { \
        const int tau = (C0) + r + 4 * ((i0) + i); const bool ok = tau < T; \
        const int tc = ok ? (dir ? T - 1 - tau : tau) : 0; \
        uint4 val = *(const uint4*)(colp + (long)(base + tc) * 512); \
        sv[(S0) + i].x = ok ? val.x : 0u; sv[(S0) + i].y = ok ? val.y : 0u; sv[(S0) + i].z = ok ? val.z : 0u; sv[(S0) + i].w = ok ? val.w : 0u; }
#define SCAN_LOADDT(C0) do { rawdt = 0; if (tid < 128) { int tau = (C0) + (tid & 31); if (tau < T) { int t = dir ? T - 1 - tau : tau; \
        rawdt = PR[(long)(base + t) * 1552 + 1536 + dir * 8 + g * 4 + (tid >> 5)]; } } } while (0)
#define SCAN_STORE(i0) _Pragma("unroll") for (int i = 0; i < 4; ++i) { \
        const int tl = r + 4 * ((i0) + i); const int v = sv_v; \
        uint4 val = sv[i]; unsigned w4[4] = {val.x, val.y, val.z, val.w}; \
        if (v < 16) { \
          *(uint4*)(Bn + tl * 136 + 8 * v) = val; \
          _Pragma("unroll") for (int e = 0; e < 4; ++e) { BT[(8 * v + 2 * e) * 40 + tl] = (u16)(w4[e] & 0xffffu); BT[(8 * v + 2 * e + 1) * 40 + tl] = (u16)(w4[e] >> 16); } \
        } else if (v < 32) { \
          *(uint4*)(Cn + tl * 136 + 8 * (v - 16)) = val; \
        } else { \
          int h = (v - 32) >> 3, p0 = ((v - 32) & 7) * 8; \
          float dt = dts[h * 32 + tl]; \
          _Pragma("unroll") for (int e = 0; e < 4; ++e) { \
            XT[(h * 64 + p0 + 2 * e) * 40 + tl] = f2bf(lo2f(w4[e]) * dt); \
            XT[(h * 64 + p0 + 2 * e + 1) * 40 + tl] = f2bf(hi2f(w4[e]) * dt); } } }
    SCAN_LOADDT(chb * 32);
    SCAN_LOADN(0, chb * 32, 2, 0)
    for (int ch = chb; ch < che; ++ch) {
      const int c0 = ch * 32;
      __syncthreads();
      if (tid < 128) {
        int h = tid >> 5, tl = tid & 31, tau = c0 + tl;
        int hi = dir * 8 + g * 4 + h;
        float dt = 0.f;
        if (tau < T) {
          float dr = bf2f(rawdt) + dtb[hi];
          dt = dr > 20.f ? dr : __logf(1.f + __expf(dr));
        }
        float v = -dt * __expf(alog[hi]);
#pragma unroll
        for (int o = 1; o < 32; o <<= 1) { float u = bperm(v, (lane - o) & 63); if (tl >= o) v += u; }
        dts[h * 32 + tl] = dt; css[h * 32 + tl] = v;
      }
      __syncthreads();
      SCAN_LOADN(2, c0, 2, 2)
      SCAN_STORE(0)
      SCAN_LOADN(4, c0, 4, 0)
      SCAN_STORE(4)
      __syncthreads();
      if (ch + 1 < che) { SCAN_LOADDT(c0 + 32); SCAN_LOADN(0, c0 + 32, 2, 0) }
      const float* cs = css + r * 32;
      const u16* xt = XT + r * 64 * 40;
      if (lane < 32) {
        int tau = c0 + lane;
        if (tau < T) { int t = dir ? T - 1 - tau : tau; ((float*)((char*)p.out + OD_CSG))[((long)(base + t) * 2 + dir) * 8 + g * 4 + r] = csoff + cs[lane]; }
      }
      f32x4 GT00 = (f32x4){0.f, 0.f, 0.f, 0.f}, GT01 = GT00, GT11 = GT00;
#pragma unroll
      for (int kk = 0; kk < 4; ++kk) {
        bf16x8 b0 = *(const bf16x8*)(Bn + (fr) * 136 + kk * 32 + fq * 8);
        bf16x8 b1 = *(const bf16x8*)(Bn + (16 + fr) * 136 + kk * 32 + fq * 8);
        bf16x8 c0v = *(const bf16x8*)(Cn + (fr) * 136 + kk * 32 + fq * 8);
        bf16x8 c1v = *(const bf16x8*)(Cn + (16 + fr) * 136 + kk * 32 + fq * 8);
        GT00 = __builtin_amdgcn_mfma_f32_16x16x32_bf16(b0, c0v, GT00, 0, 0, 0);
        GT01 = __builtin_amdgcn_mfma_f32_16x16x32_bf16(b0, c1v, GT01, 0, 0, 0);
        GT11 = __builtin_amdgcn_mfma_f32_16x16x32_bf16(b1, c1v, GT11, 0, 0, 0);
      }
      const float csl0 = cs[fr], csl1 = cs[16 + fr];
      float m00[4], m01[4], m11[4];
#pragma unroll
      for (int j = 0; j < 4; ++j) {
        int s0 = 4 * fq + j;
        float css0 = cs[s0], css1 = cs[16 + s0];
        m00[j] = (s0 <= fr) ? GT00[j] * __expf(csl0 - css0) : 0.f;
        m01[j] = GT01[j] * __expf(csl1 - css0);
        m11[j] = (s0 <= fr) ? GT11[j] * __expf(csl1 - css1) : 0.f;
      }
      union { bf16x8 v; unsigned u[4]; } A0, A1;
      A0.u[0] = pack2(m00[0], m00[1]); A0.u[1] = pack2(m00[2], m00[3]); A0.u[2] = 0u; A0.u[3] = 0u;
      A1.u[0] = pack2(m01[0], m01[1]); A1.u[1] = pack2(m01[2], m01[3]); A1.u[2] = pack2(m11[0], m11[1]); A1.u[3] = pack2(m11[2], m11[3]);
      f32x4 Y[2][4];
#pragma unroll
      for (int tp = 0; tp < 4; ++tp) {
        union { bf16x8 v; uint2 h[2]; } xb;
        xb.h[0] = *(const uint2*)(xt + (tp * 16 + fr) * 40 + 4 * fq);
        xb.h[1] = *(const uint2*)(xt + (tp * 16 + fr) * 40 + 16 + 4 * fq);
        f32x4 z = (f32x4){0.f, 0.f, 0.f, 0.f};
        Y[0][tp] = __builtin_amdgcn_mfma_f32_16x16x32_bf16(A0.v, xb.v, z, 0, 0, 0);
        Y[1][tp] = __builtin_amdgcn_mfma_f32_16x16x32_bf16(A1.v, xb.v, z, 0, 0, 0);
      }
      const float e0 = __expf(csl0), e1 = __expf(csl1);
#pragma unroll
      for (int u = 0; u < 4; ++u) {
        union { bf16x8 v; uint2 h[2]; unsigned w[4]; } ca, cbv;
        ca.h[0] = *(const uint2*)(Cn + (fr) * 136 + 32 * u + 4 * fq);
        ca.h[1] = *(const uint2*)(Cn + (fr) * 136 + 32 * u + 16 + 4 * fq);
        cbv.h[0] = *(const uint2*)(Cn + (16 + fr) * 136 + 32 * u + 4 * fq);
        cbv.h[1] = *(const uint2*)(Cn + (16 + fr) * 136 + 32 * u + 16 + 4 * fq);
#pragma unroll
        for (int e = 0; e < 4; ++e) {
          ca.w[e] = pack2(lo2f(ca.w[e]) * e0, hi2f(ca.w[e]) * e0);
          cbv.w[e] = pack2(lo2f(cbv.w[e]) * e1, hi2f(cbv.w[e]) * e1);
        }
#pragma unroll
        for (int tp = 0; tp < 4; ++tp) {
          union { bf16x8 v; unsigned w[4]; } hb;
          hb.w[0] = pack2(HT[2 * u][tp][0], HT[2 * u][tp][1]); hb.w[1] = pack2(HT[2 * u][tp][2], HT[2 * u][tp][3]);
          hb.w[2] = pack2(HT[2 * u + 1][tp][0], HT[2 * u + 1][tp][1]); hb.w[3] = pack2(HT[2 * u + 1][tp][2], HT[2 * u + 1][tp][3]);
          Y[0][tp] = __builtin_amdgcn_mfma_f32_16x16x32_bf16(ca.v, hb.v, Y[0][tp], 0, 0, 0);
          Y[1][tp] = __builtin_amdgcn_mfma_f32_16x16x32_bf16(cbv.v, hb.v, Y[1][tp], 0, 0, 0);
        }
      }
#pragma unroll
      for (int tl = 0; tl < 2; ++tl)
#pragma unroll
        for (int j = 0; j < 4; ++j) {
          int tau = c0 + tl * 16 + 4 * fq + j;
          if (tau < T) {
            int t = dir ? T - 1 - tau : tau;
            u16* yp = Yd + (long)(base + t) * 512 + g * 256 + r * 64 + fr;
#pragma unroll
            for (int tp = 0; tp < 4; ++tp) yp[tp * 16] = f2bf(Y[tl][tp][j]);
          }
        }
      const float csL = cs[31];
      const float eL = __expf(csL);
      float w8[8];
#pragma unroll
      for (int jj = 0; jj < 8; ++jj) w8[jj] = __expf(csL - cs[8 * fq + jj]);
      bf16x8 xs4[4];
#pragma unroll
      for (int tp = 0; tp < 4; ++tp) {
        union { bf16x8 v; unsigned w[4]; } xx;
        xx.v = *(const bf16x8*)(xt + (tp * 16 + fr) * 40 + 8 * fq);
#pragma unroll
        for (int e = 0; e < 4; ++e) xx.w[e] = pack2(lo2f(xx.w[e]) * w8[2 * e], hi2f(xx.w[e]) * w8[2 * e + 1]);
        xs4[tp] = xx.v;
      }
#pragma unroll
      for (int tn = 0; tn < 8; ++tn) {
        bf16x8 bt = *(const bf16x8*)(BT + (tn * 16 + fr) * 40 + 8 * fq);
#pragma unroll
        for (int tp = 0; tp < 4; ++tp) {
          f32x4 hv = HT[tn][tp];
          hv[0] *= eL; hv[1] *= eL; hv[2] *= eL; hv[3] *= eL;
          HT[tn][tp] = __builtin_amdgcn_mfma_f32_16x16x32_bf16(bt, xs4[tp], hv, 0, 0, 0);
        }
      }
      csoff += csL;
    }
#undef SCAN_LOADN
#undef SCAN_LOADDT
#undef SCAN_STORE
    if (seg < (seq < 32 ? 1 : 3)) {
      const int sslot = seq < 32 ? seq : 32 + (seq - 32) * 3 + seg;
      const long sl = (long)((g * 2 + dir) * 56 + sslot) * 4 + r;
      f32x4* hs = (f32x4*)((float*)((char*)p.out + OD_HS) + sl * 8192);
#pragma unroll
      for (int tn = 0; tn < 8; ++tn)
#pragma unroll
        for (int tp = 0; tp < 4; ++tp) hs[(tn * 4 + tp) * 64 + lane] = HT[tn][tp];
      if (lane == 0) ((float*)((char*)p.out + OD_DS))[sl] = __expf(csoff);
    }
  }
}

__device__ void ssd_state_phase(const P& p) {
  float* HS = (float*)((char*)p.out + OD_HS);
  const float* DS = (const float*)((char*)p.out + OD_DS);
  for (long i = (long)bidx() * 256 + tidx(); i < 128l * 2048; i += (long)gridDim.x * 256) {
    int chain = (int)(i >> 11), e = (int)(i & 2047);
    int gd = chain >> 5, sq = (chain >> 2) & 7, h = chain & 3;
    long sl0 = (long)(gd * 56 + 32 + sq * 3) * 4 + h;
    float4 a = ((const float4*)(HS + sl0 * 8192))[e];
    float4 b = ((const float4*)(HS + (sl0 + 4) * 8192))[e];
    float d1 = DS[sl0 + 4];
    b.x += d1 * a.x; b.y += d1 * a.y; b.z += d1 * a.z; b.w += d1 * a.w;
    ((float4*)(HS + (sl0 + 4) * 8192))[e] = b;
    float4 c = ((const float4*)(HS + (sl0 + 8) * 8192))[e];
    float d2 = DS[sl0 + 8];
    c.x += d2 * b.x; c.y += d2 * b.y; c.z += d2 * b.z; c.w += d2 * b.w;
    ((float4*)(HS + (sl0 + 8) * 8192))[e] = c;
  }
}

__device__ void ssd_fix_phase(const P& p) {
  const float* HS = (const float*)((char*)p.out + OD_HS);
  const float* CSG = (const float*)((char*)p.out + OD_CSG);
  const u16* BC = (const u16*)(p.ws + OFF_X2T);
  const int tid = tidx(), lane = tid & 63, r = tid >> 6;
  const int fr = lane & 15, fq = lane >> 4;
  for (int task = bidx(); task < 7168; task += gridDim.x) {
    int seq, gd, ch;
    if (task < 3072) { seq = 32 + task / 384; int rem = task % 384; gd = rem / 96; ch = SEGC + rem % 96; }
    else { int q = task - 3072; seq = q >> 7; int rem = q & 127; gd = rem >> 5; ch = SEGC + (rem & 31); }
    const int g = gd >> 1, dir = gd & 1;
    const int base = seq_base(seq), T = seq < 32 ? TP : TS;
    const int seg = ch / SEGC;
    const int sslot = seq < 32 ? seq : 32 + (seq - 32) * 3 + (seg - 1);
    const f32x4* hs = (const f32x4*)(HS + ((long)(gd * 56 + sslot) * 4 + r) * 8192);
    u16* Yd = (u16*)(p.ws + OFF_BR + (size_t)(2 + dir) * SZ_BR);
    const int c0 = ch * 32;
    const int tau0 = c0 + fr, tau1 = c0 + 16 + fr;
    const bool ok0 = tau0 < T, ok1 = tau1 < T;
    const int t0r = ok0 ? (dir ? T - 1 - tau0 : tau0) : 0, t1r = ok1 ? (dir ? T - 1 - tau1 : tau1) : 0;
    const float e0 = ok0 ? __expf(CSG[((long)(base + t0r) * 2 + dir) * 8 + g * 4 + r]) : 0.f;
    const float e1 = ok1 ? __expf(CSG[((long)(base + t1r) * 2 + dir) * 8 + g * 4 + r]) : 0.f;
    const u16* c0p = BC + (long)(base + t0r) * 512 + 256 + g * 128;
    const u16* c1p = BC + (long)(base + t1r) * 512 + 256 + g * 128;
    f32x4 Y[2][4];
#pragma unroll
    for (int a = 0; a < 2; ++a)
#pragma unroll
      for (int b = 0; b < 4; ++b) Y[a][b] = (f32x4){0.f, 0.f, 0.f, 0.f};
#pragma unroll
    for (int u = 0; u < 4; ++u) {
      union { bf16x8 v; uint2 h[2]; unsigned w[4]; } ca, cbv;
      ca.h[0] = *(const uint2*)(c0p + 32 * u + 4 * fq);
      ca.h[1] = *(const uint2*)(c0p + 32 * u + 16 + 4 * fq);
      cbv.h[0] = *(const uint2*)(c1p + 32 * u + 4 * fq);
      cbv.h[1] = *(const uint2*)(c1p + 32 * u + 16 + 4 * fq);
#pragma unroll
      for (int e = 0; e < 4; ++e) {
        ca.w[e] = pack2(lo2f(ca.w[e]) * e0, hi2f(ca.w[e]) * e0);
        cbv.w[e] = pack2(lo2f(cbv.w[e]) * e1, hi2f(cbv.w[e]) * e1);
      }
#pragma unroll
      for (int tp = 0; tp < 4; ++tp) {
        f32x4 ha = hs[((2 * u) * 4 + tp) * 64 + lane], hb2 = hs[((2 * u + 1) * 4 + tp) * 64 + lane];
        union { bf16x8 v; unsigned w[4]; } hb;
        hb.w[0] = pack2(ha[0], ha[1]); hb.w[1] = pack2(ha[2], ha[3]);
        hb.w[2] = pack2(hb2[0], hb2[1]); hb.w[3] = pack2(hb2[2], hb2[3]);
        Y[0][tp] = __builtin_amdgcn_mfma_f32_16x16x32_bf16(ca.v, hb.v, Y[0][tp], 0, 0, 0);
        Y[1][tp] = __builtin_amdgcn_mfma_f32_16x16x32_bf16(cbv.v, hb.v, Y[1][tp], 0, 0, 0);
      }
    }
#pragma unroll
    for (int tl = 0; tl < 2; ++tl)
#pragma unroll
      for (int j = 0; j < 4; ++j) {
        int tau = c0 + tl * 16 + 4 * fq + j;
        if (tau < T) {
          int t = dir ? T - 1 - tau : tau;
          u16* yp = Yd + (long)(base + t) * 512 + g * 256 + r * 64 + fr;
#pragma unroll
          for (int tp = 0; tp < 4; ++tp) yp[tp * 16] = f2bf(bf2f(yp[tp * 16]) + Y[tl][tp][j]);
        }
      }
  }
}

__device__ void ssd_post_phase(const P& p, int l) {
  const u16* PR = (const u16*)((char*)p.out + OD_PROJ);
  const float* dsk = p.in[9] + l * 8;
  const float* nw = p.in[10] + l * 512;
  const u16* Yf = (const u16*)(p.ws + OFF_BR + 2 * SZ_BR);
  const u16* Yb = (const u16*)(p.ws + OFF_BR + 3 * SZ_BR);
  u16* BR1 = (u16*)(p.ws + OFF_BR + 1 * SZ_BR);
  const int lane = tidx() & 63;
  const int wave = (bidx() * 256 + tidx()) >> 6, nwv = gridDim.x * 4;
  const float4 nw0 = *(const float4*)(nw + lane * 8), nw1 = *(const float4*)(nw + lane * 8 + 4);
  const float nwv8[8] = {nw0.x, nw0.y, nw0.z, nw0.w, nw1.x, nw1.y, nw1.z, nw1.w};
  const float dk = dsk[lane >> 3];
  for (int row = wave; row < NT; row += nwv) {
    uint4 xs4 = *(const uint4*)(BR1 + (long)row * 512 + lane * 8);
    uint4 yf4 = *(const uint4*)(Yf + (long)row * 512 + lane * 8);
    uint4 yb4 = *(const uint4*)(Yb + (long)row * 512 + lane * 8);
    uint4 z4 = *(const uint4*)(PR + (long)row * 1552 + lane * 8);
    unsigned xa[4] = {xs4.x, xs4.y, xs4.z, xs4.w}, fa[4] = {yf4.x, yf4.y, yf4.z, yf4.w};
    unsigned ba[4] = {yb4.x, yb4.y, yb4.z, yb4.w}, za[4] = {z4.x, z4.y, z4.z, z4.w};
    float v[8];
    float ss = 0.f;
#pragma unroll
    for (int e = 0; e < 4; ++e) {
      float y0 = (lo2f(fa[e]) + lo2f(ba[e]) + lo2f(xa[e]) * dk) * siluf(lo2f(za[e]));
      float y1 = (hi2f(fa[e]) + hi2f(ba[e]) + hi2f(xa[e]) * dk) * siluf(hi2f(za[e]));
      v[2 * e] = y0; v[2 * e + 1] = y1; ss += y0 * y0 + y1 * y1;
    }
#pragma unroll
    for (int o = 16; o > 0; o >>= 1) ss += bperm(ss, lane ^ o);
    float rr = rsqrtf(ss * (1.f / 256.f) + EPS);
    unsigned o4[4];
#pragma unroll
    for (int e = 0; e < 4; ++e) o4[e] = pack2(v[2 * e] * rr * nwv8[2 * e], v[2 * e + 1] * rr * nwv8[2 * e + 1]);
    *(uint4*)(BR1 + (long)row * 512 + lane * 8) = make_uint4(o4[0], o4[1], o4[2], o4[3]);
  }
}

__device__ void hyena_hid_phase(const P& p, int l) {
  const float* w1 = p.in[12] + l * 33 * 64;
  const float* b1 = p.in[13] + l * 64;
  const float* w2 = p.in[14] + l * 64 * 64;
  const float* b2 = p.in[15] + l * 64;
  const float* fq = p.in[17] + l * 64;
  float* HID = (float*)(p.ws + OFF_HID);
  const int lane = tidx() & 63;
  const int wave = (bidx() * 256 + tidx()) >> 6, nwv = gridDim.x * 4;
  for (int item = wave; item < TP + TS; item += nwv) {
    int T = item < TP ? TP : TS;
    int lag = item < TP ? item : item - TP;
    float tt = (float)lag / (float)(T - 1);
    float wv = (float)(2.0 * 3.14159265358979323846 / (double)T) * (float)lag;
    float z = 0.f;
    if (lane == 0) z = tt;
    else if (lane < 33) {
      int i = (lane - 1) & 15;
      float fr = 1e-4f + (float)i * ((15.f - 1e-4f) / 15.f);
      z = lane < 17 ? cosf(fr * wv) : -sinf(fr * wv);
    }
    float s = b1[lane];
    for (int e = 0; e < 33; ++e) s += bperm(z, e) * w1[e * 64 + lane];
    float h1 = sinf(fq[lane] * s);
    float s2 = b2[lane];
    for (int i = 0; i < 64; ++i) s2 += bperm(h1, i) * w2[i * 64 + lane];
    HID[(long)item * 64 + lane] = sinf(fq[lane] * s2);
  }
}

__device__ __forceinline__ void hyena_kf_phase(const P& p, int l, int first_block, int nblocks) {
  const float* w3 = p.in[16] + (size_t)l * 64 * 2048;
  const float* HID = (const float*)(p.ws + OFF_HID);
  u16* KF = (u16*)(p.ws + OFF_KF);
  float* L1 = (float*)(p.ws + OFF_L1);
  const int lane = tidx() & 63;
  const int bl = bidx() - first_block;
  const int wave = bl * 4 + (tidx() >> 6), nwv = nblocks * 4;
  for (int it2 = (bl < 0 ? 2048 : wave); it2 < 2048; it2 += nwv) {
    const int item = it2 < 1024 ? 1024 + it2 : it2 - 1024;
    int ti = item >> 10, o = (item >> 9) & 1, c = item & 511;
    int T = ti ? TS : TP;
    const float* hid = HID + (ti ? (long)TP * 64 : 0);
    u16* kf = KF + (ti ? 2l * 512 * 4128 : 0) + (long)(o * 512 + c) * 2 * T;
    float delta = fabsf(-3.0701134573253943f + (float)c * ((-15.350567286626972f + 3.0701134573253943f) / 511.f));
    float asum = 0.f;
    {
      const int col0 = (o * 2) * 512 + c, col1 = col0 + 512;
      float wc0[64], wc1[64];
#pragma unroll
      for (int j = 0; j < 64; ++j) { wc0[j] = w3[j * 2048 + col0]; wc1[j] = w3[j * 2048 + col1]; }
      for (int lb = 0; lb < T; lb += 64) {
        int lag = lb + lane;
        if (lag < T) {
          const float4* hp = (const float4*)(hid + (long)lag * 64);
          float s0 = 0.f, s1 = 0.f;
#pragma unroll
          for (int j4 = 0; j4 < 16; ++j4) {
            float4 hv = hp[j4];
            s0 += hv.x * wc0[j4 * 4] + hv.y * wc0[j4 * 4 + 1] + hv.z * wc0[j4 * 4 + 2] + hv.w * wc0[j4 * 4 + 3];
            s1 += hv.x * wc1[j4 * 4] + hv.y * wc1[j4 * 4 + 1] + hv.z * wc1[j4 * 4 + 2] + hv.w * wc1[j4 * 4 + 3];
          }
          float tt = (float)lag / (float)(T - 1);
          float dec = __expf(-tt * delta);
          float v0 = s0 * dec, v1 = s1 * dec;
          asum += fabsf(v0); kf[T + lag] = f2bf(v0);
          if (lag > 0) { asum += fabsf(v1); kf[T - lag] = f2bf(v1); }
        }
      }
    }
    if (lane == 0) kf[0] = 0;
    asum = wave_sum(asum);
    if (lane == 0) L1[item] = asum;
  }
}

__device__ void hyena_prep_phase(const P& p, int l, char* smem) {
  const u16* PR = (const u16*)((char*)p.out + OD_PROJ);
  const float* cw = p.in[11] + l * 3 * 1536;
  u16* tile = (u16*)smem;
  const int tid = tidx();
  const int ntile = (NT / 64) * 8;
  for (int id = bidx(); id < ntile * 3; id += gridDim.x) {
    int part = id / ntile, rem = id % ntile;
    int r0 = (rem >> 3) * 64, c0 = (rem & 7) * 64;
    __syncthreads();
#pragma unroll
    for (int i = 0; i < 2; ++i) {
      int item = tid + 256 * i;
      int rl = item >> 3, cv = (item & 7) * 8;
      int row = r0 + rl; int t, T; row_info(row, t, T);
      int col = part * 512 + c0 + cv;
      const u16* pr = PR + (long)row * 1536 + col;
      uint4 z4 = make_uint4(0, 0, 0, 0);
      uint4 x1 = *(const uint4*)pr, x0 = z4, x2 = z4;
      if (t > 0) x0 = *(const uint4*)(pr - 1536);
      if (t < T - 1) x2 = *(const uint4*)(pr + 1536);
      float4 wa0 = *(const float4*)(cw + col), wa1 = *(const float4*)(cw + col + 4);
      float4 wb0 = *(const float4*)(cw + 1536 + col), wb1 = *(const float4*)(cw + 1536 + col + 4);
      float4 wc0 = *(const float4*)(cw + 3072 + col), wc1 = *(const float4*)(cw + 3072 + col + 4);
      float w0[8] = {wa0.x, wa0.y, wa0.z, wa0.w, wa1.x, wa1.y, wa1.z, wa1.w};
      float w1[8] = {wb0.x, wb0.y, wb0.z, wb0.w, wb1.x, wb1.y, wb1.z, wb1.w};
      float w2[8] = {wc0.x, wc0.y, wc0.z, wc0.w, wc1.x, wc1.y, wc1.z, wc1.w};
      unsigned a0[4] = {x0.x, x0.y, x0.z, x0.w}, a1[4] = {x1.x, x1.y, x1.z, x1.w}, a2[4] = {x2.x, x2.y, x2.z, x2.w};
#pragma unroll
      for (int e = 0; e < 4; ++e) {
        tile[(cv + 2 * e) * 72 + rl] = f2bf(w0[2 * e] * lo2f(a0[e]) + w1[2 * e] * lo2f(a1[e]) + w2[2 * e] * lo2f(a2[e]));
        tile[(cv + 2 * e + 1) * 72 + rl] = f2bf(w0[2 * e + 1] * hi2f(a0[e]) + w1[2 * e + 1] * hi2f(a1[e]) + w2[2 * e + 1] * hi2f(a2[e]));
      }
    }
    __syncthreads();
    u16* o = (u16*)(p.ws + (part == 0 ? OFF_BR + 2 * SZ_BR : (part == 1 ? OFF_BR + 3 * SZ_BR : OFF_X2T)));
#pragma unroll
    for (int i = 0; i < 2; ++i) {
      int item = tid + 256 * i;
      int cl = item >> 3, tv = (item & 7) * 8;
      *(uint4*)(o + (long)(c0 + cl) * NT + r0 + tv) = *(const uint4*)(tile + cl * 72 + tv);
    }
  }
}

template <bool SAMPLE, int ORD>
__device__ __forceinline__ void longconv_task(const P& p, int l, int c, u16* smem16) {
  constexpr int T = SAMPLE ? TS : TP;
  constexpr int W = SAMPLE ? 256 : 128;
  constexpr int NSTRIP = 17;
  constexpr int DMAX = W;
  constexpr int NEW = SAMPLE ? 1 : 2;
  constexpr int NHF = SAMPLE ? 1 : 2;
  constexpr int NB = SAMPLE ? 18 : 9;
  constexpr int PADL = 320;
  constexpr int LK = SAMPLE ? 8832 : 4672;
  constexpr int TW = SAMPLE ? 32 : 16;
  constexpr int R = SAMPLE ? 8 : 16;
  constexpr int LS = 280;
  constexpr int NV = R * 34;
  constexpr int NLD = (NV + 255) / 256;
  u16* kl = smem16;
  u16* ub = smem16 + 2 * 8832;
  const int tid = tidx(), lane = tid & 63, wave = tid >> 6;
  const u16* KF = (const u16*)(p.ws + OFF_KF) + (SAMPLE ? 2l * 512 * 4128 : 0) + (long)(ORD * 512 + c) * 2 * T;
  __syncthreads();
  for (int v = tid; v < LK / 8; v += 256) {
    int idx = v * 8 - PADL;
    uint4 val = (idx >= 0 && idx <= 2 * T - 8) ? *(const uint4*)(KF + idx) : make_uint4(0, 0, 0, 0);
    *(uint4*)(kl + v * 8) = val;
    unsigned prev = (idx - 1 >= 0 && idx - 1 <= 2 * T - 1) ? (unsigned)KF[idx - 1] : 0u;
    uint4 sh;
    sh.x = (val.x << 16) | prev; sh.y = (val.y << 16) | (val.x >> 16); sh.z = (val.z << 16) | (val.y >> 16); sh.w = (val.w << 16) | (val.z >> 16);
    *(uint4*)(kl + LK + v * 8) = sh;
  }
  const unsigned klw = (unsigned)(size_t)(__attribute__((address_space(3))) u16*)(kl + ((lane & 1) ? 0 : LK + 2));
  const u16* U = (ORD == 0 ? (const u16*)(p.ws + OFF_BR + 2 * SZ_BR) : (const u16*)((char*)p.out + OD_PROJ)) + (long)c * NT;
  const u16* X = (ORD == 0 ? (const u16*)(p.ws + OFF_BR + 3 * SZ_BR) : (const u16*)(p.ws + OFF_X2T)) + (long)c * NT;
  const float invl1 = 1.f / ((const float*)(p.ws + OFF_L1))[(SAMPLE ? 1024 : 0) + ORD * 512 + c];
  const float bias = p.in[18][(l * 2 + ORD) * 512 + c];
  const int n = lane & 15, g = lane >> 4;
  const int toff = SAMPLE ? 16 * (n >> 3) : 0;
  const int lrow = SAMPLE ? (n & 7) : n;
  const int lane_s = toff + 8 * g;
  const bf16x8 zero8 = (bf16x8){0, 0, 0, 0, 0, 0, 0, 0};
  int srow[NLD], scol[NLD];
#pragma unroll
  for (int i = 0; i < NLD; ++i) { int v = tid + 256 * i; srow[i] = v / 34; scol[i] = (v - srow[i] * 34) * 8; }
  for (int hf = 0; hf < NHF; ++hf) {
    const int rowbase_blk = SAMPLE ? ROWS_P : hf * 16 * TP;
    for (int rnd = 0; rnd < 5; ++rnd) {
      const int strip = rnd * 4 + wave;
      const bool active = strip < NSTRIP;
      const int t0 = strip * W;
      f32x4 acc[8];
      bf16x8 ring[8];
#pragma unroll
      for (int q = 0; q < 8; ++q) { acc[q] = (f32x4){0.f, 0.f, 0.f, 0.f}; ring[q] = zero8; }
      uint4 st[NLD];
#pragma unroll
      for (int i = 0; i < NLD; ++i) {
        int s = -32 + scol[i];
        bool ok = (tid + 256 * i < NV) && s >= 0 && s <= T - 8;
        st[i] = ok ? *(const uint4*)(U + rowbase_blk + srow[i] * T + s) : make_uint4(0, 0, 0, 0);
      }
      __syncthreads();
#pragma unroll
      for (int i = 0; i < NLD; ++i) if (tid + 256 * i < NV) *(uint4*)(ub + srow[i] * LS + scol[i]) = st[i];
      __syncthreads();
      unsigned x0 = 0, x1 = 0, x2 = 0, x3 = 0;
      if (active) {
        const int li0 = t0 + DMAX + n - 8 * g + T + PADL;
        const unsigned ad = klw + (((li0 - 7) >> 1) << 2);
        asm volatile("ds_read_b32 %0, %4 offset:12\n\tds_read_b32 %1, %4 offset:8\n\tds_read_b32 %2, %4 offset:4\n\tds_read_b32 %3, %4"
                     : "=&v"(x0), "=&v"(x1), "=&v"(x2), "=&v"(x3) : "v"(ad));
      }
      for (int ib = 0; ib < NB; ++ib) {
        const u16* cur = ub + (ib & 1) * (R * LS);
        if (ib + 1 < NB) {
#pragma unroll
          for (int i = 0; i < NLD; ++i) {
            int s = 256 * (ib + 1) - 32 + scol[i];
            bool ok = (tid + 256 * i < NV) && s >= 0 && s <= T - 8;
            st[i] = ok ? *(const uint4*)(U + rowbase_blk + srow[i] * T + s) : make_uint4(0, 0, 0, 0);
          }
        }
        if (active) {
#pragma unroll
          for (int u = 0; u < 8; ++u) {
            const int it = ib * 8 + u;
#pragma unroll
            for (int j = 0; j < NEW; ++j)
              ring[(8 - NEW + j + NEW * u) & 7] = *(const bf16x8*)(cur + lrow * LS + 16 * j + 32 * u + lane_s);
            asm volatile("s_waitcnt lgkmcnt(0)" : "+v"(x0), "+v"(x1), "+v"(x2), "+v"(x3));
            union { bf16x8 v; unsigned w[4]; } avu;
            avu.w[0] = (x0 >> 16) | (x0 << 16); avu.w[1] = (x1 >> 16) | (x1 << 16);
            avu.w[2] = (x2 >> 16) | (x2 << 16); avu.w[3] = (x3 >> 16) | (x3 << 16);
            const bf16x8 av = avu.v;
            {
              const int li0 = t0 + DMAX - 32 * (it + 1) + n - 8 * g + T + PADL;
              const unsigned ad = klw + (((li0 - 7) >> 1) << 2);
              asm volatile("ds_read_b32 %0, %4 offset:12\n\tds_read_b32 %1, %4 offset:8\n\tds_read_b32 %2, %4 offset:4\n\tds_read_b32 %3, %4"
                           : "=&v"(x0), "=&v"(x1), "=&v"(x2), "=&v"(x3) : "v"(ad));
            }
#pragma unroll
            for (int q = 0; q < 8; ++q)
              acc[q] = __builtin_amdgcn_mfma_f32_16x16x32_bf16(av, ring[(q + NEW * u) & 7], acc[q], 0, 0, 0);
          }
        }
        if (ib + 1 < NB) {
          u16* nb = ub + ((ib + 1) & 1) * (R * LS);
#pragma unroll
          for (int i = 0; i < NLD; ++i) if (tid + 256 * i < NV) *(uint4*)(nb + srow[i] * LS + scol[i]) = st[i];
        }
        __syncthreads();
      }
      if (active) {
#pragma unroll
        for (int q = 0; q < 8; ++q) {
          const int t = t0 + TW * q + toff + 4 * g;
          const int rb = rowbase_blk + lrow * T;
          if (t < T) {
            uint2 uu = *(const uint2*)(U + rb + t);
            uint2 xx = *(const uint2*)(X + rb + t);
            float uv[4] = {lo2f(uu.x), hi2f(uu.x), lo2f(uu.y), hi2f(uu.y)};
            float xv[4] = {lo2f(xx.x), hi2f(xx.x), lo2f(xx.y), hi2f(xx.y)};
            float zv[4];
#pragma unroll
            for (int j = 0; j < 4; ++j) zv[j] = xv[j] * (acc[q][j] * invl1 + uv[j] * bias);
            u16* Z = (ORD == 0 ? (u16*)((char*)p.out + OD_PROJ) : (u16*)(p.ws + OFF_BR + 3 * SZ_BR)) + (long)c * NT;
            *(uint2*)(Z + rb + t) = make_uint2(pack2(zv[0], zv[1]), pack2(zv[2], zv[3]));
          }
        }
      }
    }
  }
}

template <int ORD>
__device__ void longconv_phase(const P& p, int l, char* smem) {
  u16* kl = (u16*)smem;
  for (int task = bidx(); task < 1024; task += gridDim.x) {
    int c = task & 511;
    if (task >= 512) longconv_task<true, ORD>(p, l, c, kl);
    else longconv_task<false, ORD>(p, l, c, kl);
  }
}

__device__ void hyena_tr_phase(const P& p, char* smem) {
  const u16* ZT = (const u16*)(p.ws + OFF_BR + 3 * SZ_BR);
  u16* BR2 = (u16*)(p.ws + OFF_BR + 2 * SZ_BR);
  u16* tile = (u16*)smem;
  const int tid = tidx();
  const int ntile = (NT / 64) * 8;
  for (int id = bidx(); id < ntile; id += gridDim.x) {
    int r0 = (id >> 3) * 64, c0 = (id & 7) * 64;
    __syncthreads();
#pragma unroll
    for (int i = 0; i < 2; ++i) {
      int item = tid + 256 * i;
      int cl = item >> 3, tv = (item & 7) * 8;
      uint4 v = *(const uint4*)(ZT + (long)(c0 + cl) * NT + r0 + tv);
      unsigned w4[4] = {v.x, v.y, v.z, v.w};
#pragma unroll
      for (int e = 0; e < 4; ++e) { tile[(tv + 2 * e) * 72 + cl] = (u16)(w4[e] & 0xffffu); tile[(tv + 2 * e + 1) * 72 + cl] = (u16)(w4[e] >> 16); }
    }
    __syncthreads();
#pragma unroll
    for (int i = 0; i < 2; ++i) {
      int item = tid + 256 * i;
      int rl = item >> 3, cv = (item & 7) * 8;
      *(uint4*)(BR2 + (long)(r0 + rl) * 512 + c0 + cv) = *(const uint4*)(tile + rl * 72 + cv);
    }
  }
}

__device__ void sc_phase(const P& p, int l) {
  const u16* PR = (const u16*)((char*)p.out + OD_PROJ);
  const float* cw = p.in[19] + l * 3 * 512;
  u16* BR3 = (u16*)(p.ws + OFF_BR + 3 * SZ_BR);
  float w0[8], w1[8], w2[8];
  { const int c80 = (tidx() & 63) * 8; ld8(cw + c80, w0); ld8(cw + 512 + c80, w1); ld8(cw + 1024 + c80, w2); }
  for (long i = (long)bidx() * 256 + tidx(); i < (long)NT * 64; i += (long)gridDim.x * 256) {
    int row = (int)(i >> 6), c8 = (int)(i & 63) * 8;
    int t, T; row_info(row, t, T);
    const u16* pr = PR + (long)row * 1536;
    uint4 bg = *(const uint4*)(pr + c8);
    uint4 z4 = make_uint4(0, 0, 0, 0);
    uint4 c1 = *(const uint4*)(pr + 512 + c8), x1 = *(const uint4*)(pr + 1024 + c8);
    uint4 c0 = z4, x0 = z4, c2 = z4, x2 = z4;
    if (t > 0) { c0 = *(const uint4*)(pr - 1536 + 512 + c8); x0 = *(const uint4*)(pr - 1536 + 1024 + c8); }
    if (t < T - 1) { c2 = *(const uint4*)(pr + 1536 + 512 + c8); x2 = *(const uint4*)(pr + 1536 + 1024 + c8); }
    unsigned bga[4] = {bg.x, bg.y, bg.z, bg.w};
    unsigned c0a[4] = {c0.x, c0.y, c0.z, c0.w}, x0a[4] = {x0.x, x0.y, x0.z, x0.w};
    unsigned c1a[4] = {c1.x, c1.y, c1.z, c1.w}, x1a[4] = {x1.x, x1.y, x1.z, x1.w};
    unsigned c2a[4] = {c2.x, c2.y, c2.z, c2.w}, x2a[4] = {x2.x, x2.y, x2.z, x2.w};
    unsigned o[4];
#pragma unroll
    for (int e = 0; e < 4; ++e) {
      float lo = lo2f(bga[e]) * (w0[2 * e] * lo2f(c0a[e]) * lo2f(x0a[e]) + w1[2 * e] * lo2f(c1a[e]) * lo2f(x1a[e]) + w2[2 * e] * lo2f(c2a[e]) * lo2f(x2a[e]));
      float hi = hi2f(bga[e]) * (w0[2 * e + 1] * hi2f(c0a[e]) * hi2f(x0a[e]) + w1[2 * e + 1] * hi2f(c1a[e]) * hi2f(x1a[e]) + w2[2 * e + 1] * hi2f(c2a[e]) * hi2f(x2a[e]));
      o[e] = pack2(lo, hi);
    }
    *(uint4*)(BR3 + (long)row * 512 + c8) = make_uint4(o[0], o[1], o[2], o[3]);
  }
}

__device__ void ffn_act_phase(const P& p, int l, int rb, int re) {
  const u16* UP = (const u16*)((char*)p.out + OD_PROJ);
  const float* cw = p.in[23] + (size_t)l * 3 * 5632;
  u16* ACT = (u16*)(p.ws + OFF_BR);
  const long nitem = (long)(re - rb) * 352;
  for (long i = (long)bidx() * 256 + tidx(); i < nitem; i += (long)gridDim.x * 256) {
    int lr = (int)(i / 352), j8 = (int)(i % 352) * 8;
    int row = rb + lr;
    int t, T; row_info(row, t, T);
    const u16* pr = UP + (long)lr * 5632;
    uint4 z4 = make_uint4(0, 0, 0, 0);
    uint4 a1 = *(const uint4*)(pr + j8), v1 = *(const uint4*)(pr + 2816 + j8);
    uint4 a0 = z4, v0 = z4, a2 = z4, v2 = z4;
    if (t > 0) { a0 = *(const uint4*)(pr - 5632 + j8); v0 = *(const uint4*)(pr - 5632 + 2816 + j8); }
    if (t < T - 1) { a2 = *(const uint4*)(pr + 5632 + j8); v2 = *(const uint4*)(pr + 5632 + 2816 + j8); }
    unsigned a0a[4] = {a0.x, a0.y, a0.z, a0.w}, a1a[4] = {a1.x, a1.y, a1.z, a1.w}, a2a[4] = {a2.x, a2.y, a2.z, a2.w};
    unsigned v0a[4] = {v0.x, v0.y, v0.z, v0.w}, v1a[4] = {v1.x, v1.y, v1.z, v1.w}, v2a[4] = {v2.x, v2.y, v2.z, v2.w};
    float wa0[8], wa1[8], wa2[8], wv0[8], wv1[8], wv2[8];
    ld8(cw + j8, wa0); ld8(cw + 5632 + j8, wa1); ld8(cw + 11264 + j8, wa2);
    ld8(cw + 2816 + j8, wv0); ld8(cw + 5632 + 2816 + j8, wv1); ld8(cw + 11264 + 2816 + j8, wv2);
    unsigned o[4];
#pragma unroll
    for (int e = 0; e < 4; ++e) {
      float al = wa0[2 * e] * lo2f(a0a[e]) + wa1[2 * e] * lo2f(a1a[e]) + wa2[2 * e] * lo2f(a2a[e]);
      float ah = wa0[2 * e + 1] * hi2f(a0a[e]) + wa1[2 * e + 1] * hi2f(a1a[e]) + wa2[2 * e + 1] * hi2f(a2a[e]);
      float vl = wv0[2 * e] * lo2f(v0a[e]) + wv1[2 * e] * lo2f(v1a[e]) + wv2[2 * e] * lo2f(v2a[e]);
      float vh = wv0[2 * e + 1] * hi2f(v0a[e]) + wv1[2 * e + 1] * hi2f(v1a[e]) + wv2[2 * e + 1] * hi2f(v2a[e]);
      o[e] = pack2(siluf(al) * vl, siluf(ah) * vh);
    }
    *(uint4*)(ACT + (long)row * 2816 + j8) = make_uint4(o[0], o[1], o[2], o[3]);
  }
}

__device__ __forceinline__ void ffn_gate_rows(const u16* E, int rfirst, int tpos0, int T, int sb, int j0, const float* cw, u16* ACT, int tid) {
#pragma unroll
  for (int it = 0; it < 4; ++it) {
    const int item = tid + 256 * it;
    const int r = rfirst + (item >> 3), cg = (item & 7) * 8;
    const int t = tpos0 + r;
    if ((item >> 3) < 127 && t < T) {
      uint4 ea0 = *(const uint4*)(E + (r - 1) * 136 + cg), ea1 = *(const uint4*)(E + r * 136 + cg), ea2 = *(const uint4*)(E + (r + 1) * 136 + cg);
      uint4 ev0 = *(const uint4*)(E + (r - 1) * 136 + 64 + cg), ev1 = *(const uint4*)(E + r * 136 + 64 + cg), ev2 = *(const uint4*)(E + (r + 1) * 136 + 64 + cg);
      const uint4 z4 = make_uint4(0, 0, 0, 0);
      if (t == 0) { ea0 = z4; ev0 = z4; }
      if (t == T - 1) { ea2 = z4; ev2 = z4; }
      unsigned a0a[4] = {ea0.x, ea0.y, ea0.z, ea0.w}, a1a[4] = {ea1.x, ea1.y, ea1.z, ea1.w}, a2a[4] = {ea2.x, ea2.y, ea2.z, ea2.w};
      unsigned v0a[4] = {ev0.x, ev0.y, ev0.z, ev0.w}, v1a[4] = {ev1.x, ev1.y, ev1.z, ev1.w}, v2a[4] = {ev2.x, ev2.y, ev2.z, ev2.w};
      float wa0[8], wa1[8], wa2[8], wv0[8], wv1[8], wv2[8];
      const int j8 = j0 + cg;
      ld8(cw + j8, wa0); ld8(cw + 5632 + j8, wa1); ld8(cw + 11264 + j8, wa2);
      ld8(cw + 2816 + j8, wv0); ld8(cw + 5632 + 2816 + j8, wv1); ld8(cw + 11264 + 2816 + j8, wv2);
      unsigned o[4];
#pragma unroll
      for (int e = 0; e < 4; ++e) {
        float al = wa0[2 * e] * lo2f(a0a[e]) + wa1[2 * e] * lo2f(a1a[e]) + wa2[2 * e] * lo2f(a2a[e]);
        float ah = wa0[2 * e + 1] * hi2f(a0a[e]) + wa1[2 * e + 1] * hi2f(a1a[e]) + wa2[2 * e + 1] * hi2f(a2a[e]);
        float vl = wv0[2 * e] * lo2f(v0a[e]) + wv1[2 * e] * lo2f(v1a[e]) + wv2[2 * e] * lo2f(v2a[e]);
        float vh = wv0[2 * e + 1] * hi2f(v0a[e]) + wv1[2 * e + 1] * hi2f(v1a[e]) + wv2[2 * e + 1] * hi2f(v2a[e]);
        o[e] = pack2(siluf(al) * vl, siluf(ah) * vh);
      }
      *(uint4*)(ACT + (long)(sb + t) * 2816 + j8) = make_uint4(o[0], o[1], o[2], o[3]);
    }
  }
}

__device__ void ffn_up_fused_phase(const P& p, int l, char* smem) {
  u16* sA = (u16*)smem; u16* sB = sA + 256 * 72;
  u16* E = (u16*)smem;
  const u16* HN = (const u16*)(p.ws + OFF_HN);
  const u16* W = (const u16*)(p.ws + (size_t)l * SZ_WL + OW_UP);
  const float* cw = p.in[23] + (size_t)l * 3 * 5632;
  u16* ACT = (u16*)(p.ws + OFF_BR);
  const int tid = tidx(), lane = tid & 63, wid = tid >> 6, wr = wid >> 1, wc = wid & 1, fr = lane & 15, fq = lane >> 4;
  const int G = gridDim.x, bq = bidx();
  const int bsw = (G & 7) == 0 ? (bq & 7) * (G >> 3) + (bq >> 3) : bq;
  const int ntiles = 424 * 44;
  for (int tile = bsw; tile < ntiles; tile += G) {
    const int mgp = tile / 352, rr = tile - mgp * 352;
    const int nbk = rr >> 5, qq = rr & 31;
    const int mi = mgp * 8 + (qq >> 2), jt = nbk * 4 + (qq & 3);
    int seq, mt;
    if (mi < 288) { seq = mi / 9; mt = mi - seq * 9; } else { int q = mi - 288; seq = 32 + q / 17; mt = q - (q / 17) * 17; }
    const int T = seq < 32 ? TP : TS;
    const int sb = seq_base(seq);
    const int tfirst = 254 * mt - 1;
    const int j0 = jt * 64;
    f32x4 acc[8][4];
#pragma unroll
    for (int m = 0; m < 8; ++m)
#pragma unroll
      for (int n = 0; n < 4; ++n) acc[m][n] = (f32x4){0.f, 0.f, 0.f, 0.f};
    {
      const int lr = tid >> 3, lk = (tid & 7) * 8;
      const u16* pA = HN + (long)(sb + tfirst + lr) * 1024 + lk;
      const u16* pBa = W + (long)(j0 + lr) * 1024 + lk;
      const u16* pBv = W + (long)(2816 + j0 + lr) * 1024 + lk;
      uint4 a0, a1, a2, a3, a4, a5, a6, a7, b0, b1, b2, b3;
#define UP_LOAD(k) do { \
      a0 = *(const uint4*)(pA + (k)); a1 = *(const uint4*)(pA + (k) + 32 * 1024); a2 = *(const uint4*)(pA + (k) + 64 * 1024); a3 = *(const uint4*)(pA + (k) + 96 * 1024); \
      a4 = *(const uint4*)(pA + (k) + 128 * 1024); a5 = *(const uint4*)(pA + (k) + 160 * 1024); a6 = *(const uint4*)(pA + (k) + 192 * 1024); a7 = *(const uint4*)(pA + (k) + 224 * 1024); \
      b0 = *(const uint4*)(pBa + (k)); b1 = *(const uint4*)(pBa + (k) + 32 * 1024); b2 = *(const uint4*)(pBv + (k)); b3 = *(const uint4*)(pBv + (k) + 32 * 1024); } while (0)
      UP_LOAD(0);
      u16* wA = sA + lr * 72 + lk;
      for (int kt = 0; kt < 16; ++kt) {
        __syncthreads();
        *(uint4*)(wA) = a0; *(uint4*)(wA + 32 * 72) = a1; *(uint4*)(wA + 64 * 72) = a2; *(uint4*)(wA + 96 * 72) = a3;
        *(uint4*)(wA + 128 * 72) = a4; *(uint4*)(wA + 160 * 72) = a5; *(uint4*)(wA + 192 * 72) = a6; *(uint4*)(wA + 224 * 72) = a7;
        *(uint4*)(wA + 256 * 72) = b0; *(uint4*)(wA + 288 * 72) = b1; *(uint4*)(wA + 320 * 72) = b2; *(uint4*)(wA + 352 * 72) = b3;
        __syncthreads();
        const int k = (kt + 1 < 16 ? kt + 1 : kt) * 64;
        UP_LOAD(k);
        gemm_compute<true, 8>(acc, sA, sB, wr, wc, fr, fq);
      }
#undef UP_LOAD
    }
    unsigned pk[8][4][2];
#pragma unroll
    for (int m = 0; m < 8; ++m)
#pragma unroll
      for (int n = 0; n < 4; ++n) { pk[m][n][0] = pack2(acc[m][n][0], acc[m][n][1]); pk[m][n][1] = pack2(acc[m][n][2], acc[m][n][3]); }
    __syncthreads();
    if (wr == 0) {
#pragma unroll
      for (int m = 0; m < 8; ++m)
#pragma unroll
        for (int n = 0; n < 4; ++n)
          *(uint2*)(E + (m * 16 + fr) * 136 + wc * 64 + n * 16 + fq * 4) = make_uint2(pk[m][n][0], pk[m][n][1]);
    } else if (fr == 0) {
#pragma unroll
      for (int n = 0; n < 4; ++n)
        *(uint2*)(E + 128 * 136 + wc * 64 + n * 16 + fq * 4) = make_uint2(pk[0][n][0], pk[0][n][1]);
    }
    __syncthreads();
    ffn_gate_rows(E, 1, tfirst, T, sb, j0, cw, ACT, tid);
    __syncthreads();
    if (wr == 1) {
#pragma unroll
      for (int m = 0; m < 8; ++m)
#pragma unroll
        for (int n = 0; n < 4; ++n)
          *(uint2*)(E + (1 + m * 16 + fr) * 136 + wc * 64 + n * 16 + fq * 4) = make_uint2(pk[m][n][0], pk[m][n][1]);
    } else if (fr == 15) {
#pragma unroll
      for (int n = 0; n < 4; ++n)
        *(uint2*)(E + wc * 64 + n * 16 + fq * 4) = make_uint2(pk[7][n][0], pk[7][n][1]);
    }
    __syncthreads();
    ffn_gate_rows(E, 1, tfirst + 127, T, sb, j0, cw, ACT, tid);
  }
}

__device__ void merge_phase(const P& p, int l, char* smem) {
  u16* sA = (u16*)smem; u16* sB = sA + 128 * 72;
  const u16* HN = (const u16*)(p.ws + OFF_HN);
  const char* wl = p.ws + (size_t)l * SZ_WL;
  const u16* Wg = (const u16*)(wl + OW_IN) + (size_t)5136 * 1024;
  const u16* Wb = (const u16*)(wl + OW_BR);
  u16* MG = (u16*)((char*)p.out + OD_PROJ);
  const int nN = 8, nM = NT / 128;
  const int G = gridDim.x, bq = bidx();
  const int bsw = (G & 7) == 0 ? (bq & 7) * (G >> 3) + (bq >> 3) : bq;
  for (int tile = bsw; tile < nM * nN; tile += G) {
    int m0 = (tile / nN) * 128, n0 = (tile % nN) * 128;
    unsigned mgp[4][4][2];
#pragma unroll
    for (int m = 0; m < 4; ++m)
#pragma unroll
      for (int n = 0; n < 4; ++n) { mgp[m][n][0] = 0u; mgp[m][n][1] = 0u; }
    for (int k = 0; k < 4; ++k) {
      unsigned gate[4][4][2];
      {
        f32x4 acc[4][4];
#pragma unroll
        for (int m = 0; m < 4; ++m)
#pragma unroll
          for (int n = 0; n < 4; ++n) acc[m][n] = (f32x4){0.f, 0.f, 0.f, 0.f};
        GA g{HN, 1024, NT, Wg + (size_t)k * 1024 * 1024, 1024, 1024, 1024};
        gemm_main_db_4<true>(g, m0, n0, acc, sA);
#pragma unroll
        for (int m = 0; m < 4; ++m)
#pragma unroll
          for (int n = 0; n < 4; ++n) {
            gate[m][n][0] = pack2(sigmf(acc[m][n][0]), sigmf(acc[m][n][1]));
            gate[m][n][1] = pack2(sigmf(acc[m][n][2]), sigmf(acc[m][n][3]));
          }
      }
      {
        f32x4 acc[4][4];
#pragma unroll
        for (int m = 0; m < 4; ++m)
#pragma unroll
          for (int n = 0; n < 4; ++n) acc[m][n] = (f32x4){0.f, 0.f, 0.f, 0.f};
        GA g{(const u16*)(p.ws + OFF_BR + (size_t)k * SZ_BR), 512, NT, Wb + (size_t)k * 1024 * 512, 512, 1024, 512};
        gemm_main_db_4<true>(g, m0, n0, acc, sA);
#pragma unroll
        for (int m = 0; m < 4; ++m)
#pragma unroll
          for (int n = 0; n < 4; ++n) {
            mgp[m][n][0] = pack2(lo2f(mgp[m][n][0]) + lo2f(gate[m][n][0]) * acc[m][n][0], hi2f(mgp[m][n][0]) + hi2f(gate[m][n][0]) * acc[m][n][1]);
            mgp[m][n][1] = pack2(lo2f(mgp[m][n][1]) + lo2f(gate[m][n][1]) * acc[m][n][2], hi2f(mgp[m][n][1]) + hi2f(gate[m][n][1]) * acc[m][n][3]);
          }
      }
    }
    const int lane = tidx() & 63, wid = tidx() >> 6, wr = wid >> 1, wc = wid & 1, fr = lane & 15, fq = lane >> 4;
#pragma unroll
    for (int m = 0; m < 4; ++m)
#pragma unroll
      for (int n = 0; n < 4; ++n) {
        int row = m0 + wr * 64 + m * 16 + fr, col = n0 + wc * 64 + n * 16 + fq * 4;
        *(uint2*)(MG + (long)row * 1024 + col) = make_uint2(mgp[m][n][0], mgp[m][n][1]);
      }
  }
}

__global__ void __launch_bounds__(256, 2) hybrid_fwd(P p) {
  cg::grid_group grid = cg::this_grid();
  __shared__ __attribute__((aligned(16))) char smem[55296];
  u16* H = (u16*)(p.ws + OFF_H);
  u16* HN = (u16*)(p.ws + OFF_HN);
  u16* PROJ = (u16*)((char*)p.out + OD_PROJ);

  __shared__ uint4 xb_words;
  if (threadIdx.x == 0) xb_words = make_uint4(0u, 0u, 0u, 0u);
  __syncthreads();
  XcdBarrier xb = xcd_barrier_post((unsigned*)(p.ws + OFF_BAR), (volatile LAS unsigned*)&xb_words);
  prep_phase(p, smem);
  grid.sync();

  for (int l = 0; l < 2; ++l) {
    const char* wl = p.ws + (size_t)l * SZ_WL;
    for (int rep = 0; rep < REPE; ++rep) rmsnorm_phase(H, p.in[3] + l * 1024, HN, nullptr, 0);
    for (int rep = 0; rep < REPE; ++rep) hyena_hid_phase(p, l);
    GSYNC();
    {
      GA g{HN, 1024, NT, (const u16*)(wl + OW_FN), 1024, 1024, 1024};
      gemm_phase256<false>(g, [&](int row, int col, f32x4 v) {
        if (row >= NT) return;
        int t, T; row_info(row, t, T);
        const int Th = T == TP ? THP : THS;
        long gb = T == TP ? (long)(row / TP) * (512l * 2 * THP) : GT_SAMPLE0 + (long)((row - ROWS_P) / TS) * (512l * 2 * THS);
        int c = col & 511, half = col >> 9;
        *(uint2*)(PROJ + gb + (long)(c * 2 + half) * Th + t) = make_uint2(pack2(v[0], v[1]), pack2(v[2], v[3]));
      }, smem, REPG);
      for (long i = (long)bidx() * 256 + tidx(); i < 40l * 1024 * 6; i += (long)gridDim.x * 256) {
        int rowi = (int)(i / 6), v6 = (int)(i % 6);
        int seq = rowi >> 10, ch = rowi & 1023;
        long off = seq < 32 ? (long)seq * (512l * 2 * THP) + (long)ch * THP + TP : GT_SAMPLE0 + (long)(seq - 32) * (512l * 2 * THS) + (long)ch * THS + TS;
        unsigned zz = 0; asm volatile("" : "+v"(zz));
        *(uint4*)(PROJ + off + v6 * 8) = make_uint4(zz, zz, zz, zz);
      }
    }
    GSYNC();
    {
      u16* BR0 = (u16*)(p.ws + OFF_BR);
      u16* sA = (u16*)smem; u16* sB = sA + 128 * 72;
      const int tiles_s = 8 * 17 * 4, tiles_p = 32 * 9 * 4;
      const int Gd = gridDim.x, bd = bidx();
      const bool bal = (Gd == 512);
      const int nslot = bal ? 4 : (tiles_s + tiles_p + Gd - 1) / Gd;
      for (int rep = 0; rep < REPG; ++rep)
      for (int slot = 0; slot < nslot; ++slot) {
        int tile;
        if (bal) {
          if (slot == 0) tile = bd;
          else if (bd < 32) tile = slot == 1 ? 512 + bd : (slot == 2 ? tiles_s + bd : -1);
          else { int pi = 32 + (bd - 32) + 480 * (slot - 1); tile = pi < tiles_p ? tiles_s + pi : -1; }
        } else tile = bd + slot * Gd;
        if (tile < 0 || tile >= tiles_s + tiles_p) continue;
        int seq, mt, nt, T, Th;
        if (tile < tiles_s) { mt = tile / 32; int r = tile % 32; seq = 32 + (r >> 2); nt = r & 3; T = TS; Th = THS; }
        else { int q = tile - tiles_s; mt = q / 128; int r = q % 128; seq = r >> 2; nt = r & 3; T = TP; Th = THP; }
        const int sb = seq_base(seq);
        const u16* Am = (const u16*)((char*)p.out + (T == TS ? OD_DFTS : OD_DFTP));
        const u16* Bm = PROJ + (seq < 32 ? (long)seq * (512l * 2 * THP) : GT_SAMPLE0 + (long)(seq - 32) * (512l * 2 * THS));
        f32x4 accP[4][4], accQ[4][4];
#pragma unroll
        for (int m = 0; m < 4; ++m)
#pragma unroll
          for (int n = 0; n < 4; ++n) { accP[m][n] = (f32x4){0.f, 0.f, 0.f, 0.f}; accQ[m][n] = (f32x4){0.f, 0.f, 0.f, 0.f}; }
        {
          GA g{Am, 2l * Th, T, Bm, 2l * Th, 512, Th};
          gemm_main2_4<true>(g, mt * 128, nt * 128, accP, sA, sB);
        }
        {
          GA g{Am + Th, 2l * Th, T, Bm + Th, 2l * Th, 512, Th};
          gemm_main2_4<true>(g, mt * 128, nt * 128, accQ, sA, sB);
        }
        const float sc = rsqrtf((float)T * 128.f);
        const int lane = tidx() & 63, wid = tidx() >> 6, wr = wid >> 1, wc = wid & 1, fr = lane & 15, fq = lane >> 4;
#pragma unroll
        for (int m = 0; m < 4; ++m)
#pragma unroll
          for (int n = 0; n < 4; ++n) {
            int row = mt * 128 + wr * 64 + m * 16 + fr, col = nt * 128 + wc * 64 + n * 16 + fq * 4;
            f32x4 pv = accP[m][n], qv = accQ[m][n];
            if (row <= T / 2)
              *(uint2*)(BR0 + (long)(sb + row) * 512 + col) = make_uint2(pack2((pv[0] - qv[0]) * sc, (pv[1] - qv[1]) * sc), pack2((pv[2] - qv[2]) * sc, (pv[3] - qv[3]) * sc));
            if (row >= 1 && row < T / 2)
              *(uint2*)(BR0 + (long)(sb + T - row) * 512 + col) = make_uint2(pack2((pv[0] + qv[0]) * sc, (pv[1] + qv[1]) * sc), pack2((pv[2] + qv[2]) * sc, (pv[3] + qv[3]) * sc));
          }
      }
    }
    GSYNC();
    {
      GA g{HN, 1024, NT, (const u16*)(wl + OW_IN) + (size_t)512 * 1024, 1024, 1552, 1024};
      gemm_phase256<true>(g, [&](int row, int col, f32x4 v) {
        if (col < 1552 && row < NT) *(uint2*)(PROJ + (long)row * 1552 + col) = make_uint2(pack2(v[0], v[1]), pack2(v[2], v[3]));
      }, smem, REPG);
    }
    GSYNC();
    ssd_conv_phase(p, l);
    GSYNC();
    for (int rep = 0; rep < REPS; ++rep) ssd_scan_phase(p, l, smem);
    { const int kf0 = (int)gridDim.x > 384 ? 384 : 0; hyena_kf_phase(p, l, kf0, (int)gridDim.x - kf0); }
    GSYNC();
    ssd_state_phase(p);
    GSYNC();
    ssd_fix_phase(p);
    GSYNC();
    for (int rep = 0; rep < REPE; ++rep) ssd_post_phase(p, l);
    GSYNC();
    {
      GA g{HN, 1024, NT, (const u16*)(wl + OW_IN) + (size_t)2064 * 1024, 1024, 1536, 1024};
      gemm_phase256<true>(g, [&](int row, int col, f32x4 v) {
        if (row < NT) *(uint2*)(PROJ + (long)row * 1536 + col) = make_uint2(pack2(v[0], v[1]), pack2(v[2], v[3]));
      }, smem, REPG);
    }
    GSYNC();
    for (int rep = 0; rep < REPE; ++rep) hyena_prep_phase(p, l, smem);
    GSYNC();
    for (int rep = 0; rep < REPL; ++rep) longconv_phase<0>(p, l, smem);
    GSYNC();
    for (int rep = 0; rep < REPL; ++rep) longconv_phase<1>(p, l, smem);
    GSYNC();
    hyena_tr_phase(p, smem);
    GSYNC();
    {
      GA g{HN, 1024, NT, (const u16*)(wl + OW_IN) + (size_t)3600 * 1024, 1024, 1536, 1024};
      gemm_phase256<true>(g, [&](int row, int col, f32x4 v) {
        if (row < NT) *(uint2*)(PROJ + (long)row * 1536 + col) = make_uint2(pack2(v[0], v[1]), pack2(v[2], v[3]));
      }, smem, REPG);
    }
    GSYNC();
    for (int rep = 0; rep < REPE; ++rep) sc_phase(p, l);
    GSYNC();
    for (int rep = 0; rep < REPG; ++rep) merge_phase(p, l, smem);
    GSYNC();
    {
      GA g{PROJ, 1024, NT, (const u16*)(wl + OW_OUT), 1024, 1024, 1024};
      gemm_phase256<true>(g, [&](int row, int col, f32x4 v) {
        if (row >= NT) return;
        uint2* hp = (uint2*)(H + (long)row * 1024 + col);
        uint2 o = *hp;
        *hp = make_uint2(pack2(lo2f(o.x) + v[0], hi2f(o.x) + v[1]), pack2(lo2f(o.y) + v[2], hi2f(o.y) + v[3]));
      }, smem, 1);
    }
    GSYNC();
    for (int rep = 0; rep < REPE; ++rep) rmsnorm_phase(H, p.in[22] + l * 1024, HN, nullptr, 0);
    GSYNC();
    for (int rep = 0; rep < REPG; ++rep) ffn_up_fused_phase(p, l, smem);
    GSYNC();
    {
      GA g{(const u16*)(p.ws + OFF_BR), 2816, NT, (const u16*)(wl + OW_DOWN), 2816, 1024, 2816};
      gemm_phase256<true>(g, [&](int row, int col, f32x4 v) {
        if (row >= NT) return;
        uint2* hp = (uint2*)(H + (long)row * 1024 + col);
        uint2 o = *hp;
        *hp = make_uint2(pack2(lo2f(o.x) + v[0], hi2f(o.x) + v[1]), pack2(lo2f(o.y) + v[2], hi2f(o.y) + v[3]));
      }, smem, 1);
    }
    GSYNC();
  }
  final_phase(p);
}

extern "C" void kernel_launch(void* const* d_in, const int* in_sizes, int n_in, void* d_out, int out_size,
                              void* d_ws, size_t ws_size, hipStream_t stream) {
  static int grid_blocks = 0;
  if (!grid_blocks) {
    int dev = 0, cus = 0, per_cu = 0;
    (void)hipGetDevice(&dev);
    (void)hipDeviceGetAttribute(&cus, hipDeviceAttributeMultiprocessorCount, dev);
    (void)hipOccupancyMaxActiveBlocksPerMultiprocessor(&per_cu, hybrid_fwd, 256, 0);
    if (per_cu > 2) per_cu = 2;
    grid_blocks = cus * per_cu;
  }
  if (ws_size < WS_TOTAL) { fprintf(stderr, "workspace too small: %zu < %zu\n", ws_size, (size_t)WS_NEED); return; }
  (void)hipMemsetAsync((char*)d_ws + OFF_BAR, 0, XCD_BAR_WORDS_C * 4, stream);
  P p{};
  for (int i = 0; i < 27; ++i) p.in[i] = (const float*)d_in[i];
  p.out = (float*)d_out;
  p.ws = (char*)d_ws;
  void* args[] = {&p};
  hipError_t e = hipLaunchCooperativeKernel((void*)hybrid_fwd, dim3(grid_blocks), dim3(256), args, 0, stream);
  if (e != hipSuccess) fprintf(stderr, "cooperative launch failed: %s (grid %d)\n", hipGetErrorString(e), grid_blocks);
}
```

```cpp
#include <hip/hip_runtime.h>
#include <hip/hip_cooperative_groups.h>
#include <cstdio>
namespace cg = cooperative_groups;

typedef unsigned short u16;
using bf16x8 = __attribute__((ext_vector_type(8))) short;
using f32x4 = __attribute__((ext_vector_type(4))) float;

constexpr int NT = 98944, TP = 2064, TS = 4112, ROWS_P = 32 * 2064;
constexpr int DIN = 9232;
constexpr float EPS = 1e-6f;
constexpr int XCD_BAR_WORDS_C = 3456;
#ifndef REPG
#define REPG 1
#endif
#ifndef REPL
#define REPL 1
#endif
#ifndef REPS
#define REPS 1
#endif
#ifndef REPE
#define REPE 1
#endif
#ifndef REPY
#define REPY 1
#endif
#define GSYNC() do { for (int rs_ = 0; rs_ < REPY; ++rs_) xcd_barrier_impl(xb.bar, xb.x, xb.st); } while (0)

constexpr size_t SZ_WL = 44597248ull;
constexpr size_t OW_IN = 0, OW_FN = 18907136ull, OW_BR = OW_FN + 2097152ull, OW_OUT = OW_BR + 4194304ull,
                 OW_UP = OW_OUT + 2097152ull, OW_DOWN = OW_UP + 11534336ull;
constexpr size_t OFF_H = 2 * SZ_WL;
constexpr size_t SZ_ACT = (size_t)NT * 1024 * 2;
constexpr size_t OFF_HN = OFF_H + SZ_ACT;
constexpr size_t OFF_BR = OFF_HN + SZ_ACT;
constexpr size_t SZ_BR = (size_t)NT * 512 * 2;
constexpr size_t OFF_X2T = OFF_BR + 4 * SZ_BR;
constexpr size_t OFF_KF = OFF_X2T + SZ_BR;
constexpr size_t SZ_KF = 2ull * 512 * (4128 + 8224) * 2;
constexpr size_t OFF_HID = OFF_KF + SZ_KF;
constexpr size_t SZ_HID = (size_t)(TP + TS) * 64 * 4;
constexpr size_t OFF_L1 = OFF_HID + SZ_HID;
constexpr size_t WS_NEED = OFF_BR + (size_t)NT * 2816 * 2;
constexpr size_t OFF_BAR = (WS_NEED + 4095) / 4096 * 4096;
constexpr size_t WS_TOTAL = OFF_BAR + XCD_BAR_WORDS_C * 4;
constexpr int THP = 2112, THS = 4160;
constexpr int MHP = 9 * 128, MHS = 17 * 128;
constexpr size_t OD_DFTP = 0, OD_DFTS = (size_t)MHP * 2 * THP * 2, OD_PROJ = OD_DFTS + (size_t)MHS * 2 * THS * 2;
constexpr size_t OD_HS = OD_PROJ + (size_t)NT * 1552 * 2;
constexpr size_t OD_DS = OD_HS + 4ull * 56 * 4 * 8192 * 4;
constexpr size_t OD_CSG = OD_DS + 4ull * 56 * 4 * 4;
constexpr int SEGC = 33;
constexpr long GT_SAMPLE0 = 32l * 512 * 2 * THP;

struct P {
  const float* in[27];
  float* out;
  char* ws;
};

__device__ __forceinline__ u16 f2bf(float f) {
  unsigned u = __float_as_uint(f);
  u += 0x7fffu + ((u >> 16) & 1u);
  return (u16)(u >> 16);
}
__device__ __forceinline__ float bf2f(u16 h) { return __uint_as_float(((unsigned)h) << 16); }
__device__ __forceinline__ unsigned pack2(float a, float b) { return (unsigned)f2bf(a) | ((unsigned)f2bf(b) << 16); }
__device__ __forceinline__ float lo2f(unsigned u) { return __uint_as_float(u << 16); }
__device__ __forceinline__ float hi2f(unsigned u) { return __uint_as_float(u & 0xffff0000u); }
__device__ __forceinline__ float siluf(float x) { return x / (1.f + __expf(-x)); }
__device__ __forceinline__ float sigmf(float x) { return 1.f / (1.f + __expf(-x)); }

__device__ __forceinline__ int tidx() { int t = threadIdx.x; asm volatile("" : "+v"(t)); return t; }
__device__ __forceinline__ int bidx() { int b = blockIdx.x; asm volatile("" : "+s"(b)); return b; }
__device__ __forceinline__ void ld8(const float* p, float (&w)[8]) {
  float4 a = *(const float4*)p, b = *(const float4*)(p + 4);
  w[0] = a.x; w[1] = a.y; w[2] = a.z; w[3] = a.w; w[4] = b.x; w[5] = b.y; w[6] = b.z; w[7] = b.w;
}
__device__ __forceinline__ int seq_base(int seq) { return seq < 32 ? seq * TP : ROWS_P + (seq - 32) * TS; }
__device__ __forceinline__ void row_info(int r, int& t, int& T) {
  if (r < ROWS_P) { t = r % TP; T = TP; } else { t = (r - ROWS_P) % TS; T = TS; }
}
__device__ __forceinline__ float bperm(float v, int src_lane) {
  return __int_as_float(__builtin_amdgcn_ds_bpermute(src_lane << 2, __float_as_int(v)));
}
__device__ __forceinline__ float wave_sum(float v) {
  const int lane = tidx() & 63;
#pragma unroll
  for (int o = 32; o > 0; o >>= 1) v += bperm(v, lane ^ o);
  return v;
}


#define XB_TMO      128
#define XB_XCNT(j)  (256  + 64 * (j))
#define XB_XSUB(j)  (1280 + 64 * (j))
#define XB_XGEN(j)  (2304 + 64 * (j))
#define XB_TOP      3328
#define XB_TOPGEN   3392
#define XCD_BAR_WORDS 3456
#define XB_SPIN_CAP (1u << 24)
#define LAS __attribute__((address_space(3)))
__device__ __forceinline__ unsigned xb_ld(unsigned* p)              { return __hip_atomic_load(p, __ATOMIC_RELAXED, __HIP_MEMORY_SCOPE_AGENT); }
__device__ __forceinline__ unsigned xb_add(unsigned* p, unsigned v) { return __hip_atomic_fetch_add(p, v, __ATOMIC_RELAXED, __HIP_MEMORY_SCOPE_AGENT); }
__device__ __forceinline__ unsigned xb_xcc_id() { return (unsigned)__builtin_amdgcn_s_getreg((3 << 11) | 20) & 0xFu; }
#define XB_SPIN(cond, bar) do { unsigned _sp = 0; while (cond) { __builtin_amdgcn_s_sleep(1); \
    if ((++_sp & 255u) == 0u) { if (xb_ld(&(bar)[XB_TMO])) break; if (_sp > XB_SPIN_CAP) { atomicAdd(&(bar)[XB_TMO], 1u); break; } } } } while (0)
struct XcdBarrier { unsigned* bar; unsigned x; volatile LAS unsigned* st; };
__device__ __forceinline__ XcdBarrier xcd_barrier_post(unsigned* bar, volatile LAS unsigned* st) {
  XcdBarrier b; b.bar = bar; b.x = xb_xcc_id(); b.st = st;
  if (threadIdx.x == 0) (void)xb_add(&bar[XB_XCNT(b.x)], 1u);
  return b;
}
__device__ __forceinline__ void xcd_barrier_complete(unsigned* bar, unsigned x, unsigned& nloc, unsigned& nx) {
  const unsigned G = gridDim.x * gridDim.y * gridDim.z;
  unsigned sum, cnt, mine, sp = 0u;
  for (;;) {
    sum = 0u; cnt = 0u; mine = 0u;
#pragma unroll
    for (unsigned j = 0; j < 16; ++j) { const unsigned c = xb_ld(&bar[XB_XCNT(j)]); sum += c; cnt += (c > 0u) ? 1u : 0u; mine = (j == x) ? c : mine; }
    if (sum == G) break;
    __builtin_amdgcn_s_sleep(1);
    if ((++sp & 255u) == 0u) { if (xb_ld(&bar[XB_TMO])) break; if (sp > XB_SPIN_CAP) { atomicAdd(&bar[XB_TMO], 1u); break; } }
  }
  nloc = mine > 0u ? mine : 1u; nx = cnt > 0u ? cnt : 1u;
}
__device__ __noinline__ void xcd_barrier_impl(unsigned* bar, unsigned bx, volatile LAS unsigned* st) {
  XcdBarrier b; b.bar = bar; b.x = bx; b.st = st;
  asm volatile("s_waitcnt vmcnt(0)" ::: "memory");
  __syncthreads();
  if (threadIdx.x == 0) {
    unsigned* bar = b.bar;
    __builtin_amdgcn_s_waitcnt(0);
    unsigned nloc = b.st[0], nx = b.st[1];
    if (nloc == 0u) { xcd_barrier_complete(bar, b.x, nloc, nx); b.st[0] = nloc; b.st[1] = nx; }
    const unsigned old = xb_add(&bar[XB_XSUB(b.x)], 1u);
    const unsigned gen = old / nloc;
    if (old + 1u == (gen + 1u) * nloc) {
      __builtin_amdgcn_fence(__ATOMIC_RELEASE, "agent");
      asm volatile("s_waitcnt vmcnt(0)" ::: "memory");
      const unsigned og = xb_add(&bar[XB_TOP], 1u);
      const unsigned tg = og / nx;
      if (og + 1u == (tg + 1u) * nx) xb_add(&bar[XB_TOPGEN], 1u);
      else XB_SPIN(xb_ld(&bar[XB_TOPGEN]) == tg, bar);
      __builtin_amdgcn_fence(__ATOMIC_ACQUIRE, "agent");
      xb_add(&bar[XB_XGEN(b.x)], 1u);
      asm volatile("s_waitcnt vmcnt(0)" ::: "memory");
    } else {
      XB_SPIN(xb_ld(&bar[XB_XGEN(b.x)]) == gen, bar);
      __builtin_amdgcn_fence(__ATOMIC_ACQUIRE, "agent");
      asm volatile("s_waitcnt vmcnt(0)" ::: "memory");
    }
  }
  __syncthreads();
}

struct GA { const u16* A; long lda; int M; const u16* B; long ldb; int N; int K; };

__device__ __forceinline__ uint4 ld_mask(const u16* base, long ld, int r, int R, int k, int K) {
  const bool ok = (r < R) && (k < K);
  const int rr = r < R ? r : R - 1;
  const int kk = k < K ? k : 0;
  uint4 v = *(const uint4*)(base + (long)rr * ld + kk);
  v.x = ok ? v.x : 0u; v.y = ok ? v.y : 0u; v.z = ok ? v.z : 0u; v.w = ok ? v.w : 0u;
  return v;
}

template <bool SWAP, int MW>
__device__ __forceinline__ void gemm_compute(f32x4 (&acc)[MW][4], const u16* sA, const u16* sB, int wr, int wc, int fr, int fq) {
  constexpr int MG = MW < 4 ? MW : 4;
#pragma unroll
  for (int kk = 0; kk < 2; ++kk) {
    bf16x8 bfr[4];
#pragma unroll
    for (int n = 0; n < 4; ++n) bfr[n] = *(const bf16x8*)(sB + (wc * 64 + n * 16 + fr) * 72 + kk * 32 + fq * 8);
#pragma unroll
    for (int mg = 0; mg < MW / MG; ++mg) {
      bf16x8 af[MG];
#pragma unroll
      for (int m = 0; m < MG; ++m) af[m] = *(const bf16x8*)(sA + (wr * (MW * 16) + (mg * MG + m) * 16 + fr) * 72 + kk * 32 + fq * 8);
#pragma unroll
      for (int m = 0; m < MG; ++m)
#pragma unroll
        for (int n = 0; n < 4; ++n)
          acc[mg * MG + m][n] = SWAP ? __builtin_amdgcn_mfma_f32_16x16x32_bf16(bfr[n], af[m], acc[mg * MG + m][n], 0, 0, 0)
                                     : __builtin_amdgcn_mfma_f32_16x16x32_bf16(af[m], bfr[n], acc[mg * MG + m][n], 0, 0, 0);
    }
  }
}

template <bool SWAP, int MW = 4>
__device__ __forceinline__ void gemm_main(const GA& g, int m0, int n0, f32x4 (&acc)[MW][4], u16* sA, u16* sB) {
  const int tid = tidx(), lane = tid & 63, wid = tid >> 6, wr = wid >> 1, wc = wid & 1, fr = lane & 15, fq = lane >> 4;
  uint4 ra0[MW], rb0[4], ra1[MW], rb1[4];
  const int nk = (g.K + 63) >> 6;
  const int lr = tid >> 3, lk = (tid & 7) * 8;
#pragma unroll
  for (int i = 0; i < MW; ++i) ra0[i] = ld_mask(g.A, g.lda, m0 + lr + i * 32, g.M, lk, g.K);
#pragma unroll
  for (int i = 0; i < 4; ++i) rb0[i] = ld_mask(g.B, g.ldb, n0 + lr + i * 32, g.N, lk, g.K);
#pragma unroll
  for (int i = 0; i < MW; ++i) ra1[i] = ld_mask(g.A, g.lda, m0 + lr + i * 32, g.M, 64 + lk, g.K);
#pragma unroll
  for (int i = 0; i < 4; ++i) rb1[i] = ld_mask(g.B, g.ldb, n0 + lr + i * 32, g.N, 64 + lk, g.K);
  for (int kt = 0; kt < nk; kt += 2) {
    __syncthreads();
#pragma unroll
    for (int i = 0; i < MW; ++i) *(uint4*)(sA + (lr + i * 32) * 72 + lk) = ra0[i];
#pragma unroll
    for (int i = 0; i < 4; ++i) *(uint4*)(sB + (lr + i * 32) * 72 + lk) = rb0[i];
    __syncthreads();
    if (kt + 2 < nk) {
      const int k = (kt + 2) * 64 + lk;
#pragma unroll
      for (int i = 0; i < MW; ++i) ra0[i] = ld_mask(g.A, g.lda, m0 + lr + i * 32, g.M, k, g.K);
#pragma unroll
      for (int i = 0; i < 4; ++i) rb0[i] = ld_mask(g.B, g.ldb, n0 + lr + i * 32, g.N, k, g.K);
    }
    gemm_compute<SWAP, MW>(acc, sA, sB, wr, wc, fr, fq);
    if (kt + 1 < nk) {
      __syncthreads();
#pragma unroll
      for (int i = 0; i < MW; ++i) *(uint4*)(sA + (lr + i * 32) * 72 + lk) = ra1[i];
#pragma unroll
      for (int i = 0; i < 4; ++i) *(uint4*)(sB + (lr + i * 32) * 72 + lk) = rb1[i];
      __syncthreads();
      if (kt + 3 < nk) {
        const int k = (kt + 3) * 64 + lk;
#pragma unroll
        for (int i = 0; i < MW; ++i) ra1[i] = ld_mask(g.A, g.lda, m0 + lr + i * 32, g.M, k, g.K);
#pragma unroll
        for (int i = 0; i < 4; ++i) rb1[i] = ld_mask(g.B, g.ldb, n0 + lr + i * 32, g.N, k, g.K);
      }
      gemm_compute<SWAP, MW>(acc, sA, sB, wr, wc, fr, fq);
    }
  }
}

template <bool SWAP, int MW>
__device__ __forceinline__ void gemm_main1(const GA& g, int m0, int n0, f32x4 (&acc)[MW][4], u16* sA, u16* sB) {
  static_assert(MW == 8, "256-row tile");
  const int tid = tidx(), lane = tid & 63, wid = tid >> 6, wr = wid >> 1, wc = wid & 1, fr = lane & 15, fq = lane >> 4;
  const int nk = (g.K + 63) >> 6;
  const int lr = tid >> 3, lk = (tid & 7) * 8;
  const u16* pA = g.A + (long)(m0 + lr) * g.lda + lk;
  const u16* pB = g.B + (long)(n0 + lr) * g.ldb + lk;
  const long sa = 32 * g.lda, sb = 32 * g.ldb;
  uint4 a0, a1, a2, a3, a4, a5, a6, a7, b0, b1, b2, b3;
#define GL_LOAD(k) do { \
    a0 = *(const uint4*)(pA + (k)); a1 = *(const uint4*)(pA + (k) + sa); a2 = *(const uint4*)(pA + (k) + 2 * sa); a3 = *(const uint4*)(pA + (k) + 3 * sa); \
    a4 = *(const uint4*)(pA + (k) + 4 * sa); a5 = *(const uint4*)(pA + (k) + 5 * sa); a6 = *(const uint4*)(pA + (k) + 6 * sa); a7 = *(const uint4*)(pA + (k) + 7 * sa); \
    b0 = *(const uint4*)(pB + (k)); b1 = *(const uint4*)(pB + (k) + sb); b2 = *(const uint4*)(pB + (k) + 2 * sb); b3 = *(const uint4*)(pB + (k) + 3 * sb); } while (0)
  GL_LOAD(0);
  u16* wA = sA + lr * 72 + lk;
  u16* wB = sB + lr * 72 + lk;
  for (int kt = 0; kt < nk; ++kt) {
    __syncthreads();
    *(uint4*)(wA) = a0; *(uint4*)(wA + 32 * 72) = a1; *(uint4*)(wA + 64 * 72) = a2; *(uint4*)(wA + 96 * 72) = a3;
    *(uint4*)(wA + 128 * 72) = a4; *(uint4*)(wA + 160 * 72) = a5; *(uint4*)(wA + 192 * 72) = a6; *(uint4*)(wA + 224 * 72) = a7;
    *(uint4*)(wB) = b0; *(uint4*)(wB + 32 * 72) = b1; *(uint4*)(wB + 64 * 72) = b2; *(uint4*)(wB + 96 * 72) = b3;
    __syncthreads();
    const int k = (kt + 1 < nk ? kt + 1 : kt) * 64;
    GL_LOAD(k);
    gemm_compute<SWAP, MW>(acc, sA, sB, wr, wc, fr, fq);
  }
#undef GL_LOAD
}

template <bool SWAP>
__device__ __forceinline__ void gemm_main1_4(const GA& g, int m0, int n0, f32x4 (&acc)[4][4], u16* sA, u16* sB) {
  const int tid = tidx(), lane = tid & 63, wid = tid >> 6, wr = wid >> 1, wc = wid & 1, fr = lane & 15, fq = lane >> 4;
  const int nk = (g.K + 63) >> 6;
  const int lr = tid >> 3, lk = (tid & 7) * 8;
  const u16* pA = g.A + (long)(m0 + lr) * g.lda + lk;
  const u16* pB = g.B + (long)(n0 + lr) * g.ldb + lk;
  const long sa = 32 * g.lda, sb = 32 * g.ldb;
  uint4 a0, a1, a2, a3, b0, b1, b2, b3;
#define GL_LOAD4(k) do { \
    a0 = *(const uint4*)(pA + (k)); a1 = *(const uint4*)(pA + (k) + sa); a2 = *(const uint4*)(pA + (k) + 2 * sa); a3 = *(const uint4*)(pA + (k) + 3 * sa); \
    b0 = *(const uint4*)(pB + (k)); b1 = *(const uint4*)(pB + (k) + sb); b2 = *(const uint4*)(pB + (k) + 2 * sb); b3 = *(const uint4*)(pB + (k) + 3 * sb); } while (0)
  GL_LOAD4(0);
  u16* wA = sA + lr * 72 + lk;
  u16* wB = sB + lr * 72 + lk;
  for (int kt = 0; kt < nk; ++kt) {
    __syncthreads();
    *(uint4*)(wA) = a0; *(uint4*)(wA + 32 * 72) = a1; *(uint4*)(wA + 64 * 72) = a2; *(uint4*)(wA + 96 * 72) = a3;
    *(uint4*)(wB) = b0; *(uint4*)(wB + 32 * 72) = b1; *(uint4*)(wB + 64 * 72) = b2; *(uint4*)(wB + 96 * 72) = b3;
    __syncthreads();
    const int k = (kt + 1 < nk ? kt + 1 : kt) * 64;
    GL_LOAD4(k);
    gemm_compute<SWAP, 4>(acc, sA, sB, wr, wc, fr, fq);
  }
#undef GL_LOAD4
}

template <bool SWAP>
__device__ __forceinline__ void gemm_main2_4(const GA& g, int m0, int n0, f32x4 (&acc)[4][4], u16* sA, u16* sB) {
  const int tid = tidx(), lane = tid & 63, wid = tid >> 6, wr = wid >> 1, wc = wid & 1, fr = lane & 15, fq = lane >> 4;
  const int nk = (g.K + 63) >> 6;
  const int lr = tid >> 3, lk = (tid & 7) * 8;
  const u16* pA = g.A + (long)(m0 + lr) * g.lda + lk;
  const u16* pB = g.B + (long)(n0 + lr) * g.ldb + lk;
  const long sa = 32 * g.lda, sb = 32 * g.ldb;
  uint4 a0, a1, a2, a3, b0, b1, b2, b3, c0, c1, c2, c3, d0, d1, d2, d3;
#define G2_LOAD(k, A0, A1, A2, A3, B0, B1, B2, B3) do { \
    A0 = *(const uint4*)(pA + (k)); A1 = *(const uint4*)(pA + (k) + sa); A2 = *(const uint4*)(pA + (k) + 2 * sa); A3 = *(const uint4*)(pA + (k) + 3 * sa); \
    B0 = *(const uint4*)(pB + (k)); B1 = *(const uint4*)(pB + (k) + sb); B2 = *(const uint4*)(pB + (k) + 2 * sb); B3 = *(const uint4*)(pB + (k) + 3 * sb); } while (0)
#define G2_STORE(A0, A1, A2, A3, B0, B1, B2, B3) do { \
    *(uint4*)(wA) = A0; *(uint4*)(wA + 32 * 72) = A1; *(uint4*)(wA + 64 * 72) = A2; *(uint4*)(wA + 96 * 72) = A3; \
    *(uint4*)(wB) = B0; *(uint4*)(wB + 32 * 72) = B1; *(uint4*)(wB + 64 * 72) = B2; *(uint4*)(wB + 96 * 72) = B3; } while (0)
  u16* wA = sA + lr * 72 + lk;
  u16* wB = sB + lr * 72 + lk;
  G2_LOAD(0, a0, a1, a2, a3, b0, b1, b2, b3);
  G2_LOAD((nk > 1 ? 64 : 0), c0, c1, c2, c3, d0, d1, d2, d3);
  for (int kt = 0; kt < nk; kt += 2) {
    __syncthreads();
    G2_STORE(a0, a1, a2, a3, b0, b1, b2, b3);
    __syncthreads();
    { const int k = (kt + 2 < nk ? kt + 2 : kt) * 64; G2_LOAD(k, a0, a1, a2, a3, b0, b1, b2, b3); }
    gemm_compute<SWAP, 4>(acc, sA, sB, wr, wc, fr, fq);
    if (kt + 1 < nk) {
      __syncthreads();
      G2_STORE(c0, c1, c2, c3, d0, d1, d2, d3);
      __syncthreads();
      { const int k = (kt + 3 < nk ? kt + 3 : kt + 1) * 64; G2_LOAD(k, c0, c1, c2, c3, d0, d1, d2, d3); }
      gemm_compute<SWAP, 4>(acc, sA, sB, wr, wc, fr, fq);
    }
  }
#undef G2_LOAD
#undef G2_STORE
}

template <bool SWAP>
__device__ __forceinline__ void gemm_main_db_4(const GA& g, int m0, int n0, f32x4 (&acc)[4][4], u16* lds) {
  const int tid = tidx(), lane = tid & 63, wid = tid >> 6, wr = wid >> 1, wc = wid & 1, fr = lane & 15, fq = lane >> 4;
  const int nk = g.K >> 5;
  const int lr = tid >> 2, lk = (tid & 3) * 8;
  const u16* pA = g.A + (long)(m0 + lr) * g.lda + lk;
  const u16* pB = g.B + (long)(n0 + lr) * g.ldb + lk;
  const long sa = 64 * g.lda, sb = 64 * g.ldb;
  uint4 a0, a1, b0, b1;
  a0 = *(const uint4*)(pA); a1 = *(const uint4*)(pA + sa); b0 = *(const uint4*)(pB); b1 = *(const uint4*)(pB + sb);
  u16* w = lds + lr * 40 + lk;
  *(uint4*)(w) = a0; *(uint4*)(w + 64 * 40) = a1; *(uint4*)(w + 5120) = b0; *(uint4*)(w + 5120 + 64 * 40) = b1;
  { const int k = (nk > 1 ? 32 : 0); a0 = *(const uint4*)(pA + k); a1 = *(const uint4*)(pA + k + sa); b0 = *(const uint4*)(pB + k); b1 = *(const uint4*)(pB + k + sb); }
  __syncthreads();
  for (int kt = 0; kt < nk; ++kt) {
    const u16* cA = lds + (kt & 1) * 10240;
    const u16* cB = cA + 5120;
    bf16x8 af[4], bfr[4];
#pragma unroll
    for (int m = 0; m < 4; ++m) af[m] = *(const bf16x8*)(cA + (wr * 64 + m * 16 + fr) * 40 + fq * 8);
#pragma unroll
    for (int n = 0; n < 4; ++n) bfr[n] = *(const bf16x8*)(cB + (wc * 64 + n * 16 + fr) * 40 + fq * 8);
    if (kt + 1 < nk) {
      u16* wn = w + ((kt + 1) & 1) * 10240;
      *(uint4*)(wn) = a0; *(uint4*)(wn + 64 * 40) = a1; *(uint4*)(wn + 5120) = b0; *(uint4*)(wn + 5120 + 64 * 40) = b1;
    }
    { const int k = (kt + 2 < nk ? kt + 2 : kt) * 32; a0 = *(const uint4*)(pA + k); a1 = *(const uint4*)(pA + k + sa); b0 = *(const uint4*)(pB + k); b1 = *(const uint4*)(pB + k + sb); }
#pragma unroll
    for (int m = 0; m < 4; ++m)
#pragma unroll
      for (int n = 0; n < 4; ++n)
        acc[m][n] = SWAP ? __builtin_amdgcn_mfma_f32_16x16x32_bf16(bfr[n], af[m], acc[m][n], 0, 0, 0)
                         : __builtin_amdgcn_mfma_f32_16x16x32_bf16(af[m], bfr[n], acc[m][n], 0, 0, 0);
    __syncthreads();
  }
}

template <bool SWAP, class Epi>
__device__ __forceinline__ void gemm_phase256(const GA& g, Epi epi, char* smem, int reps = 1) {
  u16* sA = (u16*)smem; u16* sB = sA + 256 * 72;
  const int nM = (g.M + 255) >> 8, nN = (g.N + 127) >> 7;
  const int G = gridDim.x, bq = bidx();
  const int bsw = (G & 7) == 0 ? (bq & 7) * (G >> 3) + (bq >> 3) : bq;
  for (int rep = 0; rep < reps; ++rep)
  for (int tile = bsw; tile < nM * nN; tile += G) {
    int m0 = (tile / nN) * 256, n0 = (tile % nN) * 128;
    f32x4 acc[8][4];
#pragma unroll
    for (int m = 0; m < 8; ++m)
#pragma unroll
      for (int n = 0; n < 4; ++n) acc[m][n] = (f32x4){0.f, 0.f, 0.f, 0.f};
    gemm_main1<SWAP, 8>(g, m0, n0, acc, sA, sB);
    gemm_epi<SWAP, 8>(m0, n0, acc, epi);
  }
}

template <bool SWAP, int MW = 4, class Epi>
__device__ __forceinline__ void gemm_epi(int m0, int n0, f32x4 (&acc)[MW][4], Epi epi) {
  const int lane = tidx() & 63, wid = tidx() >> 6, wr = wid >> 1, wc = wid & 1, fr = lane & 15, fq = lane >> 4;
#pragma unroll
  for (int m = 0; m < MW; ++m)
#pragma unroll
    for (int n = 0; n < 4; ++n) {
      int row, col;
      if (SWAP) { row = m0 + wr * (MW * 16) + m * 16 + fr; col = n0 + wc * 64 + n * 16 + fq * 4; }
      else { row = m0 + wr * (MW * 16) + m * 16 + fq * 4; col = n0 + wc * 64 + n * 16 + fr; }
      epi(row, col, acc[m][n]);
    }
}

template <bool SWAP, class Epi>
__device__ __forceinline__ void gemm_phase(const GA& g, Epi epi, char* smem, int reps = 1) {
  u16* sA = (u16*)smem; u16* sB = sA + 128 * 72;
  const int nM = (g.M + 127) >> 7, nN = (g.N + 127) >> 7;
  const int G = gridDim.x, bq = bidx();
  const int bsw = (G & 7) == 0 ? (bq & 7) * (G >> 3) + (bq >> 3) : bq;
  for (int rep = 0; rep < reps; ++rep)
  for (int tile = bsw; tile < nM * nN; tile += G) {
    int m0 = (tile / nN) * 128, n0 = (tile % nN) * 128;
    f32x4 acc[4][4];
#pragma unroll
    for (int m = 0; m < 4; ++m)
#pragma unroll
      for (int n = 0; n < 4; ++n) acc[m][n] = (f32x4){0.f, 0.f, 0.f, 0.f};
    gemm_main<SWAP, 4>(g, m0, n0, acc, sA, sB);
    gemm_epi<SWAP, 4>(m0, n0, acc, epi);
  }
}

__device__ void transpose_cvt(const float* W, int K, int N, u16* out, char* smem) {
  float* tile = (float*)smem;
  const int tk = (K + 63) / 64, tn = (N + 63) / 64;
  const int tx = tidx() & 63, ty = tidx() >> 6;
  for (int id = bidx(); id < tk * tn; id += gridDim.x) {
    int k0 = (id / tn) * 64, n0 = (id % tn) * 64;
    __syncthreads();
    for (int i = ty; i < 64; i += 4) {
      int k = k0 + i, n = n0 + tx;
      tile[i * 65 + tx] = (k < K && n < N) ? __builtin_nontemporal_load(W + (long)k * N + n) : 0.f;
    }
    __syncthreads();
    for (int i = ty; i < 64; i += 4) {
      int n = n0 + i, k = k0 + tx;
      if (n < N && k < K) out[(long)n * K + k] = f2bf(tile[tx * 65 + i]);
    }
  }
}

__device__ void prep_phase(const P& p, char* smem) {
  const int tid = tidx();
  const long gtid = (long)bidx() * 256 + tid, gsz = (long)gridDim.x * 256;
  {
    u16* H = (u16*)(p.ws + OFF_H);
    for (long i = gtid; i < (long)NT * 128; i += gsz) {
      int row = (int)(i >> 7), c8 = (int)(i & 127) * 8;
      int t, T; row_info(row, t, T);
      const float* src;
      if (t < 16) src = p.in[2] + t * 1024 + c8;
      else if (row < ROWS_P) { int s = row / TP; src = p.in[0] + ((long)s * 2048 + (t - 16)) * 1024 + c8; }
      else { int s = (row - ROWS_P) / TS; src = p.in[1] + ((long)s * 4096 + (t - 16)) * 1024 + c8; }
      f32x4 av4 = __builtin_nontemporal_load((const f32x4*)src), bv4 = __builtin_nontemporal_load((const f32x4*)(src + 4));
      float4 a = make_float4(av4[0], av4[1], av4[2], av4[3]), b = make_float4(bv4[0], bv4[1], bv4[2], bv4[3]);
      uint4 o = make_uint4(pack2(a.x, a.y), pack2(a.z, a.w), pack2(b.x, b.y), pack2(b.z, b.w));
      *(uint4*)(H + (long)row * 1024 + c8) = o;
    }
  }
  for (int which = 0; which < 2; ++which) {
    const int T = which ? TS : TP, Th = which ? THS : THP, Mh = T / 2 + 1;
    u16* A = (u16*)((char*)p.out + (which ? OD_DFTS : OD_DFTP));
    for (long i = gtid; i < (long)Mh * Th; i += gsz) {
      int tt = (int)(i / Th), k = (int)(i % Th);
      u16 c = 0, sn = 0;
      if (k < T) {
        int m = (int)(((long)tt * k) % T);
        float x = 2.f * (float)m / (float)T;
        c = f2bf(cospif(x)); sn = f2bf(sinpif(x));
      }
      A[(long)tt * 2 * Th + k] = c;
      A[(long)tt * 2 * Th + Th + k] = sn;
    }
  }
  for (int l = 0; l < 2; ++l) {
    char* wl = p.ws + (size_t)l * SZ_WL;
    transpose_cvt(p.in[4] + (size_t)l * 1024 * DIN, 1024, DIN, (u16*)(wl + OW_IN), smem);
    for (int k = 0; k < 4; ++k)
      transpose_cvt(p.in[20] + ((size_t)l * 4 + k) * 512 * 1024, 512, 1024, (u16*)(wl + OW_BR) + (size_t)k * 1024 * 512, smem);
    transpose_cvt(p.in[21] + (size_t)l * 1024 * 1024, 1024, 1024, (u16*)(wl + OW_OUT), smem);
    transpose_cvt(p.in[24] + (size_t)l * 1024 * 5632, 1024, 5632, (u16*)(wl + OW_UP), smem);
    transpose_cvt(p.in[25] + (size_t)l * 2816 * 1024, 2816, 1024, (u16*)(wl + OW_DOWN), smem);
  }
  {
    float* wt = (float*)smem;
    float* ct = wt + 64 * 129;
    for (int task = bidx(); task < 128; task += gridDim.x) {
      int l = task >> 6, kt = (task & 63) >> 2, g = task & 3;
      const float* win = p.in[4] + (size_t)l * 1024 * DIN;
      u16* Wfn = (u16*)(p.ws + (size_t)l * SZ_WL + OW_FN);
      __syncthreads();
      for (int idx = tid; idx < 64 * 128; idx += 256) {
        int kk = idx >> 7, j = idx & 127;
        wt[kk * 129 + j] = win[(size_t)(kt * 64 + kk) * DIN + g * 128 + j];
      }
      if (tid < 128) { ct[tid] = cospif(tid / 64.f); ct[128 + tid] = sinpif(tid / 64.f); }
      __syncthreads();
      int kk = tid & 63, grp = tid >> 6;
      for (int mm = grp; mm < 256; mm += 4) {
        int half = mm >> 7, m = mm & 127;
        float s = 0.f;
        for (int j = 0; j < 128; ++j) s += wt[kk * 129 + j] * ct[half * 128 + ((j * m) & 127)];
        Wfn[(size_t)(half * 512 + g * 128 + m) * 1024 + kt * 64 + kk] = f2bf(s);
      }
    }
  }
}

__device__ void rmsnorm_phase(const u16* H, const float* w, u16* HN, float* zbuf, long zn4) {
  const int lane = tidx() & 63;
  const int wave = (bidx() * 256 + tidx()) >> 6, nw = gridDim.x * 4;
  if (zbuf) {
    float4 z = make_float4(0.f, 0.f, 0.f, 0.f);
    for (long i = (long)bidx() * 256 + tidx(); i < zn4; i += (long)gridDim.x * 256) ((float4*)zbuf)[i] = z;
  }
  float wlo[8], whi[8];
  ld8(w + lane * 8, wlo); ld8(w + 512 + lane * 8, whi);
  for (int row = wave; row < NT; row += nw) {
    const uint4* hp = (const uint4*)(H + (long)row * 1024);
    uint4 a = hp[lane], b = hp[64 + lane];
    unsigned ua[8] = {a.x, a.y, a.z, a.w, b.x, b.y, b.z, b.w};
    float x[16];
    float ss = 0.f;
#pragma unroll
    for (int i = 0; i < 8; ++i) { x[2 * i] = lo2f(ua[i]); x[2 * i + 1] = hi2f(ua[i]); ss += x[2 * i] * x[2 * i] + x[2 * i + 1] * x[2 * i + 1]; }
    ss = wave_sum(ss);
    float r = rsqrtf(ss * (1.f / 1024.f) + EPS);
    unsigned o[8];
#pragma unroll
    for (int i = 0; i < 8; ++i) {
      const float w0 = i < 4 ? wlo[(i & 3) * 2] : whi[(i & 3) * 2], w1 = i < 4 ? wlo[(i & 3) * 2 + 1] : whi[(i & 3) * 2 + 1];
      o[i] = pack2(x[2 * i] * r * w0, x[2 * i + 1] * r * w1);
    }
    uint4* op = (uint4*)(HN + (long)row * 1024);
    op[lane] = make_uint4(o[0], o[1], o[2], o[3]);
    op[64 + lane] = make_uint4(o[4], o[5], o[6], o[7]);
  }
}

__device__ void final_phase(const P& p) {
  const u16* H = (const u16*)(p.ws + OFF_H);
  const float* w = p.in[26];
  const int lane = tidx() & 63;
  const int wave = (bidx() * 256 + tidx()) >> 6, nw = gridDim.x * 4;
  float wf0[8], wf1[8];
  ld8(w + lane * 8, wf0); ld8(w + 512 + lane * 8, wf1);
  for (int row = wave; row < NT; row += nw) {
    int t, T; row_info(row, t, T);
    if (t < 16) continue;
    long orow;
    if (row < ROWS_P) orow = (long)(row / TP) * 2048 + (t - 16);
    else orow = 32l * 2048 + (long)((row - ROWS_P) / TS) * 4096 + (t - 16);
    const uint4* hp = (const uint4*)(H + (long)row * 1024);
    uint4 a = hp[lane], b = hp[64 + lane];
    unsigned ua[8] = {a.x, a.y, a.z, a.w, b.x, b.y, b.z, b.w};
    float x[16];
    float ss = 0.f;
#pragma unroll
    for (int i = 0; i < 8; ++i) { x[2 * i] = lo2f(ua[i]); x[2 * i + 1] = hi2f(ua[i]); ss += x[2 * i] * x[2 * i] + x[2 * i + 1] * x[2 * i + 1]; }
    ss = wave_sum(ss);
    float r = rsqrtf(ss * (1.f / 1024.f) + EPS);
    float* op = p.out + orow * 1024;
#pragma unroll
    for (int hgrp = 0; hgrp < 2; ++hgrp) {
      int c = hgrp * 512 + lane * 8;
      float4 o0, o1;
      o0.x = x[hgrp * 8 + 0] * r * (hgrp ? wf1[0] : wf0[0]); o0.y = x[hgrp * 8 + 1] * r * (hgrp ? wf1[1] : wf0[1]);
      o0.z = x[hgrp * 8 + 2] * r * (hgrp ? wf1[2] : wf0[2]); o0.w = x[hgrp * 8 + 3] * r * (hgrp ? wf1[3] : wf0[3]);
      o1.x = x[hgrp * 8 + 4] * r * (hgrp ? wf1[4] : wf0[4]); o1.y = x[hgrp * 8 + 5] * r * (hgrp ? wf1[5] : wf0[5]);
      o1.z = x[hgrp * 8 + 6] * r * (hgrp ? wf1[6] : wf0[6]); o1.w = x[hgrp * 8 + 7] * r * (hgrp ? wf1[7] : wf0[7]);
      __builtin_nontemporal_store((f32x4){o0.x, o0.y, o0.z, o0.w}, (f32x4*)(op + c));
      __builtin_nontemporal_store((f32x4){o1.x, o1.y, o1.z, o1.w}, (f32x4*)(op + c + 4));
    }
  }
}

__device__ __forceinline__ float conv3_at(const u16* PR, long row, int ld, int col, int t, int T, float w0, float w1, float w2) {
  float x1 = bf2f(PR[row * ld + col]);
  float x0 = (t > 0) ? bf2f(PR[(row - 1) * ld + col]) : 0.f;
  float x2 = (t < T - 1) ? bf2f(PR[(row + 1) * ld + col]) : 0.f;
  return w0 * x0 + w1 * x1 + w2 * x2;
}

__device__ void ssd_conv_phase(const P& p, int l) {
  const u16* PR = (const u16*)((char*)p.out + OD_PROJ);
  const float* cw = p.in[5] + l * 3 * 1024;
  const float* cb = p.in[6] + l * 1024;
  u16* XS = (u16*)(p.ws + OFF_BR + 1 * SZ_BR);
  u16* BC = (u16*)(p.ws + OFF_X2T);
  float w0[8], w1[8], w2[8], wb[8];
  { const int c80 = (tidx() & 127) * 8; ld8(cw + c80, w0); ld8(cw + 1024 + c80, w1); ld8(cw + 2048 + c80, w2); ld8(cb + c80, wb); }
  for (long i = (long)bidx() * 256 + tidx(); i < (long)NT * 128; i += (long)gridDim.x * 256) {
    int row = (int)(i >> 7), c8 = (int)(i & 127) * 8;
    int t, T; row_info(row, t, T);
    const u16* pr = PR + (long)row * 1552 + 512 + c8;
    uint4 z4 = make_uint4(0, 0, 0, 0);
    uint4 x1 = *(const uint4*)pr, x0 = z4, x2 = z4;
    if (t > 0) x0 = *(const uint4*)(pr - 1552);
    if (t < T - 1) x2 = *(const uint4*)(pr + 1552);
    unsigned a0[4] = {x0.x, x0.y, x0.z, x0.w}, a1[4] = {x1.x, x1.y, x1.z, x1.w}, a2[4] = {x2.x, x2.y, x2.z, x2.w};
    unsigned o[4];
#pragma unroll
    for (int e = 0; e < 4; ++e) {
      float lo = siluf(w0[2 * e] * lo2f(a0[e]) + w1[2 * e] * lo2f(a1[e]) + w2[2 * e] * lo2f(a2[e]) + wb[2 * e]);
      float hi = siluf(w0[2 * e + 1] * hi2f(a0[e]) + w1[2 * e + 1] * hi2f(a1[e]) + w2[2 * e + 1] * hi2f(a2[e]) + wb[2 * e + 1]);
      o[e] = pack2(lo, hi);
    }
    u16* dst = c8 < 512 ? XS + (long)row * 512 + c8 : BC + (long)row * 512 + (c8 - 512);
    *(uint4*)dst = make_uint4(o[0], o[1], o[2], o[3]);
  }
}

__device__ void ssd_scan_phase(const P& p, int l, char* smem) {
  u16* Cn = (u16*)smem;
  u16* Bn = Cn + 32 * 136;
  u16* BT = Bn + 32 * 136;
  u16* XT = BT + 128 * 40;
  float* dts = (float*)(XT + 4 * 64 * 40);
  float* css = dts + 128;
  const u16* PR = (const u16*)((char*)p.out + OD_PROJ);
  const u16* XS = (const u16*)(p.ws + OFF_BR + 1 * SZ_BR);
  const u16* BC = (const u16*)(p.ws + OFF_X2T);
  const float* dtb = p.in[7] + l * 16;
  const float* alog = p.in[8] + l * 16;
  for (int task = bidx(); task < 384; task += gridDim.x) {
    const int tid = tidx(), lane = tid & 63, r = tid >> 6;
    const int fr = lane & 15, fq = lane >> 4;
    int seq, g, dir, seg;
    if (task < 128) { seq = 32 + (task >> 4); int rem = task & 15; g = rem >> 3; dir = (rem >> 2) & 1; seg = rem & 3; }
    else { int q = task - 128; seq = q >> 3; int rem = q & 7; g = rem >> 2; dir = (rem >> 1) & 1; seg = rem & 1; }
    int base = seq_base(seq), T = seq < 32 ? TP : TS;
    float csoff = 0.f;
    u16* Yd = (u16*)(p.ws + OFF_BR + (size_t)(2 + dir) * SZ_BR);
    f32x4 HT[8][4];
#pragma unroll
    for (int a = 0; a < 8; ++a)
#pragma unroll
      for (int b = 0; b < 4; ++b) HT[a][b] = (f32x4){0.f, 0.f, 0.f, 0.f};
    const int nch = (T + 31) >> 5;
    const int chb = seg * SEGC, che = (chb + SEGC < nch) ? chb + SEGC : nch;
    const int sv_v = tid & 63;
    const u16* colp = sv_v < 32 ? BC + (sv_v < 16 ? g * 128 + 8 * sv_v : 256 + g * 128 + 8 * (sv_v - 16)) : XS + g * 256 + 8 * (sv_v - 32);
    uint4 sv[4];
    u16 rawdt = 0;
#define SCAN_LOADN(i0, C0, NV, S0) _Pragma("unroll") for (int i = 0; i < (NV); ++i) { \
        const int tau = (C0) + r + 4 * ((i0) + i); const bool ok = tau < T; \
        const int tc = ok ? (dir ? T - 1 - tau : tau) : 0; \
        uint4 val = *(const uint4*)(colp + (long)(base + tc) * 512); \
        sv[(S0) + i].x = ok ? val.x : 0u; sv[(S0) + i].y = ok ? val.y : 0u; sv[(S0) + i].z = ok ? val.z : 0u; sv[(S0) + i].w = ok ? val.w : 0u; }
#define SCAN_LOADDT(C0) do { rawdt = 0; if (tid < 128) { int tau = (C0) + (tid & 31); if (tau < T) { int t = dir ? T - 1 - tau : tau; \
        rawdt = PR[(long)(base + t) * 1552 + 1536 + dir * 8 + g * 4 + (tid >> 5)]; } } } while (0)
#define SCAN_STORE(i0) _Pragma("unroll") for (int i = 0; i < 4; ++i) { \
        const int tl = r + 4 * ((i0) + i); const int v = sv_v; \
        uint4 val = sv[i]; unsigned w4[4] = {val.x, val.y, val.z, val.w}; \
        if (v < 16) { \
          *(uint4*)(Bn + tl * 136 + 8 * v) = val; \
          _Pragma("unroll") for (int e = 0; e < 4; ++e) { BT[(8 * v + 2 * e) * 40 + tl] = (u16)(w4[e] & 0xffffu); BT[(8 * v + 2 * e + 1) * 40 + tl] = (u16)(w4[e] >> 16); } \
        } else if (v < 32) { \
          *(uint4*)(Cn + tl * 136 + 8 * (v - 16)) = val; \
        } else { \
          int h = (v - 32) >> 3, p0 = ((v - 32) & 7) * 8; \
          float dt = dts[h * 32 + tl]; \
          _Pragma("unroll") for (int e = 0; e < 4; ++e) { \
            XT[(h * 64 + p0 + 2 * e) * 40 + tl] = f2bf(lo2f(w4[e]) * dt); \
            XT[(h * 64 + p0 + 2 * e + 1) * 40 + tl] = f2bf(hi2f(w4[e]) * dt); } } }
    SCAN_LOADDT(chb * 32);
    SCAN_LOADN(0, chb * 32, 2, 0)
    for (int ch = chb; ch < che; ++ch) {
      const int c0 = ch * 32;
      __syncthreads();
      if (tid < 128) {
        int h = tid >> 5, tl = tid & 31, tau = c0 + tl;
        int hi = dir * 8 + g * 4 + h;
        float dt = 0.f;
        if (tau < T) {
          float dr = bf2f(rawdt) + dtb[hi];
          dt = dr > 20.f ? dr : __logf(1.f + __expf(dr));
        }
        float v = -dt * __expf(alog[hi]);
#pragma unroll
        for (int o = 1; o < 32; o <<= 1) { float u = bperm(v, (lane - o) & 63); if (tl >= o) v += u; }
        dts[h * 32 + tl] = dt; css[h * 32 + tl] = v;
      }
      __syncthreads();
      SCAN_LOADN(2, c0, 2, 2)
      SCAN_STORE(0)
      SCAN_LOADN(4, c0, 4, 0)
      SCAN_STORE(4)
      __syncthreads();
      if (ch + 1 < che) { SCAN_LOADDT(c0 + 32); SCAN_LOADN(0, c0 + 32, 2, 0) }
      const float* cs = css + r * 32;
      const u16* xt = XT + r * 64 * 40;
      if (lane < 32) {
        int tau = c0 + lane;
        if (tau < T) { int t = dir ? T - 1 - tau : tau; ((float*)((char*)p.out + OD_CSG))[((long)(base + t) * 2 + dir) * 8 + g * 4 + r] = csoff + cs[lane]; }
      }
      f32x4 GT00 = (f32x4){0.f, 0.f, 0.f, 0.f}, GT01 = GT00, GT11 = GT00;
#pragma unroll
      for (int kk = 0; kk < 4; ++kk) {
        bf16x8 b0 = *(const bf16x8*)(Bn + (fr) * 136 + kk * 32 + fq * 8);
        bf16x8 b1 = *(const bf16x8*)(Bn + (16 + fr) * 136 + kk * 32 + fq * 8);
        bf16x8 c0v = *(const bf16x8*)(Cn + (fr) * 136 + kk * 32 + fq * 8);
        bf16x8 c1v = *(const bf16x8*)(Cn + (16 + fr) * 136 + kk * 32 + fq * 8);
        GT00 = __builtin_amdgcn_mfma_f32_16x16x32_bf16(b0, c0v, GT00, 0, 0, 0);
        GT01 = __builtin_amdgcn_mfma_f32_16x16x32_bf16(b0, c1v, GT01, 0, 0, 0);
        GT11 = __builtin_amdgcn_mfma_f32_16x16x32_bf16(b1, c1v, GT11, 0, 0, 0);
      }
      const float csl0 = cs[fr], csl1 = cs[16 + fr];
      float m00[4], m01[4], m11[4];
#pragma unroll
      for (int j = 0; j < 4; ++j) {
        int s0 = 4 * fq + j;
        float css0 = cs[s0], css1 = cs[16 + s0];
        m00[j] = (s0 <= fr) ? GT00[j] * __expf(csl0 - css0) : 0.f;
        m01[j] = GT01[j] * __expf(csl1 - css0);
        m11[j] = (s0 <= fr) ? GT11[j] * __expf(csl1 - css1) : 0.f;
      }
      union { bf16x8 v; unsigned u[4]; } A0, A1;
      A0.u[0] = pack2(m00[0], m00[1]); A0.u[1] = pack2(m00[2], m00[3]); A0.u[2] = 0u; A0.u[3] = 0u;
      A1.u[0] = pack2(m01[0], m01[1]); A1.u[1] = pack2(m01[2], m01[3]); A1.u[2] = pack2(m11[0], m11[1]); A1.u[3] = pack2(m11[2], m11[3]);
      f32x4 Y[2][4];
#pragma unroll
      for (int tp = 0; tp < 4; ++tp) {
        union { bf16x8 v; uint2 h[2]; } xb;
        xb.h[0] = *(const uint2*)(xt + (tp * 16 + fr) * 40 + 4 * fq);
        xb.h[1] = *(const uint2*)(xt + (tp * 16 + fr) * 40 + 16 + 4 * fq);
        f32x4 z = (f32x4){0.f, 0.f, 0.f, 0.f};
        Y[0][tp] = __builtin_amdgcn_mfma_f32_16x16x32_bf16(A0.v, xb.v, z, 0, 0, 0);
        Y[1][tp] = __builtin_amdgcn_mfma_f32_16x16x32_bf16(A1.v, xb.v, z, 0, 0, 0);
      }
      const float e0 = __expf(csl0), e1 = __expf(csl1);
#pragma unroll
      for (int u = 0; u < 4; ++u) {
        union { bf16x8 v; uint2 h[2]; unsigned w[4]; } ca, cbv;
        ca.h[0] = *(const uint2*)(Cn + (fr) * 136 + 32 * u + 4 * fq);
        ca.h[1] = *(const uint2*)(Cn + (fr) * 136 + 32 * u + 16 + 4 * fq);
        cbv.h[0] = *(const uint2*)(Cn + (16 + fr) * 136 + 32 * u + 4 * fq);
        cbv.h[1] = *(const uint2*)(Cn + (16 + fr) * 136 + 32 * u + 16 + 4 * fq);
#pragma unroll
        for (int e = 0; e < 4; ++e) {
          ca.w[e] = pack2(lo2f(ca.w[e]) * e0, hi2f(ca.w[e]) * e0);
          cbv.w[e] = pack2(lo2f(cbv.w[e]) * e1, hi2f(cbv.w[e]) * e1);
        }
#pragma unroll
        for (int tp = 0; tp < 4; ++tp) {
          union { bf16x8 v; unsigned w[4]; } hb;
          hb.w[0] = pack2(HT[2 * u][tp][0], HT[2 * u][tp][1]); hb.w[1] = pack2(HT[2 * u][tp][2], HT[2 * u][tp][3]);
          hb.w[2] = pack2(HT[2 * u + 1][tp][0], HT[2 * u + 1][tp][1]); hb.w[3] = pack2(HT[2 * u + 1][tp][2], HT[2 * u + 1][tp][3]);
          Y[0][tp] = __builtin_amdgcn_mfma_f32_16x16x32_bf16(ca.v, hb.v, Y[0][tp], 0, 0, 0);
          Y[1][tp] = __builtin_amdgcn_mfma_f32_16x16x32_bf16(cbv.v, hb.v, Y[1][tp], 0, 0, 0);
        }
      }
#pragma unroll
      for (int tl = 0; tl < 2; ++tl)
#pragma unroll
        for (int j = 0; j < 4; ++j) {
          int tau = c0 + tl * 16 + 4 * fq + j;
          if (tau < T) {
            int t = dir ? T - 1 - tau : tau;
            u16* yp = Yd + (long)(base + t) * 512 + g * 256 + r * 64 + fr;
#pragma unroll
            for (int tp = 0; tp < 4; ++tp) yp[tp * 16] = f2bf(Y[tl][tp][j]);
          }
        }
      const float csL = cs[31];
      const float eL = __expf(csL);
      float w8[8];
#pragma unroll
      for (int jj = 0; jj < 8; ++jj) w8[jj] = __expf(csL - cs[8 * fq + jj]);
      bf16x8 xs4[4];
#pragma unroll
      for (int tp = 0; tp < 4; ++tp) {
        union { bf16x8 v; unsigned w[4]; } xx;
        xx.v = *(const bf16x8*)(xt + (tp * 16 + fr) * 40 + 8 * fq);
#pragma unroll
        for (int e = 0; e < 4; ++e) xx.w[e] = pack2(lo2f(xx.w[e]) * w8[2 * e], hi2f(xx.w[e]) * w8[2 * e + 1]);
        xs4[tp] = xx.v;
      }
#pragma unroll
      for (int tn = 0; tn < 8; ++tn) {
        bf16x8 bt = *(const bf16x8*)(BT + (tn * 16 + fr) * 40 + 8 * fq);
#pragma unroll
        for (int tp = 0; tp < 4; ++tp) {
          f32x4 hv = HT[tn][tp];
          hv[0] *= eL; hv[1] *= eL; hv[2] *= eL; hv[3] *= eL;
          HT[tn][tp] = __builtin_amdgcn_mfma_f32_16x16x32_bf16(bt, xs4[tp], hv, 0, 0, 0);
        }
      }
      csoff += csL;
    }
#undef SCAN_LOADN
#undef SCAN_LOADDT
#undef SCAN_STORE
    if (seg < (seq < 32 ? 1 : 3)) {
      const int sslot = seq < 32 ? seq : 32 + (seq - 32) * 3 + seg;
      const long sl = (long)((g * 2 + dir) * 56 + sslot) * 4 + r;
      f32x4* hs = (f32x4*)((float*)((char*)p.out + OD_HS) + sl * 8192);
#pragma unroll
      for (int tn = 0; tn < 8; ++tn)
#pragma unroll
        for (int tp = 0; tp < 4; ++tp) hs[(tn * 4 + tp) * 64 + lane] = HT[tn][tp];
      if (lane == 0) ((float*)((char*)p.out + OD_DS))[sl] = __expf(csoff);
    }
  }
}

__device__ void ssd_state_phase(const P& p) {
  float* HS = (float*)((char*)p.out + OD_HS);
  const float* DS = (const float*)((char*)p.out + OD_DS);
  for (long i = (long)bidx() * 256 + tidx(); i < 128l * 2048; i += (long)gridDim.x * 256) {
    int chain = (int)(i >> 11), e = (int)(i & 2047);
    int gd = chain >> 5, sq = (chain >> 2) & 7, h = chain & 3;
    long sl0 = (long)(gd * 56 + 32 + sq * 3) * 4 + h;
    float4 a = ((const float4*)(HS + sl0 * 8192))[e];
    float4 b = ((const float4*)(HS + (sl0 + 4) * 8192))[e];
    float d1 = DS[sl0 + 4];
    b.x += d1 * a.x; b.y += d1 * a.y; b.z += d1 * a.z; b.w += d1 * a.w;
    ((float4*)(HS + (sl0 + 4) * 8192))[e] = b;
    float4 c = ((const float4*)(HS + (sl0 + 8) * 8192))[e];
    float d2 = DS[sl0 + 8];
    c.x += d2 * b.x; c.y += d2 * b.y; c.z += d2 * b.z; c.w += d2 * b.w;
    ((float4*)(HS + (sl0 + 8) * 8192))[e] = c;
  }
}

__device__ void ssd_fix_phase(const P& p) {
  const float* HS = (const float*)((char*)p.out + OD_HS);
  const float* CSG = (const float*)((char*)p.out + OD_CSG);
  const u16* BC = (const u16*)(p.ws + OFF_X2T);
  const int tid = tidx(), lane = tid & 63, r = tid >> 6;
  const int fr = lane & 15, fq = lane >> 4;
  for (int task = bidx(); task < 7168; task += gridDim.x) {
    int seq, gd, ch;
    if (task < 3072) { seq = 32 + task / 384; int rem = task % 384; gd = rem / 96; ch = SEGC + rem % 96; }
    else { int q = task - 3072; seq = q >> 7; int rem = q & 127; gd = rem >> 5; ch = SEGC + (rem & 31); }
    const int g = gd >> 1, dir = gd & 1;
    const int base = seq_base(seq), T = seq < 32 ? TP : TS;
    const int seg = ch / SEGC;
    const int sslot = seq < 32 ? seq : 32 + (seq - 32) * 3 + (seg - 1);
    const f32x4* hs = (const f32x4*)(HS + ((long)(gd * 56 + sslot) * 4 + r) * 8192);
    u16* Yd = (u16*)(p.ws + OFF_BR + (size_t)(2 + dir) * SZ_BR);
    const int c0 = ch * 32;
    const int tau0 = c0 + fr, tau1 = c0 + 16 + fr;
    const bool ok0 = tau0 < T, ok1 = tau1 < T;
    const int t0r = ok0 ? (dir ? T - 1 - tau0 : tau0) : 0, t1r = ok1 ? (dir ? T - 1 - tau1 : tau1) : 0;
    const float e0 = ok0 ? __expf(CSG[((long)(base + t0r) * 2 + dir) * 8 + g * 4 + r]) : 0.f;
    const float e1 = ok1 ? __expf(CSG[((long)(base + t1r) * 2 + dir) * 8 + g * 4 + r]) : 0.f;
    const u16* c0p = BC + (long)(base + t0r) * 512 + 256 + g * 128;
    const u16* c1p = BC + (long)(base + t1r) * 512 + 256 + g * 128;
    f32x4 Y[2][4];
#pragma unroll
    for (int a = 0; a < 2; ++a)
#pragma unroll
      for (int b = 0; b < 4; ++b) Y[a][b] = (f32x4){0.f, 0.f, 0.f, 0.f};
#pragma unroll
    for (int u = 0; u < 4; ++u) {
      union { bf16x8 v; uint2 h[2]; unsigned w[4]; } ca, cbv;
      ca.h[0] = *(const uint2*)(c0p + 32 * u + 4 * fq);
      ca.h[1] = *(const uint2*)(c0p + 32 * u + 16 + 4 * fq);
      cbv.h[0] = *(const uint2*)(c1p + 32 * u + 4 * fq);
      cbv.h[1] = *(const uint2*)(c1p + 32 * u + 16 + 4 * fq);
#pragma unroll
      for (int e = 0; e < 4; ++e) {
        ca.w[e] = pack2(lo2f(ca.w[e]) * e0, hi2f(ca.w[e]) * e0);
        cbv.w[e] = pack2(lo2f(cbv.w[e]) * e1, hi2f(cbv.w[e]) * e1);
      }
#pragma unroll
      for (int tp = 0; tp < 4; ++tp) {
        f32x4 ha = hs[((2 * u) * 4 + tp) * 64 + lane], hb2 = hs[((2 * u + 1) * 4 + tp) * 64 + lane];
        union { bf16x8 v; unsigned w[4]; } hb;
        hb.w[0] = pack2(ha[0], ha[1]); hb.w[1] = pack2(ha[2], ha[3]);
        hb.w[2] = pack2(hb2[0], hb2[1]); hb.w[3] = pack2(hb2[2], hb2[3]);
        Y[0][tp] = __builtin_amdgcn_mfma_f32_16x16x32_bf16(ca.v, hb.v, Y[0][tp], 0, 0, 0);
        Y[1][tp] = __builtin_amdgcn_mfma_f32_16x16x32_bf16(cbv.v, hb.v, Y[1][tp], 0, 0, 0);
      }
    }
#pragma unroll
    for (int tl = 0; tl < 2; ++tl)
#pragma unroll
      for (int j = 0; j < 4; ++j) {
        int tau = c0 + tl * 16 + 4 * fq + j;
        if (tau < T) {
          int t = dir ? T - 1 - tau : tau;
          u16* yp = Yd + (long)(base + t) * 512 + g * 256 + r * 64 + fr;
#pragma unroll
          for (int tp = 0; tp < 4; ++tp) yp[tp * 16] = f2bf(bf2f(yp[tp * 16]) + Y[tl][tp][j]);
        }
      }
  }
}

__device__ void ssd_post_phase(const P& p, int l) {
  const u16* PR = (const u16*)((char*)p.out + OD_PROJ);
  const float* dsk = p.in[9] + l * 8;
  const float* nw = p.in[10] + l * 512;
  const u16* Yf = (const u16*)(p.ws + OFF_BR + 2 * SZ_BR);
  const u16* Yb = (const u16*)(p.ws + OFF_BR + 3 * SZ_BR);
  u16* BR1 = (u16*)(p.ws + OFF_BR + 1 * SZ_BR);
  const int lane = tidx() & 63;
  const int wave = (bidx() * 256 + tidx()) >> 6, nwv = gridDim.x * 4;
  const float4 nw0 = *(const float4*)(nw + lane * 8), nw1 = *(const float4*)(nw + lane * 8 + 4);
  const float nwv8[8] = {nw0.x, nw0.y, nw0.z, nw0.w, nw1.x, nw1.y, nw1.z, nw1.w};
  const float dk = dsk[lane >> 3];
  for (int row = wave; row < NT; row += nwv) {
    uint4 xs4 = *(const uint4*)(BR1 + (long)row * 512 + lane * 8);
    uint4 yf4 = *(const uint4*)(Yf + (long)row * 512 + lane * 8);
    uint4 yb4 = *(const uint4*)(Yb + (long)row * 512 + lane * 8);
    uint4 z4 = *(const uint4*)(PR + (long)row * 1552 + lane * 8);
    unsigned xa[4] = {xs4.x, xs4.y, xs4.z, xs4.w}, fa[4] = {yf4.x, yf4.y, yf4.z, yf4.w};
    unsigned ba[4] = {yb4.x, yb4.y, yb4.z, yb4.w}, za[4] = {z4.x, z4.y, z4.z, z4.w};
    float v[8];
    float ss = 0.f;
#pragma unroll
    for (int e = 0; e < 4; ++e) {
      float y0 = (lo2f(fa[e]) + lo2f(ba[e]) + lo2f(xa[e]) * dk) * siluf(lo2f(za[e]));
      float y1 = (hi2f(fa[e]) + hi2f(ba[e]) + hi2f(xa[e]) * dk) * siluf(hi2f(za[e]));
      v[2 * e] = y0; v[2 * e + 1] = y1; ss += y0 * y0 + y1 * y1;
    }
#pragma unroll
    for (int o = 16; o > 0; o >>= 1) ss += bperm(ss, lane ^ o);
    float rr = rsqrtf(ss * (1.f / 256.f) + EPS);
    unsigned o4[4];
#pragma unroll
    for (int e = 0; e < 4; ++e) o4[e] = pack2(v[2 * e] * rr * nwv8[2 * e], v[2 * e + 1] * rr * nwv8[2 * e + 1]);
    *(uint4*)(BR1 + (long)row * 512 + lane * 8) = make_uint4(o4[0], o4[1], o4[2], o4[3]);
  }
}

__device__ void hyena_hid_phase(const P& p, int l) {
  const float* w1 = p.in[12] + l * 33 * 64;
  const float* b1 = p.in[13] + l * 64;
  const float* w2 = p.in[14] + l * 64 * 64;
  const float* b2 = p.in[15] + l * 64;
  const float* fq = p.in[17] + l * 64;
  float* HID = (float*)(p.ws + OFF_HID);
  const int lane = tidx() & 63;
  const int wave = (bidx() * 256 + tidx()) >> 6, nwv = gridDim.x * 4;
  for (int item = wave; item < TP + TS; item += nwv) {
    int T = item < TP ? TP : TS;
    int lag = item < TP ? item : item - TP;
    float tt = (float)lag / (float)(T - 1);
    float wv = (float)(2.0 * 3.14159265358979323846 / (double)T) * (float)lag;
    float z = 0.f;
    if (lane == 0) z = tt;
    else if (lane < 33) {
      int i = (lane - 1) & 15;
      float fr = 1e-4f + (float)i * ((15.f - 1e-4f) / 15.f);
      z = lane < 17 ? cosf(fr * wv) : -sinf(fr * wv);
    }
    float s = b1[lane];
    for (int e = 0; e < 33; ++e) s += bperm(z, e) * w1[e * 64 + lane];
    float h1 = sinf(fq[lane] * s);
    float s2 = b2[lane];
    for (int i = 0; i < 64; ++i) s2 += bperm(h1, i) * w2[i * 64 + lane];
    HID[(long)item * 64 + lane] = sinf(fq[lane] * s2);
  }
}

__device__ __forceinline__ void hyena_kf_phase(const P& p, int l, int first_block, int nblocks) {
  const float* w3 = p.in[16] + (size_t)l * 64 * 2048;
  const float* HID = (const float*)(p.ws + OFF_HID);
  u16* KF = (u16*)(p.ws + OFF_KF);
  float* L1 = (float*)(p.ws + OFF_L1);
  const int lane = tidx() & 63;
  const int bl = bidx() - first_block;
  const int wave = bl * 4 + (tidx() >> 6), nwv = nblocks * 4;
  for (int it2 = (bl < 0 ? 2048 : wave); it2 < 2048; it2 += nwv) {
    const int item = it2 < 1024 ? 1024 + it2 : it2 - 1024;
    int ti = item >> 10, o = (item >> 9) & 1, c = item & 511;
    int T = ti ? TS : TP;
    const float* hid = HID + (ti ? (long)TP * 64 : 0);
    u16* kf = KF + (ti ? 2l * 512 * 4128 : 0) + (long)(o * 512 + c) * 2 * T;
    float delta = fabsf(-3.0701134573253943f + (float)c * ((-15.350567286626972f + 3.0701134573253943f) / 511.f));
    float asum = 0.f;
    {
      const int col0 = (o * 2) * 512 + c, col1 = col0 + 512;
      float wc0[64], wc1[64];
#pragma unroll
      for (int j = 0; j < 64; ++j) { wc0[j] = w3[j * 2048 + col0]; wc1[j] = w3[j * 2048 + col1]; }
      for (int lb = 0; lb < T; lb += 64) {
        int lag = lb + lane;
        if (lag < T) {
          const float4* hp = (const float4*)(hid + (long)lag * 64);
          float s0 = 0.f, s1 = 0.f;
#pragma unroll
          for (int j4 = 0; j4 < 16; ++j4) {
            float4 hv = hp[j4];
            s0 += hv.x * wc0[j4 * 4] + hv.y * wc0[j4 * 4 + 1] + hv.z * wc0[j4 * 4 + 2] + hv.w * wc0[j4 * 4 + 3];
            s1 += hv.x * wc1[j4 * 4] + hv.y * wc1[j4 * 4 + 1] + hv.z * wc1[j4 * 4 + 2] + hv.w * wc1[j4 * 4 + 3];
          }
          float tt = (float)lag / (float)(T - 1);
          float dec = __expf(-tt * delta);
          float v0 = s0 * dec, v1 = s1 * dec;
          asum += fabsf(v0); kf[T + lag] = f2bf(v0);
          if (lag > 0) { asum += fabsf(v1); kf[T - lag] = f2bf(v1); }
        }
      }
    }
    if (lane == 0) kf[0] = 0;
    asum = wave_sum(asum);
    if (lane == 0) L1[item] = asum;
  }
}

__device__ void hyena_prep_phase(const P& p, int l, char* smem) {
  const u16* PR = (const u16*)((char*)p.out + OD_PROJ);
  const float* cw = p.in[11] + l * 3 * 1536;
  u16* tile = (u16*)smem;
  const int tid = tidx();
  const int ntile = (NT / 64) * 8;
  for (int id = bidx(); id < ntile * 3; id += gridDim.x) {
    int part = id / ntile, rem = id % ntile;
    int r0 = (rem >> 3) * 64, c0 = (rem & 7) * 64;
    __syncthreads();
#pragma unroll
    for (int i = 0; i < 2; ++i) {
      int item = tid + 256 * i;
      int rl = item >> 3, cv = (item & 7) * 8;
      int row = r0 + rl; int t, T; row_info(row, t, T);
      int col = part * 512 + c0 + cv;
      const u16* pr = PR + (long)row * 1536 + col;
      uint4 z4 = make_uint4(0, 0, 0, 0);
      uint4 x1 = *(const uint4*)pr, x0 = z4, x2 = z4;
      if (t > 0) x0 = *(const uint4*)(pr - 1536);
      if (t < T - 1) x2 = *(const uint4*)(pr + 1536);
      float4 wa0 = *(const float4*)(cw + col), wa1 = *(const float4*)(cw + col + 4);
      float4 wb0 = *(const float4*)(cw + 1536 + col), wb1 = *(const float4*)(cw + 1536 + col + 4);
      float4 wc0 = *(const float4*)(cw + 3072 + col), wc1 = *(const float4*)(cw + 3072 + col + 4);
      float w0[8] = {wa0.x, wa0.y, wa0.z, wa0.w, wa1.x, wa1.y, wa1.z, wa1.w};
      float w1[8] = {wb0.x, wb0.y, wb0.z, wb0.w, wb1.x, wb1.y, wb1.z, wb1.w};
      float w2[8] = {wc0.x, wc0.y, wc0.z, wc0.w, wc1.x, wc1.y, wc1.z, wc1.w};
      unsigned a0[4] = {x0.x, x0.y, x0.z, x0.w}, a1[4] = {x1.x, x1.y, x1.z, x1.w}, a2[4] = {x2.x, x2.y, x2.z, x2.w};
#pragma unroll
      for (int e = 0; e < 4; ++e) {
        tile[(cv + 2 * e) * 72 + rl] = f2bf(w0[2 * e] * lo2f(a0[e]) + w1[2 * e] * lo2f(a1[e]) + w2[2 * e] * lo2f(a2[e]));
        tile[(cv + 2 * e + 1) * 72 + rl] = f2bf(w0[2 * e + 1] * hi2f(a0[e]) + w1[2 * e + 1] * hi2f(a1[e]) + w2[2 * e + 1] * hi2f(a2[e]));
      }
    }
    __syncthreads();
    u16* o = (u16*)(p.ws + (part == 0 ? OFF_BR + 2 * SZ_BR : (part == 1 ? OFF_BR + 3 * SZ_BR : OFF_X2T)));
#pragma unroll
    for (int i = 0; i < 2; ++i) {
      int item = tid + 256 * i;
      int cl = item >> 3, tv = (item & 7) * 8;
      *(uint4*)(o + (long)(c0 + cl) * NT + r0 + tv) = *(const uint4*)(tile + cl * 72 + tv);
    }
  }
}

template <bool SAMPLE, int ORD>
__device__ __forceinline__ void longconv_task(const P& p, int l, int c, u16* smem16) {
  constexpr int T = SAMPLE ? TS : TP;
  constexpr int W = SAMPLE ? 256 : 128;
  constexpr int NSTRIP = 17;
  constexpr int DMAX = W;
  constexpr int NEW = SAMPLE ? 1 : 2;
  constexpr int NHF = SAMPLE ? 1 : 2;
  constexpr int NB = SAMPLE ? 18 : 9;
  constexpr int PADL = 320;
  constexpr int LK = SAMPLE ? 8832 : 4672;
  constexpr int TW = SAMPLE ? 32 : 16;
  constexpr int R = SAMPLE ? 8 : 16;
  constexpr int LS = 280;
  constexpr int NV = R * 34;
  constexpr int NLD = (NV + 255) / 256;
  u16* kl = smem16;
  u16* ub = smem16 + 2 * 8832;
  const int tid = tidx(), lane = tid & 63, wave = tid >> 6;
  const u16* KF = (const u16*)(p.ws + OFF_KF) + (SAMPLE ? 2l * 512 * 4128 : 0) + (long)(ORD * 512 + c) * 2 * T;
  __syncthreads();
  for (int v = tid; v < LK / 8; v += 256) {
    int idx = v * 8 - PADL;
    uint4 val = (idx >= 0 && idx <= 2 * T - 8) ? *(const uint4*)(KF + idx) : make_uint4(0, 0, 0, 0);
    *(uint4*)(kl + v * 8) = val;
    unsigned prev = (idx - 1 >= 0 && idx - 1 <= 2 * T - 1) ? (unsigned)KF[idx - 1] : 0u;
    uint4 sh;
    sh.x = (val.x << 16) | prev; sh.y = (val.y << 16) | (val.x >> 16); sh.z = (val.z << 16) | (val.y >> 16); sh.w = (val.w << 16) | (val.z >> 16);
    *(uint4*)(kl + LK + v * 8) = sh;
  }
  const unsigned klw = (unsigned)(size_t)(__attribute__((address_space(3))) u16*)(kl + ((lane & 1) ? 0 : LK + 2));
  const u16* U = (ORD == 0 ? (const u16*)(p.ws + OFF_BR + 2 * SZ_BR) : (const u16*)((char*)p.out + OD_PROJ)) + (long)c * NT;
  const u16* X = (ORD == 0 ? (const u16*)(p.ws + OFF_BR + 3 * SZ_BR) : (const u16*)(p.ws + OFF_X2T)) + (long)c * NT;
  const float invl1 = 1.f / ((const float*)(p.ws + OFF_L1))[(SAMPLE ? 1024 : 0) + ORD * 512 + c];
  const float bias = p.in[18][(l * 2 + ORD) * 512 + c];
  const int n = lane & 15, g = lane >> 4;
  const int toff = SAMPLE ? 16 * (n >> 3) : 0;
  const int lrow = SAMPLE ? (n & 7) : n;
  const int lane_s = toff + 8 * g;
  const bf16x8 zero8 = (bf16x8){0, 0, 0, 0, 0, 0, 0, 0};
  int srow[NLD], scol[NLD];
#pragma unroll
  for (int i = 0; i < NLD; ++i) { int v = tid + 256 * i; srow[i] = v / 34; scol[i] = (v - srow[i] * 34) * 8; }
  for (int hf = 0; hf < NHF; ++hf) {
    const int rowbase_blk = SAMPLE ? ROWS_P : hf * 16 * TP;
    for (int rnd = 0; rnd < 5; ++rnd) {
      const int strip = rnd * 4 + wave;
      const bool active = strip < NSTRIP;
      const int t0 = strip * W;
      f32x4 acc[8];
      bf16x8 ring[8];
#pragma unroll
      for (int q = 0; q < 8; ++q) { acc[q] = (f32x4){0.f, 0.f, 0.f, 0.f}; ring[q] = zero8; }
      uint4 st[NLD];
#pragma unroll
      for (int i = 0; i < NLD; ++i) {
        int s = -32 + scol[i];
        bool ok = (tid + 256 * i < NV) && s >= 0 && s <= T - 8;
        st[i] = ok ? *(const uint4*)(U + rowbase_blk + srow[i] * T + s) : make_uint4(0, 0, 0, 0);
      }
      __syncthreads();
#pragma unroll
      for (int i = 0; i < NLD; ++i) if (tid + 256 * i < NV) *(uint4*)(ub + srow[i] * LS + scol[i]) = st[i];
      __syncthreads();
      unsigned x0 = 0, x1 = 0, x2 = 0, x3 = 0;
      if (active) {
        const int li0 = t0 + DMAX + n - 8 * g + T + PADL;
        const unsigned ad = klw + (((li0 - 7) >> 1) << 2);
        asm volatile("ds_read_b32 %0, %4 offset:12\n\tds_read_b32 %1, %4 offset:8\n\tds_read_b32 %2, %4 offset:4\n\tds_read_b32 %3, %4"
                     : "=&v"(x0), "=&v"(x1), "=&v"(x2), "=&v"(x3) : "v"(ad));
      }
      for (int ib = 0; ib < NB; ++ib) {
        const u16* cur = ub + (ib & 1) * (R * LS);
        if (ib + 1 < NB) {
#pragma unroll
          for (int i = 0; i < NLD; ++i) {
            int s = 256 * (ib + 1) - 32 + scol[i];
            bool ok = (tid + 256 * i < NV) && s >= 0 && s <= T - 8;
            st[i] = ok ? *(const uint4*)(U + rowbase_blk + srow[i] * T + s) : make_uint4(0, 0, 0, 0);
          }
        }
        if (active) {
#pragma unroll
          for (int u = 0; u < 8; ++u) {
            const int it = ib * 8 + u;
#pragma unroll
            for (int j = 0; j < NEW; ++j)
              ring[(8 - NEW + j + NEW * u) & 7] = *(const bf16x8*)(cur + lrow * LS + 16 * j + 32 * u + lane_s);
            asm volatile("s_waitcnt lgkmcnt(0)" : "+v"(x0), "+v"(x1), "+v"(x2), "+v"(x3));
            union { bf16x8 v; unsigned w[4]; } avu;
            avu.w[0] = (x0 >> 16) | (x0 << 16); avu.w[1] = (x1 >> 16) | (x1 << 16);
            avu.w[2] = (x2 >> 16) | (x2 << 16); avu.w[3] = (x3 >> 16) | (x3 << 16);
            const bf16x8 av = avu.v;
            {
              const int li0 = t0 + DMAX - 32 * (it + 1) + n - 8 * g + T + PADL;
              const unsigned ad = klw + (((li0 - 7) >> 1) << 2);
              asm volatile("ds_read_b32 %0, %4 offset:12\n\tds_read_b32 %1, %4 offset:8\n\tds_read_b32 %2, %4 offset:4\n\tds_read_b32 %3, %4"
                           : "=&v"(x0), "=&v"(x1), "=&v"(x2), "=&v"(x3) : "v"(ad));
            }
#pragma unroll
            for (int q = 0; q < 8; ++q)
              acc[q] = __builtin_amdgcn_mfma_f32_16x16x32_bf16(av, ring[(q + NEW * u) & 7], acc[q], 0, 0, 0);
          }
        }
        if (ib + 1 < NB) {
          u16* nb = ub + ((ib + 1) & 1) * (R * LS);
#pragma unroll
          for (int i = 0; i < NLD; ++i) if (tid + 256 * i < NV) *(uint4*)(nb + srow[i] * LS + scol[i]) = st[i];
        }
        __syncthreads();
      }
      if (active) {
#pragma unroll
        for (int q = 0; q < 8; ++q) {
          const int t = t0 + TW * q + toff + 4 * g;
          const int rb = rowbase_blk + lrow * T;
          if (t < T) {
            uint2 uu = *(const uint2*)(U + rb + t);
            uint2 xx = *(const uint2*)(X + rb + t);
            float uv[4] = {lo2f(uu.x), hi2f(uu.x), lo2f(uu.y), hi2f(uu.y)};
            float xv[4] = {lo2f(xx.x), hi2f(xx.x), lo2f(xx.y), hi2f(xx.y)};
            float zv[4];
#pragma unroll
            for (int j = 0; j < 4; ++j) zv[j] = xv[j] * (acc[q][j] * invl1 + uv[j] * bias);
            u16* Z = (ORD == 0 ? (u16*)((char*)p.out + OD_PROJ) : (u16*)(p.ws + OFF_BR + 3 * SZ_BR)) + (long)c * NT;
            *(uint2*)(Z + rb + t) = make_uint2(pack2(zv[0], zv[1]), pack2(zv[2], zv[3]));
          }
        }
      }
    }
  }
}

template <int ORD>
__device__ void longconv_phase(const P& p, int l, char* smem) {
  u16* kl = (u16*)smem;
  for (int task = bidx(); task < 1024; task += gridDim.x) {
    int c = task & 511;
    if (task >= 512) longconv_task<true, ORD>(p, l, c, kl);
    else longconv_task<false, ORD>(p, l, c, kl);
  }
}

__device__ void hyena_tr_phase(const P& p, char* smem) {
  const u16* ZT = (const u16*)(p.ws + OFF_BR + 3 * SZ_BR);
  u16* BR2 = (u16*)(p.ws + OFF_BR + 2 * SZ_BR);
  u16* tile = (u16*)smem;
  const int tid = tidx();
  const int ntile = (NT / 64) * 8;
  for (int id = bidx(); id < ntile; id += gridDim.x) {
    int r0 = (id >> 3) * 64, c0 = (id & 7) * 64;
    __syncthreads();
#pragma unroll
    for (int i = 0; i < 2; ++i) {
      int item = tid + 256 * i;
      int cl = item >> 3, tv = (item & 7) * 8;
      uint4 v = *(const uint4*)(ZT + (long)(c0 + cl) * NT + r0 + tv);
      unsigned w4[4] = {v.x, v.y, v.z, v.w};
#pragma unroll
      for (int e = 0; e < 4; ++e) { tile[(tv + 2 * e) * 72 + cl] = (u16)(w4[e] & 0xffffu); tile[(tv + 2 * e + 1) * 72 + cl] = (u16)(w4[e] >> 16); }
    }
    __syncthreads();
#pragma unroll
    for (int i = 0; i < 2; ++i) {
      int item = tid + 256 * i;
      int rl = item >> 3, cv = (item & 7) * 8;
      *(uint4*)(BR2 + (long)(r0 + rl) * 512 + c0 + cv) = *(const uint4*)(tile + rl * 72 + cv);
    }
  }
}

__device__ void sc_phase(const P& p, int l) {
  const u16* PR = (const u16*)((char*)p.out + OD_PROJ);
  const float* cw = p.in[19] + l * 3 * 512;
  u16* BR3 = (u16*)(p.ws + OFF_BR + 3 * SZ_BR);
  float w0[8], w1[8], w2[8];
  { const int c80 = (tidx() & 63) * 8; ld8(cw + c80, w0); ld8(cw + 512 + c80, w1); ld8(cw + 1024 + c80, w2); }
  for (long i = (long)bidx() * 256 + tidx(); i < (long)NT * 64; i += (long)gridDim.x * 256) {
    int row = (int)(i >> 6), c8 = (int)(i & 63) * 8;
    int t, T; row_info(row, t, T);
    const u16* pr = PR + (long)row * 1536;
    uint4 bg = *(const uint4*)(pr + c8);
    uint4 z4 = make_uint4(0, 0, 0, 0);
    uint4 c1 = *(const uint4*)(pr + 512 + c8), x1 = *(const uint4*)(pr + 1024 + c8);
    uint4 c0 = z4, x0 = z4, c2 = z4, x2 = z4;
    if (t > 0) { c0 = *(const uint4*)(pr - 1536 + 512 + c8); x0 = *(const uint4*)(pr - 1536 + 1024 + c8); }
    if (t < T - 1) { c2 = *(const uint4*)(pr + 1536 + 512 + c8); x2 = *(const uint4*)(pr + 1536 + 1024 + c8); }
    unsigned bga[4] = {bg.x, bg.y, bg.z, bg.w};
    unsigned c0a[4] = {c0.x, c0.y, c0.z, c0.w}, x0a[4] = {x0.x, x0.y, x0.z, x0.w};
    unsigned c1a[4] = {c1.x, c1.y, c1.z, c1.w}, x1a[4] = {x1.x, x1.y, x1.z, x1.w};
    unsigned c2a[4] = {c2.x, c2.y, c2.z, c2.w}, x2a[4] = {x2.x, x2.y, x2.z, x2.w};
    unsigned o[4];
#pragma unroll
    for (int e = 0; e < 4; ++e) {
      float lo = lo2f(bga[e]) * (w0[2 * e] * lo2f(c0a[e]) * lo2f(x0a[e]) + w1[2 * e] * lo2f(c1a[e]) * lo2f(x1a[e]) + w2[2 * e] * lo2f(c2a[e]) * lo2f(x2a[e]));
      float hi = hi2f(bga[e]) * (w0[2 * e + 1] * hi2f(c0a[e]) * hi2f(x0a[e]) + w1[2 * e + 1] * hi2f(c1a[e]) * hi2f(x1a[e]) + w2[2 * e + 1] * hi2f(c2a[e]) * hi2f(x2a[e]));
      o[e] = pack2(lo, hi);
    }
    *(uint4*)(BR3 + (long)row * 512 + c8) = make_uint4(o[0], o[1], o[2], o[3]);
  }
}

__device__ void ffn_act_phase(const P& p, int l, int rb, int re) {
  const u16* UP = (const u16*)((char*)p.out + OD_PROJ);
  const float* cw = p.in[23] + (size_t)l * 3 * 5632;
  u16* ACT = (u16*)(p.ws + OFF_BR);
  const long nitem = (long)(re - rb) * 352;
  for (long i = (long)bidx() * 256 + tidx(); i < nitem; i += (long)gridDim.x * 256) {
    int lr = (int)(i / 352), j8 = (int)(i % 352) * 8;
    int row = rb + lr;
    int t, T; row_info(row, t, T);
    const u16* pr = UP + (long)lr * 5632;
    uint4 z4 = make_uint4(0, 0, 0, 0);
    uint4 a1 = *(const uint4*)(pr + j8), v1 = *(const uint4*)(pr + 2816 + j8);
    uint4 a0 = z4, v0 = z4, a2 = z4, v2 = z4;
    if (t > 0) { a0 = *(const uint4*)(pr - 5632 + j8); v0 = *(const uint4*)(pr - 5632 + 2816 + j8); }
    if (t < T - 1) { a2 = *(const uint4*)(pr + 5632 + j8); v2 = *(const uint4*)(pr + 5632 + 2816 + j8); }
    unsigned a0a[4] = {a0.x, a0.y, a0.z, a0.w}, a1a[4] = {a1.x, a1.y, a1.z, a1.w}, a2a[4] = {a2.x, a2.y, a2.z, a2.w};
    unsigned v0a[4] = {v0.x, v0.y, v0.z, v0.w}, v1a[4] = {v1.x, v1.y, v1.z, v1.w}, v2a[4] = {v2.x, v2.y, v2.z, v2.w};
    float wa0[8], wa1[8], wa2[8], wv0[8], wv1[8], wv2[8];
    ld8(cw + j8, wa0); ld8(cw + 5632 + j8, wa1); ld8(cw + 11264 + j8, wa2);
    ld8(cw + 2816 + j8, wv0); ld8(cw + 5632 + 2816 + j8, wv1); ld8(cw + 11264 + 2816 + j8, wv2);
    unsigned o[4];
#pragma unroll
    for (int e = 0; e < 4; ++e) {
      float al = wa0[2 * e] * lo2f(a0a[e]) + wa1[2 * e] * lo2f(a1a[e]) + wa2[2 * e] * lo2f(a2a[e]);
      float ah = wa0[2 * e + 1] * hi2f(a0a[e]) + wa1[2 * e + 1] * hi2f(a1a[e]) + wa2[2 * e + 1] * hi2f(a2a[e]);
      float vl = wv0[2 * e] * lo2f(v0a[e]) + wv1[2 * e] * lo2f(v1a[e]) + wv2[2 * e] * lo2f(v2a[e]);
      float vh = wv0[2 * e + 1] * hi2f(v0a[e]) + wv1[2 * e + 1] * hi2f(v1a[e]) + wv2[2 * e + 1] * hi2f(v2a[e]);
      o[e] = pack2(siluf(al) * vl, siluf(ah) * vh);
    }
    *(uint4*)(ACT + (long)row * 2816 + j8) = make_uint4(o[0], o[1], o[2], o[3]);
  }
}

__device__ __forceinline__ void ffn_gate_rows(const u16* E, int rfirst, int tpos0, int T, int sb, int j0, const float* cw, u16* ACT, int tid) {
#pragma unroll
  for (int it = 0; it < 4; ++it) {
    const int item = tid + 256 * it;
    const int r = rfirst + (item >> 3), cg = (item & 7) * 8;
    const int t = tpos0 + r;
    if ((item >> 3) < 127 && t < T) {
      uint4 ea0 = *(const uint4*)(E + (r - 1) * 136 + cg), ea1 = *(const uint4*)(E + r * 136 + cg), ea2 = *(const uint4*)(E + (r + 1) * 136 + cg);
      uint4 ev0 = *(const uint4*)(E + (r - 1) * 136 + 64 + cg), ev1 = *(const uint4*)(E + r * 136 + 64 + cg), ev2 = *(const uint4*)(E + (r + 1) * 136 + 64 + cg);
      const uint4 z4 = make_uint4(0, 0, 0, 0);
      if (t == 0) { ea0 = z4; ev0 = z4; }
      if (t == T - 1) { ea2 = z4; ev2 = z4; }
      unsigned a0a[4] = {ea0.x, ea0.y, ea0.z, ea0.w}, a1a[4] = {ea1.x, ea1.y, ea1.z, ea1.w}, a2a[4] = {ea2.x, ea2.y, ea2.z, ea2.w};
      unsigned v0a[4] = {ev0.x, ev0.y, ev0.z, ev0.w}, v1a[4] = {ev1.x, ev1.y, ev1.z, ev1.w}, v2a[4] = {ev2.x, ev2.y, ev2.z, ev2.w};
      float wa0[8], wa1[8], wa2[8], wv0[8], wv1[8], wv2[8];
      const int j8 = j0 + cg;
      ld8(cw + j8, wa0); ld8(cw + 5632 + j8, wa1); ld8(cw + 11264 + j8, wa2);
      ld8(cw + 2816 + j8, wv0); ld8(cw + 5632 + 2816 + j8, wv1); ld8(cw + 11264 + 2816 + j8, wv2);
      unsigned o[4];
#pragma unroll
      for (int e = 0; e < 4; ++e) {
        float al = wa0[2 * e] * lo2f(a0a[e]) + wa1[2 * e] * lo2f(a1a[e]) + wa2[2 * e] * lo2f(a2a[e]);
        float ah = wa0[2 * e + 1] * hi2f(a0a[e]) + wa1[2 * e + 1] * hi2f(a1a[e]) + wa2[2 * e + 1] * hi2f(a2a[e]);
        float vl = wv0[2 * e] * lo2f(v0a[e]) + wv1[2 * e] * lo2f(v1a[e]) + wv2[2 * e] * lo2f(v2a[e]);
        float vh = wv0[2 * e + 1] * hi2f(v0a[e]) + wv1[2 * e + 1] * hi2f(v1a[e]) + wv2[2 * e + 1] * hi2f(v2a[e]);
        o[e] = pack2(siluf(al) * vl, siluf(ah) * vh);
      }
      *(uint4*)(ACT + (long)(sb + t) * 2816 + j8) = make_uint4(o[0], o[1], o[2], o[3]);
    }
  }
}

__device__ void ffn_up_fused_phase(const P& p, int l, char* smem) {
  u16* sA = (u16*)smem; u16* sB = sA + 256 * 72;
  u16* E = (u16*)smem;
  const u16* HN = (const u16*)(p.ws + OFF_HN);
  const u16* W = (const u16*)(p.ws + (size_t)l * SZ_WL + OW_UP);
  const float* cw = p.in[23] + (size_t)l * 3 * 5632;
  u16* ACT = (u16*)(p.ws + OFF_BR);
  const int tid = tidx(), lane = tid & 63, wid = tid >> 6, wr = wid >> 1, wc = wid & 1, fr = lane & 15, fq = lane >> 4;
  const int G = gridDim.x, bq = bidx();
  const int bsw = (G & 7) == 0 ? (bq & 7) * (G >> 3) + (bq >> 3) : bq;
  const int ntiles = 424 * 44;
  for (int tile = bsw; tile < ntiles; tile += G) {
    const int mgp = tile / 352, rr = tile - mgp * 352;
    const int nbk = rr >> 5, qq = rr & 31;
    const int mi = mgp * 8 + (qq >> 2), jt = nbk * 4 + (qq & 3);
    int seq, mt;
    if (mi < 288) { seq = mi / 9; mt = mi - seq * 9; } else { int q = mi - 288; seq = 32 + q / 17; mt = q - (q / 17) * 17; }
    const int T = seq < 32 ? TP : TS;
    const int sb = seq_base(seq);
    const int tfirst = 254 * mt - 1;
    const int j0 = jt * 64;
    f32x4 acc[8][4];
#pragma unroll
    for (int m = 0; m < 8; ++m)
#pragma unroll
      for (int n = 0; n < 4; ++n) acc[m][n] = (f32x4){0.f, 0.f, 0.f, 0.f};
    {
      const int lr = tid >> 3, lk = (tid & 7) * 8;
      const u16* pA = HN + (long)(sb + tfirst + lr) * 1024 + lk;
      const u16* pBa = W + (long)(j0 + lr) * 1024 + lk;
      const u16* pBv = W + (long)(2816 + j0 + lr) * 1024 + lk;
      uint4 a0, a1, a2, a3, a4, a5, a6, a7, b0, b1, b2, b3;
#define UP_LOAD(k) do { \
      a0 = *(const uint4*)(pA + (k)); a1 = *(const uint4*)(pA + (k) + 32 * 1024); a2 = *(const uint4*)(pA + (k) + 64 * 1024); a3 = *(const uint4*)(pA + (k) + 96 * 1024); \
      a4 = *(const uint4*)(pA + (k) + 128 * 1024); a5 = *(const uint4*)(pA + (k) + 160 * 1024); a6 = *(const uint4*)(pA + (k) + 192 * 1024); a7 = *(const uint4*)(pA + (k) + 224 * 1024); \
      b0 = *(const uint4*)(pBa + (k)); b1 = *(const uint4*)(pBa + (k) + 32 * 1024); b2 = *(const uint4*)(pBv + (k)); b3 = *(const uint4*)(pBv + (k) + 32 * 1024); } while (0)
      UP_LOAD(0);
      u16* wA = sA + lr * 72 + lk;
      for (int kt = 0; kt < 16; ++kt) {
        __syncthreads();
        *(uint4*)(wA) = a0; *(uint4*)(wA + 32 * 72) = a1; *(uint4*)(wA + 64 * 72) = a2; *(uint4*)(wA + 96 * 72) = a3;
        *(uint4*)(wA + 128 * 72) = a4; *(uint4*)(wA + 160 * 72) = a5; *(uint4*)(wA + 192 * 72) = a6; *(uint4*)(wA + 224 * 72) = a7;
        *(uint4*)(wA + 256 * 72) = b0; *(uint4*)(wA + 288 * 72) = b1; *(uint4*)(wA + 320 * 72) = b2; *(uint4*)(wA + 352 * 72) = b3;
        __syncthreads();
        const int k = (kt + 1 < 16 ? kt + 1 : kt) * 64;
        UP_LOAD(k);
        gemm_compute<true, 8>(acc, sA, sB, wr, wc, fr, fq);
      }
#undef UP_LOAD
    }
    unsigned pk[8][4][2];
#pragma unroll
    for (int m = 0; m < 8; ++m)
#pragma unroll
      for (int n = 0; n < 4; ++n) { pk[m][n][0] = pack2(acc[m][n][0], acc[m][n][1]); pk[m][n][1] = pack2(acc[m][n][2], acc[m][n][3]); }
    __syncthreads();
    if (wr == 0) {
#pragma unroll
      for (int m = 0; m < 8; ++m)
#pragma unroll
        for (int n = 0; n < 4; ++n)
          *(uint2*)(E + (m * 16 + fr) * 136 + wc * 64 + n * 16 + fq * 4) = make_uint2(pk[m][n][0], pk[m][n][1]);
    } else if (fr == 0) {
#pragma unroll
      for (int n = 0; n < 4; ++n)
        *(uint2*)(E + 128 * 136 + wc * 64 + n * 16 + fq * 4) = make_uint2(pk[0][n][0], pk[0][n][1]);
    }
    __syncthreads();
    ffn_gate_rows(E, 1, tfirst, T, sb, j0, cw, ACT, tid);
    __syncthreads();
    if (wr == 1) {
#pragma unroll
      for (int m = 0; m < 8; ++m)
#pragma unroll
        for (int n = 0; n < 4; ++n)
          *(uint2*)(E + (1 + m * 16 + fr) * 136 + wc * 64 + n * 16 + fq * 4) = make_uint2(pk[m][n][0], pk[m][n][1]);
    } else if (fr == 15) {
#pragma unroll
      for (int n = 0; n < 4; ++n)
        *(uint2*)(E + wc * 64 + n * 16 + fq * 4) = make_uint2(pk[7][n][0], pk[7][n][1]);
    }
    __syncthreads();
    ffn_gate_rows(E, 1, tfirst + 127, T, sb, j0, cw, ACT, tid);
  }
}

__device__ void merge_phase(const P& p, int l, char* smem) {
  u16* sA = (u16*)smem; u16* sB = sA + 128 * 72;
  const u16* HN = (const u16*)(p.ws + OFF_HN);
  const char* wl = p.ws + (size_t)l * SZ_WL;
  const u16* Wg = (const u16*)(wl + OW_IN) + (size_t)5136 * 1024;
  const u16* Wb = (const u16*)(wl + OW_BR);
  u16* MG = (u16*)((char*)p.out + OD_PROJ);
  const int nN = 8, nM = NT / 128;
  const int G = gridDim.x, bq = bidx();
  const int bsw = (G & 7) == 0 ? (bq & 7) * (G >> 3) + (bq >> 3) : bq;
  for (int tile = bsw; tile < nM * nN; tile += G) {
    int m0 = (tile / nN) * 128, n0 = (tile % nN) * 128;
    unsigned mgp[4][4][2];
#pragma unroll
    for (int m = 0; m < 4; ++m)
#pragma unroll
      for (int n = 0; n < 4; ++n) { mgp[m][n][0] = 0u; mgp[m][n][1] = 0u; }
    for (int k = 0; k < 4; ++k) {
      unsigned gate[4][4][2];
      {
        f32x4 acc[4][4];
#pragma unroll
        for (int m = 0; m < 4; ++m)
#pragma unroll
          for (int n = 0; n < 4; ++n) acc[m][n] = (f32x4){0.f, 0.f, 0.f, 0.f};
        GA g{HN, 1024, NT, Wg + (size_t)k * 1024 * 1024, 1024, 1024, 1024};
        gemm_main_db_4<true>(g, m0, n0, acc, sA);
#pragma unroll
        for (int m = 0; m < 4; ++m)
#pragma unroll
          for (int n = 0; n < 4; ++n) {
            gate[m][n][0] = pack2(sigmf(acc[m][n][0]), sigmf(acc[m][n][1]));
            gate[m][n][1] = pack2(sigmf(acc[m][n][2]), sigmf(acc[m][n][3]));
          }
      }
      {
        f32x4 acc[4][4];
#pragma unroll
        for (int m = 0; m < 4; ++m)
#pragma unroll
          for (int n = 0; n < 4; ++n) acc[m][n] = (f32x4){0.f, 0.f, 0.f, 0.f};
        GA g{(const u16*)(p.ws + OFF_BR + (size_t)k * SZ_BR), 512, NT, Wb + (size_t)k * 1024 * 512, 512, 1024, 512};
        gemm_main_db_4<true>(g, m0, n0, acc, sA);
#pragma unroll
        for (int m = 0; m < 4; ++m)
#pragma unroll
          for (int n = 0; n < 4; ++n) {
            mgp[m][n][0] = pack2(lo2f(mgp[m][n][0]) + lo2f(gate[m][n][0]) * acc[m][n][0], hi2f(mgp[m][n][0]) + hi2f(gate[m][n][0]) * acc[m][n][1]);
            mgp[m][n][1] = pack2(lo2f(mgp[m][n][1]) + lo2f(gate[m][n][1]) * acc[m][n][2], hi2f(mgp[m][n][1]) + hi2f(gate[m][n][1]) * acc[m][n][3]);
          }
      }
    }
    const int lane = tidx() & 63, wid = tidx() >> 6, wr = wid >> 1, wc = wid & 1, fr = lane & 15, fq = lane >> 4;
#pragma unroll
    for (int m = 0; m < 4; ++m)
#pragma unroll
      for (int n = 0; n < 4; ++n) {
        int row = m0 + wr * 64 + m * 16 + fr, col = n0 + wc * 64 + n * 16 + fq * 4;
        *(uint2*)(MG + (long)row * 1024 + col) = make_uint2(mgp[m][n][0], mgp[m][n][1]);
      }
  }
}

__global__ void __launch_bounds__(256, 2) hybrid_fwd(P p) {
  cg::grid_group grid = cg::this_grid();
  __shared__ __attribute__((aligned(16))) char smem[55296];
  u16* H = (u16*)(p.ws + OFF_H);
  u16* HN = (u16*)(p.ws + OFF_HN);
  u16* PROJ = (u16*)((char*)p.out + OD_PROJ);

  __shared__ uint4 xb_words;
  if (threadIdx.x == 0) xb_words = make_uint4(0u, 0u, 0u, 0u);
  __syncthreads();
  XcdBarrier xb = xcd_barrier_post((unsigned*)(p.ws + OFF_BAR), (volatile LAS unsigned*)&xb_words);
  prep_phase(p, smem);
  grid.sync();

  for (int l = 0; l < 2; ++l) {
    const char* wl = p.ws + (size_t)l * SZ_WL;
    for (int rep = 0; rep < REPE; ++rep) rmsnorm_phase(H, p.in[3] + l * 1024, HN, nullptr, 0);
    for (int rep = 0; rep < REPE; ++rep) hyena_hid_phase(p, l);
    GSYNC();
    {
      GA g{HN, 1024, NT, (const u16*)(wl + OW_FN), 1024, 1024, 1024};
      gemm_phase256<false>(g, [&](int row, int col, f32x4 v) {
        if (row >= NT) return;
        int t, T; row_info(row, t, T);
        const int Th = T == TP ? THP : THS;
        long gb = T == TP ? (long)(row / TP) * (512l * 2 * THP) : GT_SAMPLE0 + (long)((row - ROWS_P) / TS) * (512l * 2 * THS);
        int c = col & 511, half = col >> 9;
        *(uint2*)(PROJ + gb + (long)(c * 2 + half) * Th + t) = make_uint2(pack2(v[0], v[1]), pack2(v[2], v[3]));
      }, smem, REPG);
      for (long i = (long)bidx() * 256 + tidx(); i < 40l * 1024 * 6; i += (long)gridDim.x * 256) {
        int rowi = (int)(i / 6), v6 = (int)(i % 6);
        int seq = rowi >> 10, ch = rowi & 1023;
        long off = seq < 32 ? (long)seq * (512l * 2 * THP) + (long)ch * THP + TP : GT_SAMPLE0 + (long)(seq - 32) * (512l * 2 * THS) + (long)ch * THS + TS;
        unsigned zz = 0; asm volatile("" : "+v"(zz));
        *(uint4*)(PROJ + off + v6 * 8) = make_uint4(zz, zz, zz, zz);
      }
    }
    GSYNC();
    {
      u16* BR0 = (u16*)(p.ws + OFF_BR);
      u16* sA = (u16*)smem; u16* sB = sA + 128 * 72;
      const int tiles_s = 8 * 17 * 4, tiles_p = 32 * 9 * 4;
      const int Gd = gridDim.x, bd = bidx();
      const bool bal = (Gd == 512);
      const int nslot = bal ? 4 : (tiles_s + tiles_p + Gd - 1) / Gd;
      for (int rep = 0; rep < REPG; ++rep)
      for (int slot = 0; slot < nslot; ++slot) {
        int tile;
        if (bal) {
          if (slot == 0) tile = bd;
          else if (bd < 32) tile = slot == 1 ? 512 + bd : (slot == 2 ? tiles_s + bd : -1);
          else { int pi = 32 + (bd - 32) + 480 * (slot - 1); tile = pi < tiles_p ? tiles_s + pi : -1; }
        } else tile = bd + slot * Gd;
        if (tile < 0 || tile >= tiles_s + tiles_p) continue;
        int seq, mt, nt, T, Th;
        if (tile < tiles_s) { mt = tile / 32; int r = tile % 32; seq = 32 + (r >> 2); nt = r & 3; T = TS; Th = THS; }
        else { int q = tile - tiles_s; mt = q / 128; int r = q % 128; seq = r >> 2; nt = r & 3; T = TP; Th = THP; }
        const int sb = seq_base(seq);
        const u16* Am = (const u16*)((char*)p.out + (T == TS ? OD_DFTS : OD_DFTP));
        const u16* Bm = PROJ + (seq < 32 ? (long)seq * (512l * 2 * THP) : GT_SAMPLE0 + (long)(seq - 32) * (512l * 2 * THS));
        f32x4 accP[4][4], accQ[4][4];
#pragma unroll
        for (int m = 0; m < 4; ++m)
#pragma unroll
          for (int n = 0; n < 4; ++n) { accP[m][n] = (f32x4){0.f, 0.f, 0.f, 0.f}; accQ[m][n] = (f32x4){0.f, 0.f, 0.f, 0.f}; }
        {
          GA g{Am, 2l * Th, T, Bm, 2l * Th, 512, Th};
          gemm_main2_4<true>(g, mt * 128, nt * 128, accP, sA, sB);
        }
        {
          GA g{Am + Th, 2l * Th, T, Bm + Th, 2l * Th, 512, Th};
          gemm_main2_4<true>(g, mt * 128, nt * 128, accQ, sA, sB);
        }
        const float sc = rsqrtf((float)T * 128.f);
        const int lane = tidx() & 63, wid = tidx() >> 6, wr = wid >> 1, wc = wid & 1, fr = lane & 15, fq = lane >> 4;
#pragma unroll
        for (int m = 0; m < 4; ++m)
#pragma unroll
          for (int n = 0; n < 4; ++n) {
            int row = mt * 128 + wr * 64 + m * 16 + fr, col = nt * 128 + wc * 64 + n * 16 + fq * 4;
            f32x4 pv = accP[m][n], qv = accQ[m][n];
            if (row <= T / 2)
              *(uint2*)(BR0 + (long)(sb + row) * 512 + col) = make_uint2(pack2((pv[0] - qv[0]) * sc, (pv[1] - qv[1]) * sc), pack2((pv[2] - qv[2]) * sc, (pv[3] - qv[3]) * sc));
            if (row >= 1 && row < T / 2)
              *(uint2*)(BR0 + (long)(sb + T - row) * 512 + col) = make_uint2(pack2((pv[0] + qv[0]) * sc, (pv[1] + qv[1]) * sc), pack2((pv[2] + qv[2]) * sc, (pv[3] + qv[3]) * sc));
          }
      }
    }
    GSYNC();
    {
      GA g{HN, 1024, NT, (const u16*)(wl + OW_IN) + (size_t)512 * 1024, 1024, 1552, 1024};
      gemm_phase256<true>(g, [&](int row, int col, f32x4 v) {
        if (col < 1552 && row < NT) *(uint2*)(PROJ + (long)row * 1552 + col) = make_uint2(pack2(v[0], v[1]), pack2(v[2], v[3]));
      }, smem, REPG);
    }
    GSYNC();
    ssd_conv_phase(p, l);
    GSYNC();
    for (int rep = 0; rep < REPS; ++rep) ssd_scan_phase(p, l, smem);
    { const int kf0 = (int)gridDim.x > 384 ? 384 : 0; hyena_kf_phase(p, l, kf0, (int)gridDim.x - kf0); }
    GSYNC();
    ssd_state_phase(p);
    GSYNC();
    ssd_fix_phase(p);
    GSYNC();
    for (int rep = 0; rep < REPE; ++rep) ssd_post_phase(p, l);
    GSYNC();
    {
      GA g{HN, 1024, NT, (const u16*)(wl + OW_IN) + (size_t)2064 * 1024, 1024, 1536, 1024};
      gemm_phase256<true>(g, [&](int row, int col, f32x4 v) {
        if (row < NT) *(uint2*)(PROJ + (long)row * 1536 + col) = make_uint2(pack2(v[0], v[1]), pack2(v[2], v[3]));
      }, smem, REPG);
    }
    GSYNC();
    for (int rep = 0; rep < REPE; ++rep) hyena_prep_phase(p, l, smem);
    GSYNC();
    for (int rep = 0; rep < REPL; ++rep) longconv_phase<0>(p, l, smem);
    GSYNC();
    for (int rep = 0; rep < REPL; ++rep) longconv_phase<1>(p, l, smem);
    GSYNC();
    hyena_tr_phase(p, smem);
    GSYNC();
    {
      GA g{HN, 1024, NT, (const u16*)(wl + OW_IN) + (size_t)3600 * 1024, 1024, 1536, 1024};
      gemm_phase256<true>(g, [&](int row, int col, f32x4 v) {
        if (row < NT) *(uint2*)(PROJ + (long)row * 1536 + col) = make_uint2(pack2(v[0], v[1]), pack2(v[2], v[3]));
      }, smem, REPG);
    }
    GSYNC();
    for (int rep = 0; rep < REPE; ++rep) sc_phase(p, l);
    GSYNC();
    for (int rep = 0; rep < REPG; ++rep) merge_phase(p, l, smem);
    GSYNC();
    {
      GA g{PROJ, 1024, NT, (const u16*)(wl + OW_OUT), 1024, 1024, 1024};
      gemm_phase256<true>(g, [&](int row, int col, f32x4 v) {
        if (row >= NT) return;
        uint2* hp = (uint2*)(H + (long)row * 1024 + col);
        uint2 o = *hp;
        *hp = make_uint2(pack2(lo2f(o.x) + v[0], hi2f(o.x) + v[1]), pack2(lo2f(o.y) + v[2], hi2f(o.y) + v[3]));
      }, smem, 1);
    }
    GSYNC();
    for (int rep = 0; rep < REPE; ++rep) rmsnorm_phase(H, p.in[22] + l * 1024, HN, nullptr, 0);
    GSYNC();
    for (int rep = 0; rep < REPG; ++rep) ffn_up_fused_phase(p, l, smem);
    GSYNC();
    {
      GA g{(const u16*)(p.ws + OFF_BR), 2816, NT, (const u16*)(wl + OW_DOWN), 2816, 1024, 2816};
      gemm_phase256<true>(g, [&](int row, int col, f32x4 v) {
        if (row >= NT) return;
        uint2* hp = (uint2*)(H + (long)row * 1024 + col);
        uint2 o = *hp;
        *hp = make_uint2(pack2(lo2f(o.x) + v[0], hi2f(o.x) + v[1]), pack2(lo2f(o.y) + v[2], hi2f(o.y) + v[3]));
      }, smem, 1);
    }
    GSYNC();
  }
  final_phase(p);
}

extern "C" void kernel_launch(void* const* d_in, const int* in_sizes, int n_in, void* d_out, int out_size,
                              void* d_ws, size_t ws_size, hipStream_t stream) {
  static int grid_blocks = 0;
  if (!grid_blocks) {
    int dev = 0, cus = 0, per_cu = 0;
    (void)hipGetDevice(&dev);
    (void)hipDeviceGetAttribute(&cus, hipDeviceAttributeMultiprocessorCount, dev);
    (void)hipOccupancyMaxActiveBlocksPerMultiprocessor(&per_cu, hybrid_fwd, 256, 0);
    if (per_cu > 2) per_cu = 2;
    grid_blocks = cus * per_cu;
  }
  if (ws_size < WS_TOTAL) { fprintf(stderr, "workspace too small: %zu < %zu\n", ws_size, (size_t)WS_NEED); return; }
  (void)hipMemsetAsync((char*)d_ws + OFF_BAR, 0, XCD_BAR_WORDS_C * 4, stream);
  P p{};
  for (int i = 0; i < 27; ++i) p.in[i] = (const float*)d_in[i];
  p.out = (float*)d_out;
  p.ws = (char*)d_ws;
  void* args[] = {&p};
  hipError_t e = hipLaunchCooperativeKernel((void*)hybrid_fwd, dim3(grid_blocks), dim3(256), args, 0, stream);
  if (e != hipSuccess) fprintf(stderr, "cooperative launch failed: %s (grid %d)\n", hipGetErrorString(e), grid_blocks);
}
```
